# Optimizing an MI355X kernel written in HIP

```python
import math
import jax
import jax.numpy as jnp
from jax import lax
import numpy as np

D_MODEL = 1024
BATCH = 8
SEQ = 4096
DEPTH = 4

N_A_LAYERS = DEPTH // 2
N_B_LAYERS = DEPTH - N_A_LAYERS
HEAD_DIM = 64
ROPE_DIMS = HEAD_DIM // 4
ROPE_THETA = 500000.0
NORM_EPS = 1e-5
Q_BLOCK = 128

DIFF_HEADS = 6
DIFF_V_DIM = 2 * HEAD_DIM
DIFF_QK_WIDTH = DIFF_HEADS * 2 * HEAD_DIM
DIFF_V_WIDTH = DIFF_HEADS * DIFF_V_DIM

MEM_TOKENS = 256
MEM_HEADS = 4
MEM_Q_WIDTH = MEM_HEADS * HEAD_DIM

DIL_GROUPS = ((128, 1), (512, 4), (2048, 16))
DIL_HEADS = 12
DIL_BLOCK = 128
DIL_QK_WIDTH = len(DIL_GROUPS) * DIL_HEADS * HEAD_DIM

A_IN_WIDTH = 2 * DIFF_QK_WIDTH + DIFF_V_WIDTH + MEM_Q_WIDTH
B_IN_WIDTH = DIL_QK_WIDTH + MEM_Q_WIDTH
MIX_OUT_WIDTH = DIFF_V_WIDTH + MEM_Q_WIDTH

PEER_HEADS = 8
PEER_N_KEYS = 128
PEER_N_EXPERTS = PEER_N_KEYS ** 2
PEER_TOPK = 16
PEER_QUERY_DIM = 256
PEER_HALF = PEER_QUERY_DIM // 2
PEER_CHUNK = 128

kernel_name = "hybrid_diffattn_dilated_peer_yoco"


def rmsnorm(x, g):
    xf = x.astype(jnp.float32)
    y = xf * lax.rsqrt(jnp.mean(xf * xf, axis=-1, keepdims=True) + NORM_EPS)
    return (y * g.astype(jnp.float32)).astype(x.dtype)


def rope_tables(seq):
    inv = ROPE_THETA ** (-jnp.arange(0, ROPE_DIMS, 2, dtype=jnp.float32) / ROPE_DIMS)
    ang = jnp.arange(seq, dtype=jnp.float32)[:, None] * inv[None, :]
    return jnp.cos(ang), jnp.sin(ang)


def partial_rope(t, cos, sin):
    half = ROPE_DIMS // 2
    rot = t[..., :ROPE_DIMS].astype(jnp.float32)
    x1, x2 = rot[..., :half], rot[..., half:]
    c = cos[None, :, None, :]
    s = sin[None, :, None, :]
    rotated = jnp.concatenate([x1 * c - x2 * s, x2 * c + x1 * s], axis=-1).astype(t.dtype)
    return jnp.concatenate([rotated, t[..., ROPE_DIMS:]], axis=-1)


def diff_attention(q, k, v, lam, subln_g, lambda_init):
    B, S = q.shape[0], q.shape[1]
    qh = q.reshape(B, S, DIFF_HEADS, 2, HEAD_DIM).transpose(0, 2, 3, 1, 4)
    kh = k.reshape(B, S, DIFF_HEADS, 2, HEAD_DIM).transpose(0, 2, 3, 1, 4)
    vh = v.transpose(0, 2, 1, 3)
    scale = HEAD_DIM ** -0.5
    kpos = jnp.arange(S)

    def block(i):
        qb = lax.dynamic_slice_in_dim(qh, i * Q_BLOCK, Q_BLOCK, axis=3)
        s = jnp.einsum('bhpqd,bhpkd->bhpqk', qb, kh).astype(jnp.float32) * scale
        qpos = i * Q_BLOCK + jnp.arange(Q_BLOCK)
        causal = kpos[None, :] <= qpos[:, None]
        p = jax.nn.softmax(jnp.where(causal, s, -jnp.inf), axis=-1)
        a = p[:, :, 0] - lam * p[:, :, 1]
        return jnp.einsum('bhqk,bhkd->bhqd', a.astype(v.dtype), vh)

    o = lax.map(block, jnp.arange(S // Q_BLOCK))
    o = o.transpose(1, 0, 3, 2, 4).reshape(B, S, DIFF_HEADS, DIFF_V_DIM)
    o = rmsnorm(o, subln_g) * (1.0 - lambda_init)
    return o.reshape(B, S, DIFF_V_WIDTH)


def memory_attention(q, mem_k, mem_v):
    B, S = q.shape[0], q.shape[1]
    s = jnp.einsum('bshd,bmhd->bhsm', q, mem_k).astype(jnp.float32) * HEAD_DIM ** -0.5
    p = jax.nn.softmax(s, axis=-1)
    o = jnp.einsum('bhsm,bmhd->bshd', p.astype(q.dtype), mem_v)
    return o.reshape(B, S, MEM_Q_WIDTH)


def dilated_branch(q, k, v, window, dilation):
    B, S, H, Dh = q.shape
    L = S // dilation
    n_steps = window // dilation
    nb = -(-L // DIL_BLOCK)
    Lp = nb * DIL_BLOCK

    def split(t):
        t = t.reshape(B, L, dilation, H, Dh).transpose(0, 2, 3, 1, 4)
        t = jnp.pad(t, ((0, 0), (0, 0), (0, 0), (0, Lp - L), (0, 0)))
        return t.reshape(B, dilation, H, nb, DIL_BLOCK, Dh)

    def with_prev(t):
        prev = jnp.pad(t[:, :, :, :-1], ((0, 0), (0, 0), (0, 0), (1, 0), (0, 0), (0, 0)))
        return jnp.concatenate([prev, t], axis=4)

    qb = split(q)
    kc = with_prev(split(k))
    vc = with_prev(split(v))
    s = jnp.einsum('bdhnqc,bdhnkc->bdhnqk', qb, kc).astype(jnp.float32) * HEAD_DIM ** -0.5
    qi = jnp.arange(DIL_BLOCK)[:, None]
    kj = jnp.arange(2 * DIL_BLOCK)[None, :]
    dist = qi + DIL_BLOCK - kj
    blk = jnp.arange(nb)[:, None, None]
    valid = (dist >= 0) & (dist <= n_steps) & ((blk > 0) | (kj >= DIL_BLOCK))
    s = jnp.where(valid, s, -jnp.inf)
    m = jnp.max(s, axis=-1, keepdims=True)
    e = jnp.exp(s - m)
    den = jnp.sum(e, axis=-1, keepdims=True)
    o = jnp.einsum('bdhnqk,bdhnkc->bdhnqc', (e / den).astype(v.dtype), vc)
    lse = (m + jnp.log(den))[..., 0]

    def merge(t):
        t = t.reshape((B, dilation, H, Lp) + t.shape[5:])[:, :, :, :L]
        t = jnp.moveaxis(t, 3, 1)
        return t.reshape((B, S, H) + t.shape[4:])

    return merge(o), merge(lse)


def dilated_mixture(q_all, k_all, v_all):
    B, S = q_all.shape[0], q_all.shape[1]
    outs, lses = [], []
    for g, (window, dilation) in enumerate(DIL_GROUPS):
        sl = slice(g * DIL_HEADS, (g + 1) * DIL_HEADS)
        o, lse = dilated_branch(q_all[:, :, sl], k_all[:, :, sl], v_all[:, :, sl], window, dilation)
        outs.append(o)
        lses.append(lse)
    alpha = jax.nn.softmax(jnp.stack(lses, axis=0), axis=0)
    o = jnp.sum(alpha[..., None] * jnp.stack(outs, axis=0).astype(jnp.float32), axis=0)
    return o.astype(q_all.dtype).reshape(B, S, DIL_HEADS * HEAD_DIM)


def peer(xn, w_q, sub_keys, u, v):
    B, S, D = xn.shape
    T = B * S
    xt = xn.reshape(T, D)
    q = (xt @ w_q).reshape(T, PEER_HEADS, 2, PEER_HALF)
    s = jnp.einsum('thpc,hpnc->thpn', q, sub_keys).astype(jnp.float32)
    s1, i1 = lax.top_k(s[:, :, 0], PEER_TOPK)
    s2, i2 = lax.top_k(s[:, :, 1], PEER_TOPK)
    cand = (s1[..., :, None] + s2[..., None, :]).reshape(T, PEER_HEADS, PEER_TOPK * PEER_TOPK)
    cidx = (i1[..., :, None] * PEER_N_KEYS + i2[..., None, :]).reshape(T, PEER_HEADS, PEER_TOPK * PEER_TOPK)
    top_s, top_j = lax.top_k(cand, PEER_TOPK)
    expert = jnp.take_along_axis(cidx, top_j, axis=-1)
    gate = jax.nn.softmax(top_s, axis=-1).astype(xn.dtype)
    n_chunks = T // PEER_CHUNK

    def chunk(args):
        xc, ec, gc = args
        h = jax.nn.gelu(jnp.einsum('cd,chkd->chk', xc, u[ec]), approximate=False)
        return jnp.einsum('chk,chkd->cd', gc * h, v[ec])

    out = lax.map(chunk, (xt.reshape(n_chunks, PEER_CHUNK, D),
                          expert.reshape(n_chunks, PEER_CHUNK, PEER_HEADS, PEER_TOPK),
                          gate.reshape(n_chunks, PEER_CHUNK, PEER_HEADS, PEER_TOPK)))
    return out.reshape(B, S, D)


def setup_inputs(seed: int = 0) -> dict:
    key = jax.random.key(seed)
    ks = jax.random.split(key, 18)
    f32 = jnp.float32

    def nrm(k, shape, scale):
        return jax.random.normal(k, shape, f32) * scale

    def gain(k, shape):
        return 1.0 + 0.02 * jax.random.normal(k, shape, f32)

    D = D_MODEL
    return {
        "x": nrm(ks[0], (BATCH, SEQ, D), 1.0),
        "mem": nrm(ks[1], (BATCH, MEM_TOKENS, D), 1.0),
        "norm_mix": gain(ks[2], (DEPTH, D)),
        "a_w_in": nrm(ks[3], (N_A_LAYERS, D, A_IN_WIDTH), D ** -0.5),
        "a_lambda": nrm(ks[4], (N_A_LAYERS, 4, HEAD_DIM), 0.1),
        "a_subln": gain(ks[5], (N_A_LAYERS, DIFF_V_DIM)),
        "b_w_in": nrm(ks[6], (N_B_LAYERS, D, B_IN_WIDTH), D ** -0.5),
        "norm_mem": gain(ks[7], (DEPTH, D)),
        "w_mem_kv": nrm(ks[8], (DEPTH, D, 2 * MEM_Q_WIDTH), D ** -0.5),
        "w_out": nrm(ks[9], (DEPTH, MIX_OUT_WIDTH, D), MIX_OUT_WIDTH ** -0.5),
        "norm_ffn": gain(ks[10], (DEPTH, D)),
        "peer_wq": nrm(ks[11], (DEPTH, D, PEER_HEADS * PEER_QUERY_DIM), D ** -0.5),
        "peer_keys": nrm(ks[12], (DEPTH, PEER_HEADS, 2, PEER_N_KEYS, PEER_HALF), PEER_HALF ** -0.5),
        "peer_u": nrm(ks[13], (DEPTH, PEER_N_EXPERTS, D), D ** -0.5),
        "peer_v": nrm(ks[14], (DEPTH, PEER_N_EXPERTS, D), PEER_TOPK ** -0.5),
        "shared_norm": gain(ks[15], (D,)),
        "shared_w_kv": nrm(ks[16], (D, 2 * DIL_QK_WIDTH), D ** -0.5),
        "final_norm": gain(ks[17], (D,)),
    }


def reference(x, mem, norm_mix, a_w_in, a_lambda, a_subln, b_w_in, norm_mem, w_mem_kv, w_out,
              norm_ffn, peer_wq, peer_keys, peer_u, peer_v, shared_norm, shared_w_kv, final_norm):
    B, S, D = x.shape
    M = mem.shape[1]
    n_dil = len(DIL_GROUPS) * DIL_HEADS
    cos, sin = rope_tables(S)
    shared_k = None
    shared_v = None
    for l in range(DEPTH):
        h = rmsnorm(x, norm_mix[l])
        mkv = (rmsnorm(mem, norm_mem[l]) @ w_mem_kv[l]).reshape(B, M, 2, MEM_HEADS, HEAD_DIM)
        if l < N_A_LAYERS:
            proj = h @ a_w_in[l]
            q, k, v, q_mem = jnp.split(
                proj, [DIFF_QK_WIDTH, 2 * DIFF_QK_WIDTH, 2 * DIFF_QK_WIDTH + DIFF_V_WIDTH], axis=-1)
            q = partial_rope(q.reshape(B, S, 2 * DIFF_HEADS, HEAD_DIM), cos, sin)
            k = partial_rope(k.reshape(B, S, 2 * DIFF_HEADS, HEAD_DIM), cos, sin)
            v = v.reshape(B, S, DIFF_HEADS, DIFF_V_DIM)
            lambda_init = 0.8 - 0.6 * math.exp(-0.3 * l)
            lp = a_lambda[l].astype(jnp.float32)
            lam = jnp.exp(jnp.sum(lp[0] * lp[1])) - jnp.exp(jnp.sum(lp[2] * lp[3])) + lambda_init
            mix = diff_attention(q, k, v, lam, a_subln[l], lambda_init)
        else:
            proj = h @ b_w_in[l - N_A_LAYERS]
            q_dil, q_mem = jnp.split(proj, [DIL_QK_WIDTH], axis=-1)
            q_dil = partial_rope(q_dil.reshape(B, S, n_dil, HEAD_DIM), cos, sin)
            mix = dilated_mixture(q_dil, shared_k, shared_v)
        mo = memory_attention(q_mem.reshape(B, S, MEM_HEADS, HEAD_DIM), mkv[:, :, 0], mkv[:, :, 1])
        x = x + jnp.concatenate([mix, mo], axis=-1) @ w_out[l]
        x = x + peer(rmsnorm(x, norm_ffn[l]), peer_wq[l], peer_keys[l], peer_u[l], peer_v[l])
        if l == N_A_LAYERS - 1:
            kv = (rmsnorm(x, shared_norm) @ shared_w_kv).reshape(B, S, 2, n_dil, HEAD_DIM)
            shared_k = partial_rope(kv[:, :, 0], cos, sin)
            shared_v = kv[:, :, 1]
    return rmsnorm(x, final_norm)
```

```cpp
#include <hip/hip_runtime.h>
#include <cstdio>
#include <cstdint>
#include <cmath>
namespace pg8 {
#define PG8_LAS __attribute__((address_space(3)))
typedef unsigned short bf16_t;
typedef short bf16x8 __attribute__((ext_vector_type(8)));
typedef float f32x4 __attribute__((ext_vector_type(4)));
typedef unsigned u32x4 __attribute__((ext_vector_type(4)));
constexpr int BM = 256, BK = 64, HALF = 128, HTB = HALF * BK * 2  , STAGE_BYTES = 8 * HTB, NXCD = 8, WGM = 8;

__host__ __device__ __forceinline__ int lds_byte(int r, int c) { const int st = (r >> 4) * 2 + (c >> 5), rr = r & 15, cc = c & 31, ob = rr * 64 + cc * 2; return st * 1024 + (ob ^ (((ob >> 9) & 1) << 5)); }
__host__ __device__ __forceinline__ void stage_rc(int b, int& R, int& C) { const int st = b / 1024, sb = b % 1024, swz = sb ^ (((sb >> 9) & 1) << 5); R = (st >> 1) * 16 + swz / 64; C = (st & 1) * 32 + (swz % 64) / 2; }
__host__ __device__ __forceinline__ int perm32(int rho) { const int n = rho >> 4, i = rho & 15; return 8 * (i >> 2) + 4 * n + (i & 3); }

struct Unit { int pm, pn; };
struct Gemm { const bf16_t* A; const bf16_t* Bt; int M, N, K; };

struct StaticOrder {
    int nM, nN, nwg, G, c;
    __host__ __device__ void init(int M, int N, int G_, int c_) { nM = M / BM; nN = N / BM; nwg = nM * nN; G = G_; c = c_; }
    __host__ __device__ bool next(int i, Unit& u) const {
        const long L = (long)i * G + c; if (L >= nwg) return false;
        int wgid = (int)L; { const int q = nwg / NXCD, r = nwg % NXCD, xcd = wgid % NXCD, off = wgid / NXCD; wgid = (xcd < r ? xcd * (q + 1) : r * (q + 1) + (xcd - r) * q) + off; }
        const int nig = WGM * nN, gid = wgid / nig, fm = gid * WGM, gsz = (nM - fm) < WGM ? (nM - fm) : WGM;
        u.pm = fm + ((wgid % nig) % gsz); u.pn = (wgid % nig) / gsz; return true;
    }
    __device__ __forceinline__ void a_ready(const Unit&) const {}
    __device__ __forceinline__ void done(const Unit&) const {}
};

__device__ __forceinline__ unsigned cvt_pk_bf16(float lo, float hi) { unsigned r; asm volatile("v_cvt_pk_bf16_f32 %0, %1, %2" : "=v"(r) : "v"(lo), "v"(hi)); return r; }
typedef float f32x2 __attribute__((ext_vector_type(2)));
__device__ __forceinline__ f32x2 gelu_pk(f32x2 v) {
    const f32x2 av = __builtin_elementwise_abs(v), d = av * 0.2316418882f + 1.0f;
    f32x2 t; t.x = __builtin_amdgcn_rcpf(d.x); t.y = __builtin_amdgcn_rcpf(d.y);
    f32x2 q = t * 0.5307027145f + (-0.7265760135f); q = q * t + 0.7107068705f; q = q * t + (-0.142248368f); q = q * t + 0.127414796f; q = q * t;
    const f32x2 s = (v * v) * (-0.72134752044f);
    f32x2 e; e.x = __builtin_amdgcn_exp2f(s.x); e.y = __builtin_amdgcn_exp2f(s.y);
    const f32x2 m = v * (q * e), r = v - m;
    f32x2 o; o.x = v.x < 0.f ? m.x : r.x; o.y = v.y < 0.f ? m.y : r.y; return o;
}


struct EpiProj {
    static constexpr bool PERM = true, AFTER_DRAIN = false;
    bf16_t* O; int ldc; const float* rope; int rope_lim, scale_lim, scale_tile; float sc;
    __device__ __forceinline__ void operator()(const f32x4 (&acc)[2][2][4][2], const Unit& u, int wr, int wc, int fr, int fq) const {
        const int row0 = u.pm * BM + wr * 64 + fr, col0 = u.pn * BM + wc * 32 + 8 * fq;
        const bool do_rope = (u.pn < rope_lim) && ((wc & 1) == 0);
        const float s = (u.pn < scale_lim || u.pn == scale_tile) ? sc : 1.f;
        const float sg = (fq == 0) ? -1.f : 1.f;
#pragma unroll
        for (int ai = 0; ai < 2; ++ai)
#pragma unroll
            for (int m = 0; m < 4; ++m) {
                const int row = row0 + ai * HALF + m * 16;
                f32x4 c0 = {1.f, 1.f, 1.f, 1.f}, c1 = c0, s0 = {0.f, 0.f, 0.f, 0.f}, s1 = s0;
                if (do_rope) { const f32x4* rp = (const f32x4*)(rope + (size_t)(row & 4095) * 16); c0 = rp[0]; c1 = rp[1]; s0 = rp[2]; s1 = rp[3]; }
                bf16_t* rowp = O + (size_t)row * ldc + col0;
#pragma unroll
                for (int bj = 0; bj < 2; ++bj) {
                    f32x4 v0 = acc[ai][bj][m][0], v1 = acc[ai][bj][m][1];
                    if (do_rope) {
                        f32x4 p0, p1;
#pragma unroll
                        for (int j = 0; j < 4; ++j) { p0[j] = __shfl_xor(v0[j], 16); p1[j] = __shfl_xor(v1[j], 16); }
                        if (fq < 2) { v0 = v0 * c0 + (p0 * s0) * sg; v1 = v1 * c1 + (p1 * s1) * sg; }
                    }
                    v0 = v0 * s; v1 = v1 * s;
                    u32x4 w; w.x = cvt_pk_bf16(v0[0], v0[1]); w.y = cvt_pk_bf16(v0[2], v0[3]); w.z = cvt_pk_bf16(v1[0], v1[1]); w.w = cvt_pk_bf16(v1[2], v1[3]);
                    *(u32x4*)(rowp + bj * HALF) = w;
                }
            }
    }
};
struct EpiRes {
    static constexpr bool PERM = true, AFTER_DRAIN = false;
    float* X; bf16_t* XB; float* SS; int ldc;
    __device__ __forceinline__ void operator()(const f32x4 (&acc)[2][2][4][2], const Unit& u, int wr, int wc, int fr, int fq) const {
        const int row0 = u.pm * BM + wr * 64 + fr, col0 = u.pn * BM + wc * 32 + 8 * fq;
#pragma unroll
        for (int ai = 0; ai < 2; ++ai)
#pragma unroll
            for (int m = 0; m < 4; ++m) {
                const int row = row0 + ai * HALF + m * 16;
                float q = 0.f;
#pragma unroll
                for (int bj = 0; bj < 2; ++bj) {
                    float* xp = X + (size_t)row * ldc + col0 + bj * HALF;
                    f32x4 x0 = *(const f32x4*)xp, x1 = *(const f32x4*)(xp + 4);
                    x0 = x0 + acc[ai][bj][m][0]; x1 = x1 + acc[ai][bj][m][1];
                    *(f32x4*)xp = x0; *(f32x4*)(xp + 4) = x1;
                    u32x4 w; w.x = cvt_pk_bf16(x0[0], x0[1]); w.y = cvt_pk_bf16(x0[2], x0[3]); w.z = cvt_pk_bf16(x1[0], x1[1]); w.w = cvt_pk_bf16(x1[2], x1[3]);
                    *(u32x4*)(XB + (size_t)row * ldc + col0 + bj * HALF) = w;
                    q += (x0[0] * x0[0] + x0[1] * x0[1]) + (x0[2] * x0[2] + x0[3] * x0[3]) + (x1[0] * x1[0] + x1[1] * x1[1]) + (x1[2] * x1[2] + x1[3] * x1[3]);
                }
                q += __shfl_xor(q, 16); q += __shfl_xor(q, 32);
                if (fq == 0) SS[(size_t)row * 16 + u.pn * 4 + wc] = q;
            }
    }
};
struct EpiScaleRow {
    static constexpr bool PERM = true, AFTER_DRAIN = false;
    bf16_t* O; int ldc; const float* SS; float eps;
    __device__ __forceinline__ void operator()(const f32x4 (&acc)[2][2][4][2], const Unit& u, int wr, int wc, int fr, int fq) const {
        const int row0 = u.pm * BM + wr * 64 + fr, col0 = u.pn * BM + wc * 32 + 8 * fq;
#pragma unroll
        for (int ai = 0; ai < 2; ++ai)
#pragma unroll
            for (int m = 0; m < 4; ++m) {
                const int row = row0 + ai * HALF + m * 16;
                const f32x4* sp = (const f32x4*)(SS + (size_t)row * 16);
                const f32x4 a = sp[0], b = sp[1], c = sp[2], d = sp[3];
                const float tot = (((a[0] + a[1]) + (a[2] + a[3])) + ((b[0] + b[1]) + (b[2] + b[3]))) + (((c[0] + c[1]) + (c[2] + c[3])) + ((d[0] + d[1]) + (d[2] + d[3])));
                const float rs = 1.0f / sqrtf(tot * (1.0f / 1024.0f) + eps);
                bf16_t* rowp = O + (size_t)row * ldc + col0;
#pragma unroll
                for (int bj = 0; bj < 2; ++bj) {
                    const f32x4 v0 = acc[ai][bj][m][0] * rs, v1 = acc[ai][bj][m][1] * rs;
                    u32x4 w; w.x = cvt_pk_bf16(v0[0], v0[1]); w.y = cvt_pk_bf16(v0[2], v0[3]); w.z = cvt_pk_bf16(v1[0], v1[1]); w.w = cvt_pk_bf16(v1[2], v1[3]);
                    *(u32x4*)(rowp + bj * HALF) = w;
                }
            }
    }
};

template <class Epi, class Sched, bool ALIGN_EPI = false, bool SP2 = false>
__device__ __forceinline__ void gemm_phase(PG8_LAS unsigned char* lds, const Gemm g, const Sched& S, const Epi& E) {
    int tid_ = threadIdx.x; asm volatile("" : "+v"(tid_));
    const int tid = tid_, wid = __builtin_amdgcn_readfirstlane(tid >> 6), lane = tid & 63, wr = wid >> 2, wc = wid & 3, fr = lane & 15, fq = lane >> 4;
    const int K = g.K, nt = K / BK;
    unsigned voffA[2], voffB[2];
#pragma unroll
    for (int i = 0; i < 2; ++i) { int R, C; stage_rc(tid * 16 + i * 8192, R, C); const int Rb = Epi::PERM ? ((R & ~31) + perm32(R & 31)) : R;
        voffA[i] = (unsigned)(R * K + C) * 2u; voffB[i] = (unsigned)(Rb * K + C) * 2u; }
    const size_t kstep = (size_t)(BK * 2);
    const size_t hstep = (size_t)HALF * K * 2;
    const size_t tstep = 2 * hstep;
    const unsigned ldsw = (unsigned)wid * 1024u;
    const int aoff = lds_byte(wr * 64 + fr, fq * 8), boff = lds_byte(wc * 32 + fr, fq * 8);
#define PG8_SA(b, h) (((b) * 2 + (h)) * HTB)
#define PG8_SB(b, h) ((4 + (b) * 2 + (h)) * HTB)
#define PG8_STAGE(bufoff, gbase, voff) do { _Pragma("unroll") for (int _i = 0; _i < 2; ++_i) \
        __builtin_amdgcn_global_load_lds((const unsigned*)((const char*)(gbase) + (voff)[_i]), (PG8_LAS unsigned*)(lds + (bufoff) + ldsw + _i * 8192), 16, 0, 0); } while (0)
#define PG8_LDA(dst, b, h) do { _Pragma("unroll") for (int m = 0; m < 4; ++m) _Pragma("unroll") for (int k = 0; k < 2; ++k) dst[m][k] = *(const PG8_LAS bf16x8*)(lds + PG8_SA(b, h) + aoff + m * 2048 + k * 1024); } while (0)
#define PG8_LDB(dst, b, h) do { _Pragma("unroll") for (int n = 0; n < 2; ++n) _Pragma("unroll") for (int k = 0; k < 2; ++k) dst[n][k] = *(const PG8_LAS bf16x8*)(lds + PG8_SB(b, h) + boff + n * 2048 + k * 1024); } while (0)
#define PG8_MMA(ai, bj, At, Bt) do { __builtin_amdgcn_s_setprio(1); _Pragma("unroll") for (int m = 0; m < 4; ++m) _Pragma("unroll") for (int n = 0; n < 2; ++n) _Pragma("unroll") for (int k = 0; k < 2; ++k) \
        acc[ai][bj][m][n] = __builtin_amdgcn_mfma_f32_16x16x32_bf16(Bt[n][k], At[m][k], acc[ai][bj][m][n], 0, 0, 0); __builtin_amdgcn_s_setprio(0); } while (0)
#define PG8_WAIT_V(n) asm volatile("s_waitcnt vmcnt(" #n ")" ::: "memory")
#define PG8_WAIT_L(n) asm volatile("s_waitcnt lgkmcnt(" #n ")" ::: "memory")
#define PG8_BAR __builtin_amdgcn_s_barrier()
#define PG8_SCHED __builtin_amdgcn_sched_barrier(0)
    Unit cur, nxt; int ui = 0;
    if (!S.next(0, cur)) return;
    f32x4 acc[2][2][4][2];
#pragma unroll
    for (int a = 0; a < 2; ++a)
#pragma unroll
        for (int b = 0; b < 2; ++b)
#pragma unroll
            for (int m = 0; m < 4; ++m)
#pragma unroll
                for (int n = 0; n < 2; ++n) acc[a][b][m][n] = (f32x4){0.f, 0.f, 0.f, 0.f};
    bf16x8 At[4][2], B0[2][2], B1[2][2];
    const char* cA = (const char*)g.A + (size_t)cur.pm * tstep; const char* cB = (const char*)g.Bt + (size_t)cur.pn * tstep;
    S.a_ready(cur);
    if constexpr (SP2) {
        PG8_STAGE(PG8_SB(0, 0), cB, voffB); PG8_STAGE(PG8_SB(0, 1), cB + hstep, voffB); PG8_STAGE(PG8_SA(0, 0), cA, voffA); PG8_STAGE(PG8_SA(0, 1), cA + hstep, voffA);
        if (wr == 1) PG8_BAR;
        PG8_WAIT_V(2); PG8_BAR;
        PG8_STAGE(PG8_SB(1, 0), cB + kstep, voffB); PG8_STAGE(PG8_SA(1, 0), cA + kstep, voffA); PG8_STAGE(PG8_SB(1, 1), cB + hstep + kstep, voffB);
        PG8_WAIT_V(6); PG8_BAR;
    } else {
        PG8_STAGE(PG8_SB(0, 0), cB, voffB); PG8_STAGE(PG8_SA(0, 0), cA, voffA); PG8_STAGE(PG8_SB(0, 1), cB + hstep, voffB); PG8_STAGE(PG8_SA(0, 1), cA + hstep, voffA);
        if (wr == 1) PG8_BAR;
        PG8_WAIT_V(4); PG8_BAR;
        PG8_STAGE(PG8_SB(1, 0), cB + kstep, voffB); PG8_STAGE(PG8_SA(1, 0), cA + kstep, voffA); PG8_STAGE(PG8_SB(1, 1), cB + hstep + kstep, voffB);
        PG8_WAIT_V(6); PG8_BAR;
    }
    for (;;) {
        const bool has_next = S.next(ui + 1, nxt);
        const char* nA = has_next ? (const char*)g.A + (size_t)nxt.pm * tstep : cA; const char* nB = has_next ? (const char*)g.Bt + (size_t)nxt.pn * tstep : cB;
        for (int t = 0; t < nt; t += 2) {
            const bool last = (t == nt - 2);
            const char* a1 = cA + (size_t)(t + 1) * kstep;
            const char* a2 = last ? nA : cA + (size_t)(t + 2) * kstep; const char* b2 = last ? nB : cB + (size_t)(t + 2) * kstep;
            const char* a3 = a2 + kstep; const char* b3 = b2 + kstep;
            if (last && has_next) S.a_ready(nxt);
            if constexpr (SP2) {
            PG8_LDB(B0, 0, 0); PG8_LDB(B1, 0, 1); PG8_SCHED; PG8_LDA(At, 0, 0); PG8_STAGE(PG8_SA(1, 1), a1 + hstep, voffA);
            PG8_WAIT_V(8); PG8_WAIT_L(0); PG8_BAR; PG8_MMA(0, 0, At, B0); PG8_MMA(0, 1, At, B1); PG8_BAR; PG8_SCHED;
            PG8_LDA(At, 0, 1); PG8_STAGE(PG8_SB(0, 0), b2, voffB); PG8_STAGE(PG8_SB(0, 1), b2 + hstep, voffB); PG8_STAGE(PG8_SA(0, 0), a2, voffA);
            PG8_WAIT_V(8); PG8_WAIT_L(0); PG8_BAR; PG8_MMA(1, 0, At, B0); PG8_MMA(1, 1, At, B1); PG8_BAR; PG8_SCHED;
            PG8_LDB(B0, 1, 0); PG8_LDB(B1, 1, 1); PG8_SCHED; PG8_LDA(At, 1, 0); PG8_STAGE(PG8_SA(0, 1), a2 + hstep, voffA);
            PG8_WAIT_V(8); PG8_WAIT_L(0); PG8_BAR; PG8_MMA(0, 0, At, B0); PG8_MMA(0, 1, At, B1); PG8_BAR; PG8_SCHED;
            PG8_LDA(At, 1, 1); PG8_STAGE(PG8_SB(1, 0), b3, voffB); PG8_STAGE(PG8_SB(1, 1), b3 + hstep, voffB); PG8_STAGE(PG8_SA(1, 0), a3, voffA);
            PG8_WAIT_V(8); PG8_WAIT_L(0); PG8_BAR; PG8_MMA(1, 0, At, B0); PG8_MMA(1, 1, At, B1); PG8_BAR; PG8_SCHED;
            } else {
            PG8_LDB(B0, 0, 0); PG8_SCHED; PG8_LDA(At, 0, 0); PG8_STAGE(PG8_SA(1, 1), a1 + hstep, voffA);
            PG8_WAIT_L(8); PG8_BAR; PG8_WAIT_L(0); PG8_MMA(0, 0, At, B0); PG8_BAR; PG8_SCHED;
            PG8_LDB(B1, 0, 1); PG8_STAGE(PG8_SB(0, 0), b2, voffB);
            PG8_BAR; PG8_WAIT_L(0); PG8_MMA(0, 1, At, B1); PG8_BAR;
            PG8_LDA(At, 0, 1); PG8_STAGE(PG8_SA(0, 0), a2, voffA);
            PG8_BAR; PG8_WAIT_L(0); PG8_MMA(1, 0, At, B0); PG8_BAR; PG8_SCHED;
            PG8_STAGE(PG8_SB(0, 1), b2 + hstep, voffB);
            PG8_WAIT_V(6); PG8_BAR; PG8_MMA(1, 1, At, B1); PG8_BAR;
            PG8_LDB(B0, 1, 0); PG8_SCHED; PG8_LDA(At, 1, 0); PG8_STAGE(PG8_SA(0, 1), a2 + hstep, voffA);
            PG8_WAIT_L(8); PG8_BAR; PG8_WAIT_L(0); PG8_MMA(0, 0, At, B0); PG8_BAR; PG8_SCHED;
            PG8_LDB(B1, 1, 1); PG8_STAGE(PG8_SB(1, 0), b3, voffB);
            PG8_BAR; PG8_WAIT_L(0); PG8_MMA(0, 1, At, B1); PG8_BAR;
            PG8_LDA(At, 1, 1); PG8_STAGE(PG8_SA(1, 0), a3, voffA);
            PG8_BAR; PG8_WAIT_L(0); PG8_MMA(1, 0, At, B0); PG8_BAR; PG8_SCHED;
            PG8_STAGE(PG8_SB(1, 1), b3 + hstep, voffB);
            PG8_WAIT_V(6); PG8_BAR; PG8_MMA(1, 1, At, B1); PG8_BAR;
            }
        }
        if constexpr (ALIGN_EPI) { if (wr == 0) PG8_BAR; }
        if constexpr (!Epi::AFTER_DRAIN) { E(acc, cur, wr, wc, fr, fq); S.done(cur); }
        if (!has_next) break;
#pragma unroll
        for (int a = 0; a < 2; ++a)
#pragma unroll
            for (int b = 0; b < 2; ++b)
#pragma unroll
                for (int m = 0; m < 4; ++m)
#pragma unroll
                    for (int n = 0; n < 2; ++n) acc[a][b][m][n] = (f32x4){0.f, 0.f, 0.f, 0.f};
        cur = nxt; cA = nA; cB = nB; ++ui;
        if constexpr (ALIGN_EPI) { if (wr == 1) PG8_BAR; }
    }
    PG8_WAIT_V(0);
    if constexpr (!ALIGN_EPI) { if (wr == 0) PG8_BAR; }
    PG8_BAR;
    if constexpr (Epi::AFTER_DRAIN) { E.fused(acc, cur, wr, wc, fr, fq, lds, wid, lane); S.done(cur); }
#undef PG8_SA
#undef PG8_SB
#undef PG8_STAGE
#undef PG8_LDA
#undef PG8_LDB
#undef PG8_MMA
#undef PG8_WAIT_V
#undef PG8_WAIT_L
#undef PG8_BAR
#undef PG8_SCHED
}
}
#define GAS __attribute__((address_space(1)))
#define LAS __attribute__((address_space(3)))
typedef unsigned short bf16;
typedef unsigned v4u __attribute__((ext_vector_type(4)));
typedef float f32x4 __attribute__((ext_vector_type(4)));
typedef short bf16x8 __attribute__((ext_vector_type(8)));
typedef GAS unsigned gu32;
typedef GAS unsigned long long gu64;
#define RLX_AGENT __ATOMIC_RELAXED, __HIP_MEMORY_SCOPE_AGENT
#define LDS_WAIT() asm volatile("s_waitcnt lgkmcnt(0)" ::: "memory")
#define VM_WAIT() asm volatile("s_waitcnt vmcnt(0)" ::: "memory")
__device__ __forceinline__ unsigned long long rt() { return __builtin_amdgcn_s_memrealtime(); }
__device__ __forceinline__ unsigned f2bf(float f) { unsigned u = __builtin_bit_cast(unsigned, f); return (u + 0x7fffu + ((u >> 16) & 1u)) >> 16; }
__device__ __forceinline__ unsigned pk2(float lo, float hi) { return f2bf(lo) | (f2bf(hi) << 16); }

namespace att {
typedef __attribute__((address_space(3))) const char* lds_cptr;
typedef __attribute__((address_space(3))) char* lds_ptr;
typedef __attribute__((address_space(3))) float* lds_fptr;
using s16x4 = __attribute__((ext_vector_type(4))) short;
using f32x16 = __attribute__((ext_vector_type(16))) float;
using u32x4 = __attribute__((ext_vector_type(4))) unsigned;
typedef short v4i16_t __attribute__((ext_vector_type(4)));
typedef float f32x2_t __attribute__((ext_vector_type(2))); typedef __bf16 bf16x2_t __attribute__((ext_vector_type(2)));
constexpr float C2 = 0.125f * 1.4426950408889634f;
__device__ __forceinline__ int crow(int r, int hi) { return (r & 3) + 8 * (r >> 2) + 4 * hi; }
__device__ __forceinline__ unsigned cvtpk_s(float lo, float hi) { f32x2_t v = {lo, hi}; bf16x2_t b = __builtin_convertvector(v, bf16x2_t); return __builtin_bit_cast(unsigned, b); }
__device__ __forceinline__ void glds16(const void* gsrc, unsigned lds_dst) { unsigned keep;
    asm volatile("s_mov_b32 %0, m0\n\ts_mov_b32 m0, %2\n\ts_nop 0\n\tglobal_load_lds_dwordx4 %1, off\n\ts_mov_b32 m0, %0" : "=&s"(keep) : "v"(gsrc), "s"(lds_dst) : "memory"); }
#define ATT_WAITV(N) asm volatile("s_waitcnt vmcnt(" #N ")" ::: "memory")
#define ATT_WAITL() asm volatile("s_waitcnt lgkmcnt(0)" ::: "memory")
#define ATT_BAR() asm volatile("s_waitcnt lgkmcnt(0)\n\ts_barrier" ::: "memory")
__device__ __forceinline__ s16x4 vtr(lds_cptr p) { return __builtin_bit_cast(s16x4, __builtin_amdgcn_ds_read_tr16_b64_v4i16((__attribute__((address_space(3))) v4i16_t*)p)); }

__device__ __forceinline__ void qkt(f32x16& p0, f32x16& p1, lds_cptr kslot, const bf16x8* qr, int r32, int hi) {
    lds_cptr kb = kslot + hi * 1024 + r32 * 16;
    const f32x16 z = {};
#pragma unroll
    for (int d0 = 0; d0 < 4; ++d0) {
        const bf16x8 b0 = *(const __attribute__((address_space(3))) bf16x8*)(kb + d0 * 2048);
        const bf16x8 b1 = *(const __attribute__((address_space(3))) bf16x8*)(kb + d0 * 2048 + 512);
        if (d0 == 0) { p0 = __builtin_amdgcn_mfma_f32_32x32x16_bf16(b0, qr[0], z, 0, 0, 0); p1 = __builtin_amdgcn_mfma_f32_32x32x16_bf16(b1, qr[0], z, 0, 0, 0); }
        else { p0 = __builtin_amdgcn_mfma_f32_32x32x16_bf16(b0, qr[d0], p0, 0, 0, 0); p1 = __builtin_amdgcn_mfma_f32_32x32x16_bf16(b1, qr[d0], p1, 0, 0, 0); }
    }
}
__device__ __forceinline__ float rowmax(const f32x16& p0, const f32x16& p1) {
    float a = __builtin_fmaxf(p0[0], p1[0]), b = __builtin_fmaxf(p0[1], p1[1]);
#pragma unroll
    for (int r = 2; r < 16; r += 2) { a = __builtin_fmaxf(a, __builtin_fmaxf(p0[r], p1[r])); b = __builtin_fmaxf(b, __builtin_fmaxf(p0[r + 1], p1[r + 1])); }
    const float m = __builtin_fmaxf(a, b);
    auto rr = __builtin_amdgcn_permlane32_swap(__float_as_uint(m), __float_as_uint(m), false, false);
    return __builtin_fmaxf(__uint_as_float(rr[0]), __uint_as_float(rr[1]));
}
__device__ __forceinline__ float halfsum(float v) {
    auto rr = __builtin_amdgcn_permlane32_swap(__float_as_uint(v), __float_as_uint(v), false, false);
    return __uint_as_float(rr[0]) + __uint_as_float(rr[1]);
}
__device__ __forceinline__ int vlane_off(int lane) { const int hi = lane >> 5; return ((lane >> 4) & 1) * 32 + (lane & 3) * 8 + (4 * hi + ((lane & 15) >> 2)) * 64; }

template <int NDB>
__device__ __forceinline__ void softmax_pv(f32x16& p0, f32x16& p1, float& m_run, float& l_run, f32x16 (&o)[NDB], lds_cptr vp, lds_fptr wsf, int r32, int hi) {
    const float rm = rowmax(p0, p1);
    const float m_new = __builtin_fmaxf(m_run, rm);
    if (__any(m_new > m_run)) {
        const float alpha = __builtin_amdgcn_exp2f(m_run - m_new);
        l_run *= alpha;
        if (hi == 0) wsf[r32] = alpha;
        m_run = m_new;
        ATT_WAITL();
#pragma unroll
        for (int g = 0; g < 4; ++g) {
            const f32x4 a4 = *(const __attribute__((address_space(3))) f32x4*)(wsf + 8 * g + 4 * hi);
#pragma unroll
            for (int d = 0; d < NDB; ++d) { o[d][4 * g + 0] *= a4[0]; o[d][4 * g + 1] *= a4[1]; o[d][4 * g + 2] *= a4[2]; o[d][4 * g + 3] *= a4[3]; }
        }
    }
    float s = 0.f;
#pragma unroll
    for (int r = 0; r < 16; ++r) { p0[r] = __builtin_amdgcn_exp2f(p0[r] - m_run); p1[r] = __builtin_amdgcn_exp2f(p1[r] - m_run); s += p0[r] + p1[r]; }
    l_run += s;
    u32x4 pw[4];
#pragma unroll
    for (int k = 0; k < 2; ++k) { pw[k] = (u32x4){cvtpk_s(p0[8 * k], p0[8 * k + 1]), cvtpk_s(p0[8 * k + 2], p0[8 * k + 3]), cvtpk_s(p0[8 * k + 4], p0[8 * k + 5]), cvtpk_s(p0[8 * k + 6], p0[8 * k + 7])};
        pw[2 + k] = (u32x4){cvtpk_s(p1[8 * k], p1[8 * k + 1]), cvtpk_s(p1[8 * k + 2], p1[8 * k + 3]), cvtpk_s(p1[8 * k + 4], p1[8 * k + 5]), cvtpk_s(p1[8 * k + 6], p1[8 * k + 7])}; }
#pragma unroll
    for (int d0 = 0; d0 < NDB; ++d0)
#pragma unroll
        for (int ks = 0; ks < 4; ++ks) {
            const s16x4 lo = vtr(vp + d0 * 4096 + ks * 1024), hh = vtr(vp + d0 * 4096 + ks * 1024 + 512);
            const bf16x8 vb = (bf16x8){lo[0], lo[1], lo[2], lo[3], hh[0], hh[1], hh[2], hh[3]};
            o[d0] = __builtin_amdgcn_mfma_f32_32x32x16_bf16(__builtin_bit_cast(bf16x8, pw[ks]), vb, o[d0], 0, 0, 0);
        }
}
template <int NDB>
__device__ __forceinline__ float finish_o(float l_run, f32x16 (&o)[NDB], lds_fptr wsf, int r32, int hi) {
    const float l = halfsum(l_run);
    if (hi == 0) wsf[32 + r32] = 1.0f / l;
    ATT_WAITL();
#pragma unroll
    for (int g = 0; g < 4; ++g) {
        const f32x4 a4 = *(const __attribute__((address_space(3))) f32x4*)(wsf + 32 + 8 * g + 4 * hi);
#pragma unroll
        for (int d = 0; d < NDB; ++d) { o[d][4 * g + 0] *= a4[0]; o[d][4 * g + 1] *= a4[1]; o[d][4 * g + 2] *= a4[2]; o[d][4 * g + 3] *= a4[3]; }
    }
    return l;
}
}

constexpr int NWAVES = 8;
constexpr int NB = 8, SEQ = 4096, DM = 1024, TT = NB * SEQ;
constexpr int MEMT = 256, MEMROWS = NB * MEMT;
constexpr int INW = 2560, SKVW = 4608, PQW = 2048, MKVW = 512;
constexpr int NEXP = 16384;
constexpr float EPS = 1e-5f;
constexpr int NPHASE = 21;

constexpr size_t MiB = 1u << 20;
constexpr size_t WS_CTL = 0, CTL_ZERO_BYTES = 1 * MiB;
constexpr size_t WS_WA = 1 * MiB, WS_WB = 11 * MiB, WS_WMKV = 21 * MiB, WS_WOUT = 25 * MiB, WS_WPQ = 33 * MiB, WS_WSKV = 49 * MiB, WS_PKEYS = 58 * MiB, WS_ROPE = 60 * MiB, WS_SS = 61 * MiB, WS_MEMKV = 63 * MiB;
constexpr size_t WS_PU = 96 * MiB, WS_PV = 224 * MiB;
constexpr size_t WS_XN = 352 * MiB, WS_XB = 416 * MiB, WS_PROJ = 480 * MiB, WS_MIX = 640 * MiB, WS_SKV = 704 * MiB, WS_END = 992 * MiB;
constexpr size_t WS_MEMN = WS_SKV;
constexpr size_t WS_OG = WS_XN;
constexpr size_t OG_PER_CU = 3 * 512 * 64 * 2 + 3 * 512 * 4;
static_assert(OG_PER_CU * 256 <= 128 * MiB, "OG scratch");
constexpr int CW_BAR = 4096;

constexpr int RING_OFF = 0, RING_BYTES = 131072;
constexpr int LDSCTL_OFF = RING_BYTES, MISC_OFF = LDSCTL_OFF + 320;
constexpr int PEER_SCR = LDSCTL_OFF + 1024;
constexpr int LDS_BYTES = 163840;
static_assert(PEER_SCR + 8 * 2048 <= LDS_BYTES, "LDS map");

#define XB_TMO      128
#define XB_XCNT(j)  (256  + 64 * (j))
#define XB_XSUB(j)  (1280 + 64 * (j))
#define XB_XGEN(j)  (2304 + 64 * (j))
#define XB_TOP      3328
#define XB_TOPGEN   3392
#define XCD_BAR_WORDS 3456
#define XB_SPIN_CAP (1u << 18)

__device__ __forceinline__ unsigned xb_ld(unsigned* p)              { return __hip_atomic_load(p, __ATOMIC_RELAXED, __HIP_MEMORY_SCOPE_AGENT); }
__device__ __forceinline__ unsigned xb_add(unsigned* p, unsigned v) { return __hip_atomic_fetch_add(p, v, __ATOMIC_RELAXED, __HIP_MEMORY_SCOPE_AGENT); }
__device__ __forceinline__ unsigned xb_xcc_id() { return (unsigned)__builtin_amdgcn_s_getreg((3 << 11) | 20) & 0xFu; }
#define XB_SPIN(cond, bar) do { unsigned _sp = 0; while (cond) { __builtin_amdgcn_s_sleep(1); \
    if ((++_sp & 255u) == 0u) { if (xb_ld(&(bar)[XB_TMO])) break; if (_sp > XB_SPIN_CAP) { atomicAdd(&(bar)[XB_TMO], 1u); break; } } } } while (0)

struct XcdBarrier {
    unsigned* bar; unsigned x;
    volatile LAS unsigned* st;
};

__device__ __forceinline__ XcdBarrier xcd_barrier_post(unsigned* bar, volatile LAS unsigned* st) {
    XcdBarrier b; b.bar = bar; b.x = xb_xcc_id(); b.st = st;
    if (threadIdx.x == 0) (void)xb_add(&bar[XB_XCNT(b.x)], 1u);
    return b;
}
__device__ __forceinline__ void xcd_barrier_complete(unsigned* bar, unsigned x, unsigned& nloc, unsigned& nx) {
    const unsigned G = gridDim.x * gridDim.y * gridDim.z;
    unsigned sum, cnt, mine, sp = 0u;
    for (;;) {
        sum = 0u; cnt = 0u; mine = 0u;
#pragma unroll
        for (unsigned j = 0; j < 16; ++j) { const unsigned c = xb_ld(&bar[XB_XCNT(j)]); sum += c; cnt += (c > 0u) ? 1u : 0u; mine = (j == x) ? c : mine; }
        if (sum == G) break;
        __builtin_amdgcn_s_sleep(1);
        if ((++sp & 255u) == 0u) { if (xb_ld(&bar[XB_TMO])) break; if (sp > XB_SPIN_CAP) { atomicAdd(&bar[XB_TMO], 1u); break; } }
    }
    nloc = mine > 0u ? mine : 1u; nx = cnt > 0u ? cnt : 1u;
}

__device__ __forceinline__ void xcd_barrier(const XcdBarrier& b) {
    asm volatile("s_waitcnt vmcnt(0)" ::: "memory");
    __syncthreads();
    if (threadIdx.x == 0) {
        unsigned* bar = b.bar;
        __builtin_amdgcn_s_waitcnt(0);
        unsigned nloc = b.st[0], nx = b.st[1];
        if (nloc == 0u) { xcd_barrier_complete(bar, b.x, nloc, nx); b.st[0] = nloc; b.st[1] = nx; }
        const unsigned old = xb_add(&bar[XB_XSUB(b.x)], 1u);
        const unsigned gen = old / nloc;
        if (old + 1u == (gen + 1u) * nloc) {
            __builtin_amdgcn_fence(__ATOMIC_RELEASE, "agent");
            asm volatile("s_waitcnt vmcnt(0)" ::: "memory");
            const unsigned og = xb_add(&bar[XB_TOP], 1u);
            const unsigned tg = og / nx;
            if (og + 1u == (tg + 1u) * nx) xb_add(&bar[XB_TOPGEN], 1u);
            else XB_SPIN(xb_ld(&bar[XB_TOPGEN]) == tg, bar);
            __builtin_amdgcn_fence(__ATOMIC_ACQUIRE, "agent");
            xb_add(&bar[XB_XGEN(b.x)], 1u);
            asm volatile("s_waitcnt vmcnt(0)" ::: "memory");
        } else {
            XB_SPIN(xb_ld(&bar[XB_XGEN(b.x)]) == gen, bar);
            __builtin_amdgcn_fence(__ATOMIC_ACQUIRE, "agent");
            asm volatile("s_waitcnt vmcnt(0)" ::: "memory");
        }
    }
    __syncthreads();
}

struct Frame {
    LAS unsigned char* lds;
    volatile LAS unsigned* MISC;
    int tid, lane, wave, vcu, G, bx;
    const unsigned char __attribute__((address_space(4)))* ka;
};
__device__ __forceinline__ Frame make_frame() {
    extern __shared__ __attribute__((aligned(16))) unsigned char lds_dyn_[];
    Frame F; int tid = threadIdx.x, bx = blockIdx.x, G = gridDim.x;
    asm volatile("" : "+v"(tid)); asm volatile("" : "+s"(bx), "+s"(G));
    F.lds = (LAS unsigned char*)lds_dyn_; F.MISC = (volatile LAS unsigned*)(F.lds + MISC_OFF);
    F.tid = tid; F.lane = tid & 63; F.wave = __builtin_amdgcn_readfirstlane(tid >> 6);
    F.G = G; F.vcu = (G % 8 == 0) ? (bx % 8) * (G / 8) + bx / 8 : bx; F.bx = bx;
    F.ka = (const unsigned char __attribute__((address_space(4)))*)__builtin_amdgcn_kernarg_segment_ptr();
    return F;
}
__device__ __forceinline__ const unsigned char __attribute__((address_space(4)))* ka_fresh(const Frame& F) { const unsigned char __attribute__((address_space(4)))* p = F.ka; asm volatile("" : "+s"(p)); return p; }
#define KA_IN(kp, i) (*(const float* const __attribute__((address_space(4)))*)((kp) + 8 * (i)))
#define KA_OUT(kp) (*(float* const __attribute__((address_space(4)))*)((kp) + 144))
#define KA_WS(kp) (*(unsigned char* const __attribute__((address_space(4)))*)((kp) + 152))
#define WSP(T, off) ((T*)(ws_ + (off)))
__device__ __forceinline__ float wave_sum(float v) {
#pragma unroll
    for (int o = 1; o < 64; o <<= 1) v += __shfl_xor(v, o);
    return v;
}
__device__ __forceinline__ unsigned cvtpk(float lo, float hi) { return att::cvtpk_s(lo, hi); }

__device__ __forceinline__ void p0_transpose_item(const float* W, int K, int N, bf16* WT, const float* gain, LAS float* scr, int item, int lane) {
    const int nblk = N / 32, kb = item / nblk, nb = item % nblk, k0 = 64 * kb, n0 = 32 * nb;
#pragma unroll 8
    for (int i = 0; i < 32; ++i) { const int kk = 2 * i + (lane >> 5); float w = W[(size_t)(k0 + kk) * N + n0 + (lane & 31)]; if (gain) w *= gain[k0 + kk]; scr[kk * 33 + (lane & 31)] = w; }
    LDS_WAIT(); asm volatile("" ::: "memory");
    const int c = lane & 7;
#pragma unroll
    for (int j = 0; j < 4; ++j) { const int n = (lane >> 3) + 8 * j; const LAS float* s = scr + (8 * c) * 33 + n;
        v4u o; o.x = cvtpk(s[0 * 33], s[1 * 33]); o.y = cvtpk(s[2 * 33], s[3 * 33]); o.z = cvtpk(s[4 * 33], s[5 * 33]); o.w = cvtpk(s[6 * 33], s[7 * 33]);
        *(GAS v4u*)(WT + (size_t)(n0 + n) * K + k0 + 8 * c) = o; }
    LDS_WAIT(); asm volatile("" ::: "memory");
}
__device__ __forceinline__ void cvt_row(const float* src, bf16* dst, int lane) {
    const GAS f32x4* s = (const GAS f32x4*)src + lane; GAS unsigned long long* d = (GAS unsigned long long*)dst + lane;
    f32x4 v[4];
#pragma unroll
    for (int j = 0; j < 4; ++j) v[j] = s[64 * j];
#pragma unroll
    for (int j = 0; j < 4; ++j) d[64 * j] = (unsigned long long)cvtpk(v[j].x, v[j].y) | ((unsigned long long)cvtpk(v[j].z, v[j].w) << 32);
}
__device__ __forceinline__ void rms_row(const float* xrow, const float* g, bf16* orow, float* cp, int lane) {
    const GAS f32x4* xr = (const GAS f32x4*)xrow + lane; const GAS f32x4* gr = (const GAS f32x4*)g + lane;
    f32x4 v[4]; float s = 0.f;
#pragma unroll
    for (int j = 0; j < 4; ++j) { v[j] = xr[64 * j]; s += (v[j].x * v[j].x + v[j].y * v[j].y) + (v[j].z * v[j].z + v[j].w * v[j].w); }
    if (cp) { GAS f32x4* c = (GAS f32x4*)cp + lane;
#pragma unroll
        for (int j = 0; j < 4; ++j) c[64 * j] = v[j]; }
    const float rstd = 1.0f / sqrtf(wave_sum(s) * (1.f / DM) + EPS);
    GAS unsigned long long* o8 = (GAS unsigned long long*)orow + lane;
#pragma unroll
    for (int j = 0; j < 4; ++j) { const f32x4 gg = gr[64 * j]; o8[64 * j] = (unsigned long long)cvtpk(v[j].x * rstd * gg.x, v[j].y * rstd * gg.y) | ((unsigned long long)cvtpk(v[j].z * rstd * gg.z, v[j].w * rstd * gg.w) << 32); }
}
__device__ __forceinline__ void p0_prologue(Frame& F) {
    const auto kp_ = ka_fresh(F); unsigned char* const ws_ = KA_WS(kp_); float* const out_ = KA_OUT(kp_);
#define FIN(i) KA_IN(kp_, i)
    LAS float* scr = (LAS float*)(F.lds + RING_OFF + F.wave * 16384);
    const int gw = F.vcu * NWAVES + F.wave, NGW = F.G * NWAVES, lane = F.lane;
    constexpr int I_IN = 16 * (INW / 32), I_MKV = 16 * (MKVW / 32), I_OUT = 16 * (DM / 32), I_PQ = 16 * (PQW / 32), I_SKV = 16 * (SKVW / 32);
    constexpr int E0 = 2 * I_IN, E1 = E0 + 2 * I_IN, E2 = E1 + 4 * I_MKV, E3 = E2 + 4 * I_OUT, E4 = E3 + 4 * I_PQ, E5 = E4 + I_SKV;
    for (int it = gw; it < E5; it += NGW) {
        if (it < E0) { const int l = it / I_IN, r = it % I_IN; p0_transpose_item(FIN(3) + (size_t)l * DM * INW, DM, INW, WSP(bf16, WS_WA) + (size_t)l * INW * DM, nullptr, scr, r, lane); }
        else if (it < E1) { const int q = it - E0, l = q / I_IN, r = q % I_IN; p0_transpose_item(FIN(6) + (size_t)l * DM * INW, DM, INW, WSP(bf16, WS_WB) + (size_t)l * INW * DM, nullptr, scr, r, lane); }
        else if (it < E2) { const int q = it - E1, l = q / I_MKV, r = q % I_MKV; p0_transpose_item(FIN(8) + (size_t)l * DM * MKVW, DM, MKVW, WSP(bf16, WS_WMKV) + (size_t)l * MKVW * DM, nullptr, scr, r, lane); }
        else if (it < E3) { const int q = it - E2, l = q / I_OUT, r = q % I_OUT; p0_transpose_item(FIN(9) + (size_t)l * DM * DM, DM, DM, WSP(bf16, WS_WOUT) + (size_t)l * DM * DM, nullptr, scr, r, lane); }
        else if (it < E4) { const int q = it - E3, l = q / I_PQ, r = q % I_PQ; p0_transpose_item(FIN(11) + (size_t)l * DM * PQW, DM, PQW, WSP(bf16, WS_WPQ) + (size_t)l * PQW * DM, FIN(10) + l * DM, scr, r, lane); }
        else { const int r = it - E4; p0_transpose_item(FIN(16), DM, SKVW, WSP(bf16, WS_WSKV), nullptr, scr, r, lane); }
    }
    for (int r = gw; r < 4 * NEXP; r += NGW) { cvt_row(FIN(13) + (size_t)r * DM, WSP(bf16, WS_PU) + (size_t)r * DM, lane); cvt_row(FIN(14) + (size_t)r * DM, WSP(bf16, WS_PV) + (size_t)r * DM, lane); }
    for (int r = gw; r < 1024; r += NGW) cvt_row(FIN(12) + (size_t)r * 1024, WSP(bf16, WS_PKEYS) + (size_t)r * 1024, lane);
    for (int e = gw * 64 + lane; e < SEQ * 8; e += NGW * 64) { const int t = e >> 3, i = e & 7;
        const double ang = (double)t * pow(500000.0, -(double)i / 8.0);
        WSP(float, WS_ROPE)[t * 16 + i] = (float)cos(ang); WSP(float, WS_ROPE)[t * 16 + 8 + i] = (float)sin(ang); }
    for (int r = gw; r < 4 * MEMROWS; r += NGW) { const int l = r / MEMROWS, m = r % MEMROWS; rms_row(FIN(1) + (size_t)m * DM, FIN(7) + l * DM, WSP(bf16, WS_MEMN) + (size_t)r * DM, nullptr, lane); }
    for (int m = gw; m < TT; m += NGW) rms_row(FIN(0) + (size_t)m * DM, FIN(2), WSP(bf16, WS_XN) + (size_t)m * DM, out_ + (size_t)m * DM, lane);
}
#undef FIN

__device__ __forceinline__ void diff_unit(Frame& F, int b, int h, int ib, const bf16* PROJ, bf16* MIX, float lam, float oml, const float* subg) {
    using namespace att;
    const int lane = F.lane, r32 = lane & 31, hi = lane >> 5, w = F.wave, p = w >> 2, wq = w & 3;
    const lds_cptr L = (lds_cptr)(F.lds + RING_OFF);
    const unsigned lds0 = (unsigned)(uintptr_t)(F.lds + RING_OFF);
    lds_fptr wsf = (lds_fptr)(F.lds + RING_OFF + 65536 + w * 256);
    const size_t rb = (size_t)b * SEQ;
    const bf16* Qw = PROJ + (rb + 128 * ib + 32 * wq + r32) * INW + (2 * h + p) * 64;
    const bf16* Kg = PROJ + rb * INW + 768 + (2 * h) * 64;
    const bf16* Vg = PROJ + rb * INW + 1536 + h * 128;
    const int NT = 2 * (ib + 1);
    const bf16* ksrc0 = Kg + (size_t)lane * INW + w * 8;
    const bf16* ksrc1 = ksrc0 + 64;
    const int pc0 = 2 * w, pc1 = 2 * w + 1;
    const bf16* vsrc0 = Vg + (size_t)(16 * (pc0 & 3) + (lane >> 2)) * INW + (pc0 >> 2) * 32 + (lane & 3) * 8;
    const bf16* vsrc1 = Vg + (size_t)(16 * (pc1 & 3) + (lane >> 2)) * INW + (pc1 >> 2) * 32 + (lane & 3) * 8;
#define DIFF_ISSUE(t, slot) do { const size_t go_ = (size_t)(t) * 64 * INW; const unsigned sb_ = lds0 + (slot) * 32768; \
        glds16(ksrc0 + go_, (unsigned)__builtin_amdgcn_readfirstlane(sb_ + w * 1024)); glds16(ksrc1 + go_, (unsigned)__builtin_amdgcn_readfirstlane(sb_ + 8192 + w * 1024)); \
        glds16(vsrc0 + go_, (unsigned)__builtin_amdgcn_readfirstlane(sb_ + 16384 + pc0 * 1024)); glds16(vsrc1 + go_, (unsigned)__builtin_amdgcn_readfirstlane(sb_ + 16384 + pc1 * 1024)); } while (0)
    DIFF_ISSUE(0, 0);
    bf16x8 qr[4];
#pragma unroll
    for (int d0 = 0; d0 < 4; ++d0) qr[d0] = *(const bf16x8*)(Qw + d0 * 16 + hi * 8);
    float m_run = -1e30f, l_run = 0.f; f32x16 o[4];
#pragma unroll
    for (int d = 0; d < 4; ++d) o[d] = f32x16{};
    const int qrel = 32 * wq + r32, voff = vlane_off(lane);
    for (int t = 0; t < NT; ++t) {
        ATT_WAITV(0); ATT_BAR();
        if (t + 1 < NT) DIFF_ISSUE(t + 1, (t + 1) & 1);
        const lds_cptr S = L + (t & 1) * 32768;
        f32x16 p0, p1;
        qkt(p0, p1, S + p * 8192, qr, r32, hi);
        const int jb = t - (NT - 2);
        if (jb >= 0) { const int kb = 64 * jb + 4 * hi;
#pragma unroll
            for (int r = 0; r < 16; ++r) { const int kv = kb + (r & 3) + 8 * (r >> 2); if (kv > qrel) p0[r] = -INFINITY; if (kv + 32 > qrel) p1[r] = -INFINITY; } }
        softmax_pv<4>(p0, p1, m_run, l_run, o, S + 16384 + voff, wsf, r32, hi);
    }
#undef DIFF_ISSUE
    finish_o<4>(l_run, o, wsf, r32, hi);
    ATT_BAR();
    lds_fptr X = (lds_fptr)(F.lds + RING_OFF) + wq * 4096;
    if (p == 1) {
#pragma unroll
        for (int d = 0; d < 4; ++d)
#pragma unroll
            for (int r = 0; r < 16; ++r) X[(d * 16 + r) * 64 + lane] = o[d][r];
    }
    ATT_BAR();
    if (p == 0) {
        float ss[16];
#pragma unroll
        for (int r = 0; r < 16; ++r) ss[r] = 0.f;
#pragma unroll
        for (int d = 0; d < 4; ++d)
#pragma unroll
            for (int r = 0; r < 16; ++r) { const float v = o[d][r] - lam * X[(d * 16 + r) * 64 + lane]; o[d][r] = v; ss[r] += v * v; }
#pragma unroll
        for (int r = 0; r < 16; ++r) {
            float s = ss[r];
            s += __shfl_xor(s, 1); s += __shfl_xor(s, 2); s += __shfl_xor(s, 4); s += __shfl_xor(s, 8); s += __shfl_xor(s, 16);
            ss[r] = oml / sqrtf(s * (1.f / 128.f) + EPS);
        }
        LAS unsigned short* stg = (LAS unsigned short*)(F.lds + RING_OFF + 67584 + wq * 8192);
#pragma unroll
        for (int d = 0; d < 4; ++d) { const float g = subg[32 * d + r32];
#pragma unroll
            for (int r = 0; r < 16; ++r) { const unsigned short hb = (unsigned short)(cvtpk(o[d][r] * ss[r] * g, 0.f) & 0xffffu); stg[crow(r, hi) * 128 + 32 * d + r32] = hb; } }
        ATT_WAITL();
        bf16* Ow = MIX + (rb + 128 * ib + 32 * wq) * DM + h * 128;
#pragma unroll
        for (int i = 0; i < 8; ++i) { const int idx = i * 64 + lane, row = idx >> 4, ch = idx & 15;
            const u32x4 v = *(const LAS u32x4*)(stg + row * 128 + ch * 8); *(u32x4*)(Ow + (size_t)row * DM + ch * 8) = v; }
    }
    ATT_BAR();
}

constexpr int WP_STRIDE = 16384;
struct MemMap {
    int base;
    __device__ __forceinline__ int nt() const { return 4; }
    __device__ __forceinline__ int first() const { return 0; }
    __device__ __forceinline__ int krow(int tt, int j) const { return base + 64 * tt + j; }
    __device__ __forceinline__ void mask(int, att::f32x16&, att::f32x16&, int, int) const {}
};
struct DilMap {
    int rowbase, d, res, m0, ks, Lm1;
    __device__ __forceinline__ int nt() const { return 3; }
    __device__ __forceinline__ int first() const { return ks + 64 <= 0 ? (ks + 128 <= 0 ? 2 : 1) : 0; }
    __device__ __forceinline__ int krow(int tt, int j) const { int mp = ks + 64 * tt + j; mp = mp < 0 ? 0 : (mp > Lm1 ? Lm1 : mp); return rowbase + mp * d + res; }
    __device__ __forceinline__ void mask(int tt, att::f32x16& p0, att::f32x16& p1, int r32, int hi) const {
        const int m = m0 + r32, kb = ks + 64 * tt + 4 * hi;
#pragma unroll
        for (int r = 0; r < 16; ++r) { const int mp = kb + (r & 3) + 8 * (r >> 2);
            if (mp < 0 || mp > m || mp < m - 128) p0[r] = -INFINITY;
            if (mp + 32 < 0 || mp + 32 > m || mp + 32 < m - 128) p1[r] = -INFINITY; }
    }
};
template <class KM>
__device__ __forceinline__ void win_attn(Frame& F, const KM& km, const bf16* qp, const bf16* Kg, int pitchK, const bf16* Vg, int pitchV, att::f32x16 (&o)[2], float& m_out, float& l_out) {
    using namespace att;
    const int lane = F.lane, r32 = lane & 31, hi = lane >> 5, w = F.wave;
    const unsigned kdst = (unsigned)(uintptr_t)(F.lds + RING_OFF + w * WP_STRIDE), vdst = kdst + 8192;
    const lds_cptr Ks = (lds_cptr)(F.lds + RING_OFF + w * WP_STRIDE), Vs = Ks + 8192;
    lds_fptr wsf = (lds_fptr)(F.lds + PEER_SCR + w * 256);
    bf16x8 qr[4];
#pragma unroll
    for (int d0 = 0; d0 < 4; ++d0) qr[d0] = *(const bf16x8*)(qp + d0 * 16 + hi * 8);
    float m_run = -1e30f, l_run = 0.f;
    o[0] = f32x16{}; o[1] = f32x16{};
    const int voff = vlane_off(lane);
#define WP_ISSUE_K(tt) do { const bf16* s_ = Kg + (size_t)km.krow(tt, lane) * pitchK; _Pragma("unroll") for (int c = 0; c < 8; ++c) glds16(s_ + c * 8, (unsigned)__builtin_amdgcn_readfirstlane(kdst + c * 1024)); } while (0)
#define WP_ISSUE_V(tt) do { _Pragma("unroll") for (int kb = 0; kb < 4; ++kb) { const bf16* s_ = Vg + (size_t)km.krow(tt, 16 * kb + (lane >> 2)) * pitchV + (lane & 3) * 8; \
        glds16(s_, (unsigned)__builtin_amdgcn_readfirstlane(vdst + kb * 1024)); glds16(s_ + 32, (unsigned)__builtin_amdgcn_readfirstlane(vdst + (4 + kb) * 1024)); } } while (0)
    const int t0 = km.first(), nt = km.nt();
    ATT_WAITL();
    WP_ISSUE_K(t0); WP_ISSUE_V(t0);
    for (int tt = t0; tt < nt; ++tt) {
        ATT_WAITV(8);
        f32x16 p0, p1;
        qkt(p0, p1, Ks, qr, r32, hi);
        if (tt + 1 < nt) { ATT_WAITL(); WP_ISSUE_K(tt + 1); ATT_WAITV(8); } else { ATT_WAITV(0); }
        km.mask(tt, p0, p1, r32, hi);
        softmax_pv<2>(p0, p1, m_run, l_run, o, Vs + voff, wsf, r32, hi);
        if (tt + 1 < nt) { ATT_WAITL(); WP_ISSUE_V(tt + 1); }
    }
#undef WP_ISSUE_K
#undef WP_ISSUE_V
    l_out = finish_o<2>(l_run, o, wsf, r32, hi);
    m_out = m_run;
}
template <class RowOff>
__device__ __forceinline__ void win_store(Frame& F, const att::f32x16 (&o)[2], bf16* dst, const RowOff& rowoff) {
    using namespace att;
    const int lane = F.lane, r32 = lane & 31, hi = lane >> 5;
    LAS unsigned short* stg = (LAS unsigned short*)(F.lds + RING_OFF + F.wave * WP_STRIDE);
    ATT_WAITL();
#pragma unroll
    for (int r = 0; r < 16; ++r) { const int orow = crow(r, hi);
#pragma unroll
        for (int d0 = 0; d0 < 2; ++d0) stg[orow * 64 + d0 * 32 + r32] = (unsigned short)(cvtpk(o[d0][r], 0.f) & 0xffffu); }
    ATT_WAITL();
#pragma unroll
    for (int i = 0; i < 4; ++i) { const int row = i * 8 + (lane >> 3), ch = lane & 7; const u32x4 v = *(const LAS u32x4*)(stg + row * 64 + ch * 8); *(u32x4*)(dst + rowoff(row) + ch * 8) = v; }
    ATT_WAITL();
}
__device__ __forceinline__ void mem_attn_all(Frame& F, const bf16* PROJ, const bf16* MKV, bf16* MIX) {
    const int gw = F.vcu * NWAVES + F.wave, NGW = F.G * NWAVES, r32 = F.lane & 31;
    for (int qb = gw; qb < NB * 4 * (SEQ / 32); qb += NGW) {
        const int blk = qb % (SEQ / 32), mh = (qb / (SEQ / 32)) & 3, b = qb / (4 * (SEQ / 32));
        const size_t row0 = (size_t)b * SEQ + 32 * blk;
        MemMap km{b * MEMT};
        att::f32x16 o[2]; float m_, l_;
        win_attn(F, km, PROJ + (row0 + r32) * INW + 2304 + mh * 64, MKV + mh * 64, MKVW, MKV + 256 + mh * 64, MKVW, o, m_, l_);
        win_store(F, o, MIX + row0 * DM + 768 + mh * 64, [](int i) { return (size_t)i * DM; });
    }
}
__device__ __forceinline__ void dil_unit(Frame& F, unsigned char* ws_, int b, int j, int sp, const bf16* PROJ, const bf16* SKV, bf16* MIX) {
    const int lane = F.lane, r32 = lane & 31, hi = lane >> 5, w = F.wave;
    unsigned char* scr = ws_ + WS_OG + (size_t)F.bx * OG_PER_CU;
    bf16* og = (bf16*)scr; float* lse = (float*)(scr + 3 * 512 * 64 * 2);
    const size_t rb = (size_t)b * SEQ;
    for (int e = w; e < 48; e += NWAVES) {
        const int g = e >> 4, idx = e & 15;
        const int d = g == 0 ? 1 : (g == 1 ? 4 : 16);
        const int res = g == 0 ? 0 : (g == 1 ? (idx >> 2) : idx);
        const int mb = g == 0 ? (sp * 16 + idx) : (g == 1 ? (sp * 4 + (idx & 3)) : sp);
        const int m0 = 32 * mb, head = g * 12 + j;
        DilMap km{(int)rb, d, res, m0, m0 - 128, SEQ / d - 1};
        const size_t qrow = rb + (size_t)(m0 + r32) * d + res;
        att::f32x16 o[2]; float m_, l_;
        win_attn(F, km, PROJ + qrow * INW + head * 64, SKV + head * 64, SKVW, SKV + 2304 + head * 64, SKVW, o, m_, l_);
        const int pos0 = m0 * d + res - 512 * sp;
        win_store(F, o, og + (size_t)g * 512 * 64 + (size_t)pos0 * 64, [d](int i) { return (size_t)i * d * 64; });
        if (hi == 0) lse[g * 512 + pos0 + r32 * d] = m_ + __builtin_amdgcn_logf(l_);
    }
    asm volatile("s_waitcnt vmcnt(0)" ::: "memory");
    __syncthreads();
    {
        const int pos = F.tid;
        const float l0 = __builtin_nontemporal_load(lse + pos), l1 = __builtin_nontemporal_load(lse + 512 + pos), l2 = __builtin_nontemporal_load(lse + 1024 + pos);
        const float mx = __builtin_fmaxf(l0, __builtin_fmaxf(l1, l2));
        float a0 = __builtin_amdgcn_exp2f(l0 - mx), a1 = __builtin_amdgcn_exp2f(l1 - mx), a2 = __builtin_amdgcn_exp2f(l2 - mx);
        const float inv = 1.0f / (a0 + a1 + a2); a0 *= inv; a1 *= inv; a2 *= inv;
        const v4u* g0 = (const v4u*)(og + (size_t)pos * 64); const v4u* g1 = g0 + 512 * 8; const v4u* g2 = g1 + 512 * 8;
        v4u* dst = (v4u*)(MIX + (rb + 512 * sp + pos) * DM + j * 64);
#pragma unroll
        for (int c = 0; c < 8; ++c) {
            const v4u x = __builtin_nontemporal_load(g0 + c), y = __builtin_nontemporal_load(g1 + c), z = __builtin_nontemporal_load(g2 + c);
            v4u r;
#pragma unroll
            for (int k = 0; k < 4; ++k) {
                const float lo = a0 * __uint_as_float(x[k] << 16) + a1 * __uint_as_float(y[k] << 16) + a2 * __uint_as_float(z[k] << 16);
                const float hh = a0 * __uint_as_float(x[k] & 0xffff0000u) + a1 * __uint_as_float(y[k] & 0xffff0000u) + a2 * __uint_as_float(z[k] & 0xffff0000u);
                r[k] = cvtpk(lo, hh);
            }
            dst[c] = r;
        }
    }
    __syncthreads();
}

#define CEX(a, b) do { const float hi_ = __builtin_fmaxf(a, b), lo_ = __builtin_fminf(a, b); a = hi_; b = lo_; } while (0)
template <int K, int J> __device__ __forceinline__ void bstage(float (&a)[16]) {
#pragma unroll
    for (int i = 0; i < 16; ++i) { constexpr int k = K, j = J; const int l = i ^ j; if (l > i) { if ((i & k) == 0) CEX(a[i], a[l]); else CEX(a[l], a[i]); } }
}
__device__ __forceinline__ void sort16_desc(float (&a)[16]) {
    bstage<2, 1>(a); bstage<4, 2>(a); bstage<4, 1>(a); bstage<8, 4>(a); bstage<8, 2>(a); bstage<8, 1>(a); bstage<16, 8>(a); bstage<16, 4>(a); bstage<16, 2>(a); bstage<16, 1>(a);
}
__device__ __forceinline__ void merge16(float (&a)[16], const float (&b)[16]) {
#pragma unroll
    for (int i = 0; i < 16; ++i) a[i] = __builtin_fmaxf(a[i], b[15 - i]);
    bstage<16, 8>(a); bstage<16, 4>(a); bstage<16, 2>(a); bstage<16, 1>(a);
}
__device__ __forceinline__ void top16_of_64(const float (&v)[64], float (&out)[16]) {
    float c1[16], c2[16], c3[16];
#pragma unroll
    for (int i = 0; i < 16; ++i) { out[i] = v[i]; c1[i] = v[16 + i]; }
    sort16_desc(out); sort16_desc(c1); merge16(out, c1);
#pragma unroll
    for (int i = 0; i < 16; ++i) { c2[i] = v[32 + i]; c3[i] = v[48 + i]; }
    sort16_desc(c2); sort16_desc(c3); merge16(c2, c3); merge16(out, c2);
}
struct CandTab { int pos[16][16]; int n;
    constexpr CandTab() : pos{}, n(0) { for (int a = 0; a < 16; ++a) for (int b = 0; b < 16; ++b) pos[a][b] = ((a + 1) * (b + 1) <= 16) ? n++ : -1; } };
static constexpr CandTab kCand{};
static_assert(kCand.n == 50, "50 candidate pairs");
__device__ __forceinline__ float gelu1(float v) { pg8::f32x2 t = {v, v}; return pg8::gelu_pk(t).x; }

__device__ __forceinline__ void peer_phase(Frame& F, int l) {
    using att::f32x16; using att::crow;
    const int lane = F.lane, r32 = lane & 31, hi = lane >> 5, w = F.wave;
    const auto kp_ = ka_fresh(F); unsigned char* const ws_ = KA_WS(kp_); float* const out_ = KA_OUT(kp_);
    const bf16* PQ = WSP(bf16, WS_PROJ);
    const bf16* keys = WSP(bf16, WS_PKEYS) + (size_t)l * 16 * 128 * 128;
    const bf16* U = WSP(bf16, WS_PU) + (size_t)l * NEXP * DM;
    const bf16* V = WSP(bf16, WS_PV) + (size_t)l * NEXP * DM;
    LAS unsigned* ids = (LAS unsigned*)(F.lds + RING_OFF);
    LAS float* gates = (LAS float*)(F.lds + RING_OFF + 65536);
    LAS unsigned char* scr = F.lds + PEER_SCR + w * 2048 + lane * 32;
    const float* gf = KA_IN(kp_, 10) + l * DM;
    for (int tile = F.bx; tile < TT / 128; tile += F.G) {
        {
            const int tokl = 32 * (w & 3) + r32; const size_t tok = (size_t)tile * 128 + tokl;
            for (int hh = 0; hh < 4; ++hh) {
                const int h = 4 * (w >> 2) + hh;
                float L0[16], L1[16];
#pragma unroll
                for (int p = 0; p < 2; ++p) {
                    const bf16* kg = keys + (size_t)(h * 2 + p) * 16384 + (size_t)r32 * 128 + hi * 8;
                    const bf16* qp = PQ + tok * PQW + h * 256 + p * 128 + hi * 8;
                    f32x16 acc[4];
#pragma unroll
                    for (int kb = 0; kb < 4; ++kb) acc[kb] = f32x16{};
#pragma unroll
                    for (int ks = 0; ks < 8; ++ks) { const bf16x8 bq = *(const bf16x8*)(qp + ks * 16);
#pragma unroll
                        for (int kb = 0; kb < 4; ++kb) { const bf16x8 ak = *(const bf16x8*)(kg + kb * 32 * 128 + ks * 16); acc[kb] = __builtin_amdgcn_mfma_f32_32x32x16_bf16(ak, bq, acc[kb], 0, 0, 0); } }
                    float v[64];
#pragma unroll
                    for (int kb = 0; kb < 4; ++kb)
#pragma unroll
                        for (int r = 0; r < 16; ++r) v[kb * 16 + r] = __uint_as_float((__float_as_uint(acc[kb][r]) & ~127u) | (unsigned)(kb * 32 + crow(r, hi)));
                    float t[16]; top16_of_64(v, t);
                    float a[16], b[16];
#pragma unroll
                    for (int i = 0; i < 16; ++i) { auto rr = __builtin_amdgcn_permlane32_swap(__float_as_uint(t[i]), __float_as_uint(t[i]), false, false); a[i] = __uint_as_float(rr[0]); b[i] = __uint_as_float(rr[1]); }
                    merge16(a, b);
#pragma unroll
                    for (int i = 0; i < 16; ++i) { if (p == 0) L0[i] = a[i]; else L1[i] = a[i]; }
                }
#pragma unroll
                for (int q = 0; q < 4; ++q) {
                    ((LAS unsigned*)scr)[q] = (__float_as_uint(L0[4 * q]) & 127u) | ((__float_as_uint(L0[4 * q + 1]) & 127u) << 8) | ((__float_as_uint(L0[4 * q + 2]) & 127u) << 16) | ((__float_as_uint(L0[4 * q + 3]) & 127u) << 24);
                    ((LAS unsigned*)scr)[4 + q] = (__float_as_uint(L1[4 * q]) & 127u) | ((__float_as_uint(L1[4 * q + 1]) & 127u) << 8) | ((__float_as_uint(L1[4 * q + 2]) & 127u) << 16) | ((__float_as_uint(L1[4 * q + 3]) & 127u) << 24);
                }
                float cand[64];
#pragma unroll
                for (int i = 0; i < 64; ++i) cand[i] = -INFINITY;
#pragma unroll
                for (int i = 0; i < 16; ++i)
#pragma unroll
                    for (int j = 0; j < 16; ++j) if ((i + 1) * (j + 1) <= 16) cand[kCand.pos[i][j]] = __uint_as_float((__float_as_uint(L0[i] + L1[j]) & ~255u) | (unsigned)(i * 16 + j));
                float sel[16]; top16_of_64(cand, sel);
                asm volatile("s_waitcnt lgkmcnt(0)" ::: "memory");
                float ev[16]; unsigned eid[16]; float esum = 0.f;
                const float s0 = __uint_as_float(__float_as_uint(sel[0]) & ~255u);
#pragma unroll
                for (int k = 0; k < 16; ++k) { const unsigned bits = __float_as_uint(sel[k]); const unsigned code = bits & 255u;
                    const unsigned i1 = scr[code >> 4], i2 = scr[16 + (code & 15u)];
                    eid[k] = i1 * 128u + i2; ev[k] = __expf(__uint_as_float(bits & ~255u) - s0); esum += ev[k]; }
                const float rinv = 1.0f / esum;
                asm volatile("s_waitcnt lgkmcnt(0)" ::: "memory");
#pragma unroll
                for (int k = 0; k < 8; ++k) { const unsigned idv = hi ? eid[k + 8] : eid[k]; const float gv = (hi ? ev[k + 8] : ev[k]) * rinv;
                    ids[tokl * 128 + h * 16 + 8 * hi + k] = idv; gates[tokl * 128 + h * 16 + 8 * hi + k] = gv; }
            }
        }
        __syncthreads();
        {
        const Frame F2 = make_frame(); const int lane = F2.lane, w = F2.wave;
        for (int tt = 0; tt < 16; ++tt) {
            const int tokl = 16 * w + tt; const size_t tok = (size_t)tile * 128 + tokl;
            float* xrow = out_ + tok * DM;
            f32x4 x[4]; { const f32x4* xp = (const f32x4*)(xrow + 8 * lane); x[0] = xp[0]; x[1] = xp[1]; const f32x4* xq = (const f32x4*)(xrow + 512 + 8 * lane); x[2] = xq[0]; x[3] = xq[1]; }
            float ssq = 0.f;
#pragma unroll
            for (int j = 0; j < 4; ++j) ssq += (x[j][0] * x[j][0] + x[j][1] * x[j][1]) + (x[j][2] * x[j][2] + x[j][3] * x[j][3]);
            const float rstd = 1.0f / sqrtf(wave_sum(ssq) * (1.f / DM) + EPS);
            unsigned xb[8];
            { const f32x4* gp = (const f32x4*)(gf + 8 * lane); const f32x4* gq = (const f32x4*)(gf + 512 + 8 * lane); const f32x4 g0 = gp[0], g1 = gp[1], g2 = gq[0], g3 = gq[1];
              const f32x4 n0 = x[0] * rstd * g0, n1 = x[1] * rstd * g1, n2 = x[2] * rstd * g2, n3 = x[3] * rstd * g3;
              xb[0] = cvtpk(n0[0], n0[1]); xb[1] = cvtpk(n0[2], n0[3]); xb[2] = cvtpk(n1[0], n1[1]); xb[3] = cvtpk(n1[2], n1[3]);
              xb[4] = cvtpk(n2[0], n2[1]); xb[5] = cvtpk(n2[2], n2[3]); xb[6] = cvtpk(n3[0], n3[1]); xb[7] = cvtpk(n3[2], n3[3]); }
            float acc[16];
#pragma unroll
            for (int i = 0; i < 16; ++i) acc[i] = 0.f;
            const LAS unsigned* idp = ids + tokl * 128; const LAS float* gtp = gates + tokl * 128;
            typedef __bf16 bf2 __attribute__((ext_vector_type(2))); typedef unsigned v2u __attribute__((ext_vector_type(2))); typedef float f32x2 __attribute__((ext_vector_type(2)));
#define PEER_LOAD(UU, VV, bt) do { const v2u e2_ = *(const LAS v2u*)(idp + 2 * (bt)); _Pragma("unroll") for (int j_ = 0; j_ < 2; ++j_) { const unsigned e_ = (unsigned)__builtin_amdgcn_readfirstlane((int)e2_[j_]); \
                const v4u* up_ = (const v4u*)(U + (size_t)e_ * DM) + lane; const v4u* vp_ = (const v4u*)(V + (size_t)e_ * DM) + lane; UU[j_][0] = up_[0]; UU[j_][1] = up_[64]; VV[j_][0] = vp_[0]; VV[j_][1] = vp_[64]; } } while (0)
#define PEER_COMP(UU, VV, bt) do { const f32x2 g2_ = *(const LAS f32x2*)(gtp + 2 * (bt)); float dt_[2]; \
                _Pragma("unroll") for (int j_ = 0; j_ < 2; ++j_) { float d_ = 0.f; _Pragma("unroll") for (int k_ = 0; k_ < 4; ++k_) { \
                    const unsigned u0_ = UU[j_][0][k_], u1_ = UU[j_][1][k_], x0_ = xb[k_], x1_ = xb[4 + k_]; d_ = __builtin_amdgcn_fdot2_f32_bf16(__builtin_bit_cast(bf2, u0_), __builtin_bit_cast(bf2, x0_), d_, false); d_ = __builtin_amdgcn_fdot2_f32_bf16(__builtin_bit_cast(bf2, u1_), __builtin_bit_cast(bf2, x1_), d_, false); } dt_[j_] = d_; } \
                _Pragma("unroll") for (int o_ = 1; o_ < 64; o_ <<= 1) { _Pragma("unroll") for (int j_ = 0; j_ < 2; ++j_) dt_[j_] += __shfl_xor(dt_[j_], o_); } \
                _Pragma("unroll") for (int j_ = 0; j_ < 2; ++j_) { const float c_ = g2_[j_] * gelu1(dt_[j_]); _Pragma("unroll") for (int k_ = 0; k_ < 4; ++k_) { \
                    acc[2 * k_] += c_ * __uint_as_float(VV[j_][0][k_] << 16); acc[2 * k_ + 1] += c_ * __uint_as_float(VV[j_][0][k_] & 0xffff0000u); \
                    acc[8 + 2 * k_] += c_ * __uint_as_float(VV[j_][1][k_] << 16); acc[8 + 2 * k_ + 1] += c_ * __uint_as_float(VV[j_][1][k_] & 0xffff0000u); } } } while (0)
            v4u ua[2][2], va[2][2], ub[2][2], vb[2][2];
            PEER_LOAD(ua, va, 0);
            for (int bt = 0; bt < 64; bt += 2) {
                PEER_LOAD(ub, vb, bt + 1);
                PEER_COMP(ua, va, bt);
                if (bt + 2 < 64) PEER_LOAD(ua, va, bt + 2);
                PEER_COMP(ub, vb, bt + 1);
            }
#undef PEER_LOAD
#undef PEER_COMP
            f32x4 y[4];
#pragma unroll
            for (int j = 0; j < 4; ++j) y[j] = (f32x4){x[j][0] + acc[4 * j], x[j][1] + acc[4 * j + 1], x[j][2] + acc[4 * j + 2], x[j][3] + acc[4 * j + 3]};
            float s2 = 0.f;
#pragma unroll
            for (int j = 0; j < 4; ++j) s2 += (y[j][0] * y[j][0] + y[j][1] * y[j][1]) + (y[j][2] * y[j][2] + y[j][3] * y[j][3]);
            const float r2 = 1.0f / sqrtf(wave_sum(s2) * (1.f / DM) + EPS);
            if (l < 3) {
                { f32x4* xp = (f32x4*)(xrow + 8 * lane); xp[0] = y[0]; xp[1] = y[1]; f32x4* xq = (f32x4*)(xrow + 512 + 8 * lane); xq[0] = y[2]; xq[1] = y[3]; }
                const float* gn = KA_IN(kp_, 2) + (l + 1) * DM;
                { const f32x4* gp = (const f32x4*)(gn + 8 * lane); const f32x4* gq = (const f32x4*)(gn + 512 + 8 * lane); const f32x4 n0 = y[0] * r2 * gp[0], n1 = y[1] * r2 * gp[1], n2 = y[2] * r2 * gq[0], n3 = y[3] * r2 * gq[1];
                  bf16* xn = WSP(bf16, WS_XN) + tok * DM;
                  *(v4u*)(xn + 8 * lane) = (v4u){cvtpk(n0[0], n0[1]), cvtpk(n0[2], n0[3]), cvtpk(n1[0], n1[1]), cvtpk(n1[2], n1[3])};
                  *(v4u*)(xn + 512 + 8 * lane) = (v4u){cvtpk(n2[0], n2[1]), cvtpk(n2[2], n2[3]), cvtpk(n3[0], n3[1]), cvtpk(n3[2], n3[3])}; }
                if (l == 1) { const float* gs = KA_IN(kp_, 15);
                  const f32x4* gp = (const f32x4*)(gs + 8 * lane); const f32x4* gq = (const f32x4*)(gs + 512 + 8 * lane); const f32x4 n0 = y[0] * r2 * gp[0], n1 = y[1] * r2 * gp[1], n2 = y[2] * r2 * gq[0], n3 = y[3] * r2 * gq[1];
                  bf16* xs = WSP(bf16, WS_XB) + tok * DM;
                  *(v4u*)(xs + 8 * lane) = (v4u){cvtpk(n0[0], n0[1]), cvtpk(n0[2], n0[3]), cvtpk(n1[0], n1[1]), cvtpk(n1[2], n1[3])};
                  *(v4u*)(xs + 512 + 8 * lane) = (v4u){cvtpk(n2[0], n2[1]), cvtpk(n2[2], n2[3]), cvtpk(n3[0], n3[1]), cvtpk(n3[2], n3[3])}; }
            } else {
                const float* gn = KA_IN(kp_, 17);
                const f32x4* gp = (const f32x4*)(gn + 8 * lane); const f32x4* gq = (const f32x4*)(gn + 512 + 8 * lane);
                f32x4* xp = (f32x4*)(xrow + 8 * lane); xp[0] = y[0] * r2 * gp[0]; xp[1] = y[1] * r2 * gp[1]; f32x4* xq = (f32x4*)(xrow + 512 + 8 * lane); xq[0] = y[2] * r2 * gq[0]; xq[1] = y[3] * r2 * gq[1];
            }
        }
        }
        __syncthreads();
    }
}

struct Args { const float* in[18]; float* out; unsigned char* ws; int ph_lo, ph_hi; };
__global__ void __launch_bounds__(NWAVES * 64, 2) hyb_fwd(Args args) {
    { Frame F = make_frame();
      for (int u = F.tid; u < 1024 / 4; u += NWAVES * 64) ((LAS unsigned*)(F.lds + LDSCTL_OFF))[u] = 0u; }
    __syncthreads();
    const int lo = args.ph_lo, hi = args.ph_hi;
    if (hi - lo > 1) { Frame F = make_frame(); const auto kp_ = ka_fresh(F); (void)xcd_barrier_post((unsigned*)(KA_WS(kp_) + WS_CTL) + CW_BAR, F.MISC + 8); }
#ifndef PHMASK
#define PHMASK 0xff
#endif
#define PHM(b) ((PHMASK & (b)) != 0)
#define IN(k) (lo <= (k) && (k) < hi)
#define SEAM(k) do { if (IN(k) && IN((k) + 1)) { Frame F = make_frame(); const auto kq_ = ka_fresh(F); XcdBarrier b_; b_.bar = (unsigned*)(KA_WS(kq_) + WS_CTL) + CW_BAR; b_.x = xb_xcc_id(); b_.st = F.MISC + 8; xcd_barrier(b_); } } while (0)

    if (PHM(1) && IN(0)) { Frame F = make_frame(); p0_prologue(F); }
    SEAM(0);
    for (int l = 0; l < 4; ++l) {
        const int pb = 1 + 5 * l;
        if (PHM(2) && IN(pb)) {
            const int njobs = (l == 0) ? 5 : (l == 2 ? 2 : 1);
            for (int jb = 0; jb < njobs; ++jb) {
                Frame F = make_frame(); const auto kp_ = ka_fresh(F); unsigned char* const ws_ = KA_WS(kp_);
                pg8::Gemm g; pg8::EpiProj E; int cid = F.bx;
                E.rope = WSP(float, WS_ROPE); E.sc = att::C2;
                const bool is_skv = (l == 2 && jb == 0), is_proj = (l == 2) ? (jb == 1) : (jb == 0);
                if (is_skv) { g = pg8::Gemm{WSP(pg8::bf16_t, WS_XB), WSP(pg8::bf16_t, WS_WSKV), TT, SKVW, DM}; E.O = WSP(pg8::bf16_t, WS_SKV); E.ldc = SKVW; E.rope_lim = 9; E.scale_lim = 0; E.scale_tile = -1; }
                else if (is_proj) { g = pg8::Gemm{WSP(pg8::bf16_t, WS_XN), (l < 2 ? WSP(pg8::bf16_t, WS_WA) + (size_t)l * INW * DM : WSP(pg8::bf16_t, WS_WB) + (size_t)(l - 2) * INW * DM), TT, INW, DM};
                    E.O = WSP(pg8::bf16_t, WS_PROJ); E.ldc = INW; E.rope_lim = (l < 2) ? 6 : 9; E.scale_lim = (l < 2) ? 3 : 9; E.scale_tile = 9; }
                else { const int lm = jb - 1; g = pg8::Gemm{WSP(pg8::bf16_t, WS_MEMN) + (size_t)lm * MEMROWS * DM, WSP(pg8::bf16_t, WS_WMKV) + (size_t)lm * MKVW * DM, MEMROWS, MKVW, DM};
                    E.O = WSP(pg8::bf16_t, WS_MEMKV) + (size_t)lm * MEMROWS * MKVW; E.ldc = MKVW; E.rope_lim = 0; E.scale_lim = 0; E.scale_tile = -1; cid = (int)((F.bx + F.G - 16 * lm) % F.G); }
                pg8::StaticOrder S; S.init(g.M, g.N, F.G, cid);
                pg8::gemm_phase<pg8::EpiProj, pg8::StaticOrder, true, true>(F.lds + RING_OFF, g, S, E);
                __syncthreads();
            }
        }
        SEAM(pb);
        if (IN(pb + 1)) {
            Frame F = make_frame(); const auto kp_ = ka_fresh(F); unsigned char* const ws_ = KA_WS(kp_);
            const bf16* PROJ = WSP(bf16, WS_PROJ); bf16* MIX = WSP(bf16, WS_MIX);
            if (PHM(4) && l < 2) {
                const float li = 0.8f - 0.6f * expf(-0.3f * (float)l);
                const float* lp = KA_IN(kp_, 4) + l * 256;
                const float d01 = wave_sum(lp[F.lane] * lp[64 + F.lane]), d23 = wave_sum(lp[128 + F.lane] * lp[192 + F.lane]);
                const float lam = expf(d01) - expf(d23) + li;
                const float* subg = KA_IN(kp_, 5) + l * 128;
                for (int k = 0; k < 3; ++k) {
                    const int P = F.vcu * 3 + k; if (P >= 768) break;
                    const int bh = P >> 4, s = P & 15;
                    diff_unit(F, bh / 6, bh % 6, s, PROJ, MIX, lam, 1.0f - li, subg);
                    diff_unit(F, bh / 6, bh % 6, 31 - s, PROJ, MIX, lam, 1.0f - li, subg);
                }
            } else if (PHM(8)) {
                const bf16* SKV = WSP(bf16, WS_SKV);
                for (int k = 0; k < 3; ++k) {
                    const int U = F.vcu * 3 + k; if (U >= 768) break;
                    dil_unit(F, ws_, U / 96, (U >> 3) % 12, U & 7, PROJ, SKV, MIX);
                }
            }
            if (PHM(16)) mem_attn_all(F, PROJ, WSP(bf16, WS_MEMKV) + (size_t)l * MEMROWS * MKVW, MIX);
            asm volatile("s_waitcnt vmcnt(0) lgkmcnt(0)" ::: "memory"); __syncthreads();
        }
        SEAM(pb + 1);
        if (PHM(32) && IN(pb + 2)) {
            Frame F = make_frame(); const auto kp_ = ka_fresh(F); unsigned char* const ws_ = KA_WS(kp_);
            pg8::Gemm g{WSP(pg8::bf16_t, WS_MIX), WSP(pg8::bf16_t, WS_WOUT) + (size_t)l * DM * DM, TT, DM, DM};
            pg8::EpiRes E{KA_OUT(kp_), WSP(pg8::bf16_t, WS_XB), WSP(float, WS_SS), DM};
            pg8::StaticOrder S; S.init(TT, DM, F.G, F.bx);
            pg8::gemm_phase<pg8::EpiRes, pg8::StaticOrder, true, true>(F.lds + RING_OFF, g, S, E);
            __syncthreads();
        }
        SEAM(pb + 2);
        if (PHM(64) && IN(pb + 3)) {
            Frame F = make_frame(); const auto kp_ = ka_fresh(F); unsigned char* const ws_ = KA_WS(kp_);
            pg8::Gemm g{WSP(pg8::bf16_t, WS_XB), WSP(pg8::bf16_t, WS_WPQ) + (size_t)l * PQW * DM, TT, PQW, DM};
            pg8::EpiScaleRow E{WSP(pg8::bf16_t, WS_PROJ), PQW, WSP(float, WS_SS), EPS};
            pg8::StaticOrder S; S.init(TT, PQW, F.G, F.bx);
            pg8::gemm_phase<pg8::EpiScaleRow, pg8::StaticOrder, true, true>(F.lds + RING_OFF, g, S, E);
            __syncthreads();
        }
        SEAM(pb + 3);
        if (PHM(128) && IN(pb + 4)) { Frame F = make_frame(); peer_phase(F, l); }
        SEAM(pb + 4);
    }
#undef IN
#undef SEAM
}

#ifndef HYB_N_LAUNCHES
#define HYB_N_LAUNCHES 21
#endif
extern "C" void kernel_launch(void* const* d_in, const int* in_sizes, int n_in, void* d_out, int out_size, void* d_ws, size_t ws_size, hipStream_t stream) {
    static int grid = 0;
    if (grid == 0) {
        if (n_in != 18 || out_size != TT * DM || ws_size < WS_END) { fprintf(stderr, "kernel_launch: unexpected shapes (n_in %d, out %d, ws %zu)\n", n_in, out_size, ws_size); grid = -1; return; }
        int dev = 0, cus = 0, per_cu = 0;
        if (hipGetDevice(&dev) != hipSuccess || hipDeviceGetAttribute(&cus, hipDeviceAttributeMultiprocessorCount, dev) != hipSuccess) { grid = -1; return; }
        if (hipFuncSetAttribute((const void*)hyb_fwd, hipFuncAttributeMaxDynamicSharedMemorySize, LDS_BYTES) != hipSuccess) { fprintf(stderr, "kernel_launch: hipFuncSetAttribute failed\n"); grid = -1; return; }
        if (hipOccupancyMaxActiveBlocksPerMultiprocessor(&per_cu, (const void*)hyb_fwd, NWAVES * 64, LDS_BYTES) != hipSuccess || per_cu < 1) { fprintf(stderr, "kernel_launch: occupancy query says %d\n", per_cu); }
        (void)hipGetLastError();
        grid = cus;
    }
    if (grid < 0) return;
    (void)hipMemsetAsync((char*)d_ws + WS_CTL, 0, CTL_ZERO_BYTES, stream);
    Args a{};
    for (int i = 0; i < 18; ++i) a.in[i] = (const float*)d_in[i];
    a.out = (float*)d_out; a.ws = (unsigned char*)d_ws;
    if (HYB_N_LAUNCHES == 1) { a.ph_lo = 0; a.ph_hi = NPHASE; hipLaunchKernelGGL(hyb_fwd, dim3(grid), dim3(NWAVES * 64), LDS_BYTES, stream, a); }
    else { for (int p = 0; p < NPHASE; ++p) { a.ph_lo = p; a.ph_hi = p + 1; hipLaunchKernelGGL(hyb_fwd, dim3(grid), dim3(NWAVES * 64), LDS_BYTES, stream, a); } }
}
```

```cpp
#include <hip/hip_runtime.h>
#include <cstdio>
#include <cstdint>
#include <cmath>
template <int CTRL> __device__ __forceinline__ float dpp_addc(float v) { return v + __uint_as_float((unsigned)__builtin_amdgcn_update_dpp(0, (int)__float_as_uint(v), CTRL, 0xf, 0xf, true)); }
template <int CTRL> __device__ __forceinline__ float dpp_maxc(float v) { return __builtin_fmaxf(v, __uint_as_float((unsigned)__builtin_amdgcn_update_dpp(0, (int)__float_as_uint(v), CTRL, 0xf, 0xf, true))); }
__device__ __forceinline__ float xor16_sum(float v) { auto r = __builtin_amdgcn_permlane16_swap(__float_as_uint(v), __float_as_uint(v), false, false); return __uint_as_float(r[0]) + __uint_as_float(r[1]); }
__device__ __forceinline__ float xor32_sum(float v) { auto r = __builtin_amdgcn_permlane32_swap(__float_as_uint(v), __float_as_uint(v), false, false); return __uint_as_float(r[0]) + __uint_as_float(r[1]); }
__device__ __forceinline__ float xor16_get(float v, bool odd_row) { auto r = __builtin_amdgcn_permlane16_swap(__float_as_uint(v), __float_as_uint(v), false, false); return __uint_as_float(odd_row ? r[0] : r[1]); }
__device__ __forceinline__ float row16_sum(float v) { v = dpp_addc<0xB1>(v); v = dpp_addc<0x4E>(v); v = dpp_addc<0x141>(v); return dpp_addc<0x140>(v); }
__device__ __forceinline__ float half32_sum(float v) { return xor16_sum(row16_sum(v)); }
__device__ __forceinline__ float wave_sum_valu(float v) { return xor32_sum(half32_sum(v)); }
__device__ __forceinline__ float wave_max_valu(float v) {
    v = dpp_maxc<0xB1>(v); v = dpp_maxc<0x4E>(v); v = dpp_maxc<0x141>(v); v = dpp_maxc<0x140>(v);
    { auto r = __builtin_amdgcn_permlane16_swap(__float_as_uint(v), __float_as_uint(v), false, false); v = __builtin_fmaxf(__uint_as_float(r[0]), __uint_as_float(r[1])); }
    { auto r = __builtin_amdgcn_permlane32_swap(__float_as_uint(v), __float_as_uint(v), false, false); v = __builtin_fmaxf(__uint_as_float(r[0]), __uint_as_float(r[1])); }
    return v;
}
namespace pg8 {
#define PG8_LAS __attribute__((address_space(3)))
typedef unsigned short bf16_t;
typedef short bf16x8 __attribute__((ext_vector_type(8)));
typedef float f32x4 __attribute__((ext_vector_type(4)));
typedef unsigned u32x4 __attribute__((ext_vector_type(4)));
constexpr int BM = 256, BK = 64, HALF = 128, HTB = HALF * BK * 2  , STAGE_BYTES = 8 * HTB, NXCD = 8, WGM = 8;

__host__ __device__ __forceinline__ int lds_byte(int r, int c) { const int st = (r >> 4) * 2 + (c >> 5), rr = r & 15, cc = c & 31, ob = rr * 64 + cc * 2; return st * 1024 + (ob ^ (((ob >> 9) & 1) << 5)); }
__host__ __device__ __forceinline__ void stage_rc(int b, int& R, int& C) { const int st = b / 1024, sb = b % 1024, swz = sb ^ (((sb >> 9) & 1) << 5); R = (st >> 1) * 16 + swz / 64; C = (st & 1) * 32 + (swz % 64) / 2; }
__host__ __device__ __forceinline__ int perm32(int rho) { const int n = rho >> 4, i = rho & 15; return 8 * (i >> 2) + 4 * n + (i & 3); }

struct Unit { int pm, pn; };
struct Gemm { const bf16_t* A; const bf16_t* Bt; int M, N, K; };

struct StaticOrder {
    int nM, nN, nwg, G, c;
    __host__ __device__ void init(int M, int N, int G_, int c_) { nM = M / BM; nN = N / BM; nwg = nM * nN; G = G_; c = c_; }
    __host__ __device__ bool next(int i, Unit& u) const {
        const long L = (long)i * G + c; if (L >= nwg) return false;
        int wgid = (int)L; { const int q = nwg / NXCD, r = nwg % NXCD, xcd = wgid % NXCD, off = wgid / NXCD; wgid = (xcd < r ? xcd * (q + 1) : r * (q + 1) + (xcd - r) * q) + off; }
        const int nig = WGM * nN, gid = wgid / nig, fm = gid * WGM, gsz = (nM - fm) < WGM ? (nM - fm) : WGM;
        u.pm = fm + ((wgid % nig) % gsz); u.pn = (wgid % nig) / gsz; return true;
    }
    __device__ __forceinline__ void a_ready(const Unit&) const {}
    __device__ __forceinline__ void done(const Unit&) const {}
};

__device__ __forceinline__ unsigned cvt_pk_bf16(float lo, float hi) { unsigned r; asm volatile("v_cvt_pk_bf16_f32 %0, %1, %2" : "=v"(r) : "v"(lo), "v"(hi)); return r; }
typedef float f32x2 __attribute__((ext_vector_type(2)));
__device__ __forceinline__ f32x2 gelu_pk(f32x2 v) {
    const f32x2 av = __builtin_elementwise_abs(v), d = av * 0.2316418882f + 1.0f;
    f32x2 t; t.x = __builtin_amdgcn_rcpf(d.x); t.y = __builtin_amdgcn_rcpf(d.y);
    f32x2 q = t * 0.5307027145f + (-0.7265760135f); q = q * t + 0.7107068705f; q = q * t + (-0.142248368f); q = q * t + 0.127414796f; q = q * t;
    const f32x2 s = (v * v) * (-0.72134752044f);
    f32x2 e; e.x = __builtin_amdgcn_exp2f(s.x); e.y = __builtin_amdgcn_exp2f(s.y);
    const f32x2 m = v * (q * e), r = v - m;
    f32x2 o; o.x = v.x < 0.f ? m.x : r.x; o.y = v.y < 0.f ? m.y : r.y; return o;
}


struct EpiProj {
    static constexpr bool PERM = true, AFTER_DRAIN = false;
    bf16_t* O; int ldc; const float* rope; int rope_lim, scale_lim, scale_tile; float sc; int hm; size_t hs;
    __device__ __forceinline__ void operator()(const f32x4 (&acc)[2][2][4][2], const Unit& u, int wr, int wc, int fr, int fq) const {
        const int row0 = u.pm * BM + wr * 64 + fr, col0 = u.pn * BM + wc * 32 + 8 * fq;
        const bool do_rope = (u.pn < rope_lim) && ((wc & 1) == 0);
        const float s = (u.pn < scale_lim || u.pn == scale_tile) ? sc : 1.f;
        const float sg = (fq == 0) ? -1.f : 1.f;
#pragma unroll
        for (int ai = 0; ai < 2; ++ai)
#pragma unroll
            for (int m = 0; m < 4; ++m) {
                const int row = row0 + ai * HALF + m * 16;
                f32x4 c0 = {1.f, 1.f, 1.f, 1.f}, c1 = c0, s0 = {0.f, 0.f, 0.f, 0.f}, s1 = s0;
                if (do_rope) { const f32x4* rp = (const f32x4*)(rope + (size_t)(row & 4095) * 16); c0 = rp[0]; c1 = rp[1]; s0 = rp[2]; s1 = rp[3]; }
                bf16_t* rowp = hm ? O + ((size_t)(row >> 12) * hm + (col0 >> 6)) * hs + (size_t)(row & 4095) * 64 + (col0 & 63) : O + (size_t)row * ldc + col0;
                const size_t bjstep = hm ? 2 * hs : (size_t)HALF;
#pragma unroll
                for (int bj = 0; bj < 2; ++bj) {
                    f32x4 v0 = acc[ai][bj][m][0], v1 = acc[ai][bj][m][1];
                    if (do_rope) {
                        f32x4 p0, p1;
#pragma unroll
                        for (int j = 0; j < 4; ++j) { p0[j] = xor16_get(v0[j], (fq & 1) != 0); p1[j] = xor16_get(v1[j], (fq & 1) != 0); }
                        if (fq < 2) { v0 = v0 * c0 + (p0 * s0) * sg; v1 = v1 * c1 + (p1 * s1) * sg; }
                    }
                    v0 = v0 * s; v1 = v1 * s;
                    u32x4 w; w.x = cvt_pk_bf16(v0[0], v0[1]); w.y = cvt_pk_bf16(v0[2], v0[3]); w.z = cvt_pk_bf16(v1[0], v1[1]); w.w = cvt_pk_bf16(v1[2], v1[3]);
                    *(u32x4*)(rowp + bj * bjstep) = w;
                }
            }
    }
};
struct EpiRes {
    static constexpr bool PERM = true, AFTER_DRAIN = false;
    bf16_t* XR; float* SS; int ldc;
    __device__ __forceinline__ void operator()(const f32x4 (&acc)[2][2][4][2], const Unit& u, int wr, int wc, int fr, int fq) const {
        const int row0 = u.pm * BM + wr * 64 + fr, col0 = u.pn * BM + wc * 32 + 8 * fq;
#pragma unroll
        for (int ai = 0; ai < 2; ++ai)
#pragma unroll
            for (int m = 0; m < 4; ++m) {
                const int row = row0 + ai * HALF + m * 16;
                float q = 0.f;
#pragma unroll
                for (int bj = 0; bj < 2; ++bj) {
                    bf16_t* xp = XR + (size_t)row * ldc + col0 + bj * HALF;
                    const u32x4 xw = *(const u32x4*)xp;
                    f32x4 x0 = {__uint_as_float(xw.x << 16), __uint_as_float(xw.x & 0xffff0000u), __uint_as_float(xw.y << 16), __uint_as_float(xw.y & 0xffff0000u)};
                    f32x4 x1 = {__uint_as_float(xw.z << 16), __uint_as_float(xw.z & 0xffff0000u), __uint_as_float(xw.w << 16), __uint_as_float(xw.w & 0xffff0000u)};
                    x0 = x0 + acc[ai][bj][m][0]; x1 = x1 + acc[ai][bj][m][1];
                    u32x4 w; w.x = cvt_pk_bf16(x0[0], x0[1]); w.y = cvt_pk_bf16(x0[2], x0[3]); w.z = cvt_pk_bf16(x1[0], x1[1]); w.w = cvt_pk_bf16(x1[2], x1[3]);
                    *(u32x4*)xp = w;
                    q += (x0[0] * x0[0] + x0[1] * x0[1]) + (x0[2] * x0[2] + x0[3] * x0[3]) + (x1[0] * x1[0] + x1[1] * x1[1]) + (x1[2] * x1[2] + x1[3] * x1[3]);
                }
                q = xor32_sum(xor16_sum(q));
                if (fq == 0) SS[(size_t)row * 16 + u.pn * 4 + wc] = q;
            }
    }
};
struct EpiScaleRow {
    static constexpr bool PERM = true, AFTER_DRAIN = false;
    bf16_t* O; int ldc; const float* SS; float eps;
    __device__ __forceinline__ void operator()(const f32x4 (&acc)[2][2][4][2], const Unit& u, int wr, int wc, int fr, int fq) const {
        const int row0 = u.pm * BM + wr * 64 + fr, col0 = u.pn * BM + wc * 32 + 8 * fq;
#pragma unroll
        for (int ai = 0; ai < 2; ++ai)
#pragma unroll
            for (int m = 0; m < 4; ++m) {
                const int row = row0 + ai * HALF + m * 16;
                const f32x4* sp = (const f32x4*)(SS + (size_t)row * 16);
                const f32x4 a = sp[0], b = sp[1], c = sp[2], d = sp[3];
                const float tot = (((a[0] + a[1]) + (a[2] + a[3])) + ((b[0] + b[1]) + (b[2] + b[3]))) + (((c[0] + c[1]) + (c[2] + c[3])) + ((d[0] + d[1]) + (d[2] + d[3])));
                const float rs = 1.0f / sqrtf(tot * (1.0f / 1024.0f) + eps);
                bf16_t* rowp = O + (size_t)row * ldc + col0;
#pragma unroll
                for (int bj = 0; bj < 2; ++bj) {
                    const f32x4 v0 = acc[ai][bj][m][0] * rs, v1 = acc[ai][bj][m][1] * rs;
                    u32x4 w; w.x = cvt_pk_bf16(v0[0], v0[1]); w.y = cvt_pk_bf16(v0[2], v0[3]); w.z = cvt_pk_bf16(v1[0], v1[1]); w.w = cvt_pk_bf16(v1[2], v1[3]);
                    *(u32x4*)(rowp + bj * HALF) = w;
                }
            }
    }
};

template <class Epi, class Sched, bool ALIGN_EPI = false, bool SP2 = false>
__device__ __forceinline__ void gemm_phase(PG8_LAS unsigned char* lds, const Gemm g, const Sched& S, const Epi& E) {
    int tid_ = threadIdx.x; asm volatile("" : "+v"(tid_));
    const int tid = tid_, wid = __builtin_amdgcn_readfirstlane(tid >> 6), lane = tid & 63, wr = wid >> 2, wc = wid & 3, fr = lane & 15, fq = lane >> 4;
    const int K = g.K, nt = K / BK;
    unsigned voffA[2], voffB[2];
#pragma unroll
    for (int i = 0; i < 2; ++i) { int R, C; stage_rc(tid * 16 + i * 8192, R, C); const int Rb = Epi::PERM ? ((R & ~31) + perm32(R & 31)) : R;
        voffA[i] = (unsigned)(R * K + C) * 2u; voffB[i] = (unsigned)(Rb * K + C) * 2u; }
    const size_t kstep = (size_t)(BK * 2);
    const size_t hstep = (size_t)HALF * K * 2;
    const size_t tstep = 2 * hstep;
    const unsigned ldsw = (unsigned)wid * 1024u;
    const int aoff = lds_byte(wr * 64 + fr, fq * 8), boff = lds_byte(wc * 32 + fr, fq * 8);
#define PG8_SA(b, h) (((b) * 2 + (h)) * HTB)
#define PG8_SB(b, h) ((4 + (b) * 2 + (h)) * HTB)
#define PG8_STAGE(bufoff, gbase, voff) do { _Pragma("unroll") for (int _i = 0; _i < 2; ++_i) \
        __builtin_amdgcn_global_load_lds((const unsigned*)((const char*)(gbase) + (voff)[_i]), (PG8_LAS unsigned*)(lds + (bufoff) + ldsw + _i * 8192), 16, 0, 0); } while (0)
#define PG8_LDA(dst, b, h) do { _Pragma("unroll") for (int m = 0; m < 4; ++m) _Pragma("unroll") for (int k = 0; k < 2; ++k) dst[m][k] = *(const PG8_LAS bf16x8*)(lds + PG8_SA(b, h) + aoff + m * 2048 + k * 1024); } while (0)
#define PG8_LDB(dst, b, h) do { _Pragma("unroll") for (int n = 0; n < 2; ++n) _Pragma("unroll") for (int k = 0; k < 2; ++k) dst[n][k] = *(const PG8_LAS bf16x8*)(lds + PG8_SB(b, h) + boff + n * 2048 + k * 1024); } while (0)
#define PG8_MMA(ai, bj, At, Bt) do { __builtin_amdgcn_s_setprio(1); _Pragma("unroll") for (int m = 0; m < 4; ++m) _Pragma("unroll") for (int n = 0; n < 2; ++n) _Pragma("unroll") for (int k = 0; k < 2; ++k) \
        acc[ai][bj][m][n] = __builtin_amdgcn_mfma_f32_16x16x32_bf16(Bt[n][k], At[m][k], acc[ai][bj][m][n], 0, 0, 0); __builtin_amdgcn_s_setprio(0); } while (0)
#define PG8_WAIT_V(n) asm volatile("s_waitcnt vmcnt(" #n ")" ::: "memory")
#define PG8_WAIT_L(n) asm volatile("s_waitcnt lgkmcnt(" #n ")" ::: "memory")
#define PG8_BAR __builtin_amdgcn_s_barrier()
#define PG8_SCHED __builtin_amdgcn_sched_barrier(0)
    Unit cur, nxt; int ui = 0;
    if (!S.next(0, cur)) return;
    f32x4 acc[2][2][4][2];
#pragma unroll
    for (int a = 0; a < 2; ++a)
#pragma unroll
        for (int b = 0; b < 2; ++b)
#pragma unroll
            for (int m = 0; m < 4; ++m)
#pragma unroll
                for (int n = 0; n < 2; ++n) acc[a][b][m][n] = (f32x4){0.f, 0.f, 0.f, 0.f};
    bf16x8 At[4][2], B0[2][2], B1[2][2];
    const char* cA = (const char*)g.A + (size_t)cur.pm * tstep; const char* cB = (const char*)g.Bt + (size_t)cur.pn * tstep;
    S.a_ready(cur);
    if constexpr (SP2) {
        PG8_STAGE(PG8_SB(0, 0), cB, voffB); PG8_STAGE(PG8_SB(0, 1), cB + hstep, voffB); PG8_STAGE(PG8_SA(0, 0), cA, voffA); PG8_STAGE(PG8_SA(0, 1), cA + hstep, voffA);
        if (wr == 1) PG8_BAR;
        PG8_WAIT_V(2); PG8_BAR;
        PG8_STAGE(PG8_SB(1, 0), cB + kstep, voffB); PG8_STAGE(PG8_SA(1, 0), cA + kstep, voffA); PG8_STAGE(PG8_SB(1, 1), cB + hstep + kstep, voffB);
        PG8_WAIT_V(6); PG8_BAR;
    } else {
        PG8_STAGE(PG8_SB(0, 0), cB, voffB); PG8_STAGE(PG8_SA(0, 0), cA, voffA); PG8_STAGE(PG8_SB(0, 1), cB + hstep, voffB); PG8_STAGE(PG8_SA(0, 1), cA + hstep, voffA);
        if (wr == 1) PG8_BAR;
        PG8_WAIT_V(4); PG8_BAR;
        PG8_STAGE(PG8_SB(1, 0), cB + kstep, voffB); PG8_STAGE(PG8_SA(1, 0), cA + kstep, voffA); PG8_STAGE(PG8_SB(1, 1), cB + hstep + kstep, voffB);
        PG8_WAIT_V(6); PG8_BAR;
    }
    for (;;) {
        const bool has_next = S.next(ui + 1, nxt);
        const char* nA = has_next ? (const char*)g.A + (size_t)nxt.pm * tstep : cA; const char* nB = has_next ? (const char*)g.Bt + (size_t)nxt.pn * tstep : cB;
        for (int t = 0; t < nt; t += 2) {
            const bool last = (t == nt - 2);
            const char* a1 = cA + (size_t)(t + 1) * kstep;
            const char* a2 = last ? nA : cA + (size_t)(t + 2) * kstep; const char* b2 = last ? nB : cB + (size_t)(t + 2) * kstep;
            const char* a3 = a2 + kstep; const char* b3 = b2 + kstep;
            if (last && has_next) S.a_ready(nxt);
            if constexpr (SP2) {
            PG8_LDB(B0, 0, 0); PG8_LDB(B1, 0, 1); PG8_SCHED; PG8_LDA(At, 0, 0); PG8_STAGE(PG8_SA(1, 1), a1 + hstep, voffA);
            PG8_WAIT_V(8); PG8_WAIT_L(0); PG8_BAR; PG8_MMA(0, 0, At, B0); PG8_MMA(0, 1, At, B1); PG8_BAR; PG8_SCHED;
            PG8_LDA(At, 0, 1); PG8_STAGE(PG8_SB(0, 0), b2, voffB); PG8_STAGE(PG8_SB(0, 1), b2 + hstep, voffB); PG8_STAGE(PG8_SA(0, 0), a2, voffA);
            PG8_WAIT_V(8); PG8_WAIT_L(0); PG8_BAR; PG8_MMA(1, 0, At, B0); PG8_MMA(1, 1, At, B1); PG8_BAR; PG8_SCHED;
            PG8_LDB(B0, 1, 0); PG8_LDB(B1, 1, 1); PG8_SCHED; PG8_LDA(At, 1, 0); PG8_STAGE(PG8_SA(0, 1), a2 + hstep, voffA);
            PG8_WAIT_V(8); PG8_WAIT_L(0); PG8_BAR; PG8_MMA(0, 0, At, B0); PG8_MMA(0, 1, At, B1); PG8_BAR; PG8_SCHED;
            PG8_LDA(At, 1, 1); PG8_STAGE(PG8_SB(1, 0), b3, voffB); PG8_STAGE(PG8_SB(1, 1), b3 + hstep, voffB); PG8_STAGE(PG8_SA(1, 0), a3, voffA);
            PG8_WAIT_V(8); PG8_WAIT_L(0); PG8_BAR; PG8_MMA(1, 0, At, B0); PG8_MMA(1, 1, At, B1); PG8_BAR; PG8_SCHED;
            } else {
            PG8_LDB(B0, 0, 0); PG8_SCHED; PG8_LDA(At, 0, 0); PG8_STAGE(PG8_SA(1, 1), a1 + hstep, voffA);
            PG8_WAIT_L(8); PG8_BAR; PG8_WAIT_L(0); PG8_MMA(0, 0, At, B0); PG8_BAR; PG8_SCHED;
            PG8_LDB(B1, 0, 1); PG8_STAGE(PG8_SB(0, 0), b2, voffB);
            PG8_BAR; PG8_WAIT_L(0); PG8_MMA(0, 1, At, B1); PG8_BAR;
            PG8_LDA(At, 0, 1); PG8_STAGE(PG8_SA(0, 0), a2, voffA);
            PG8_BAR; PG8_WAIT_L(0); PG8_MMA(1, 0, At, B0); PG8_BAR; PG8_SCHED;
            PG8_STAGE(PG8_SB(0, 1), b2 + hstep, voffB);
            PG8_WAIT_V(6); PG8_BAR; PG8_MMA(1, 1, At, B1); PG8_BAR;
            PG8_LDB(B0, 1, 0); PG8_SCHED; PG8_LDA(At, 1, 0); PG8_STAGE(PG8_SA(0, 1), a2 + hstep, voffA);
            PG8_WAIT_L(8); PG8_BAR; PG8_WAIT_L(0); PG8_MMA(0, 0, At, B0); PG8_BAR; PG8_SCHED;
            PG8_LDB(B1, 1, 1); PG8_STAGE(PG8_SB(1, 0), b3, voffB);
            PG8_BAR; PG8_WAIT_L(0); PG8_MMA(0, 1, At, B1); PG8_BAR;
            PG8_LDA(At, 1, 1); PG8_STAGE(PG8_SA(1, 0), a3, voffA);
            PG8_BAR; PG8_WAIT_L(0); PG8_MMA(1, 0, At, B0); PG8_BAR; PG8_SCHED;
            PG8_STAGE(PG8_SB(1, 1), b3 + hstep, voffB);
            PG8_WAIT_V(6); PG8_BAR; PG8_MMA(1, 1, At, B1); PG8_BAR;
            }
        }
        if constexpr (ALIGN_EPI) { if (wr == 0) PG8_BAR; }
        if constexpr (!Epi::AFTER_DRAIN) { E(acc, cur, wr, wc, fr, fq); S.done(cur); }
        if (!has_next) break;
#pragma unroll
        for (int a = 0; a < 2; ++a)
#pragma unroll
            for (int b = 0; b < 2; ++b)
#pragma unroll
                for (int m = 0; m < 4; ++m)
#pragma unroll
                    for (int n = 0; n < 2; ++n) acc[a][b][m][n] = (f32x4){0.f, 0.f, 0.f, 0.f};
        cur = nxt; cA = nA; cB = nB; ++ui;
        if constexpr (ALIGN_EPI) { if (wr == 1) PG8_BAR; }
    }
    PG8_WAIT_V(0);
    if constexpr (!ALIGN_EPI) { if (wr == 0) PG8_BAR; }
    PG8_BAR;
    if constexpr (Epi::AFTER_DRAIN) { E.fused(acc, cur, wr, wc, fr, fq, lds, wid, lane); S.done(cur); }
#undef PG8_SA
#undef PG8_SB
#undef PG8_STAGE
#undef PG8_LDA
#undef PG8_LDB
#undef PG8_MMA
#undef PG8_WAIT_V
#undef PG8_WAIT_L
#undef PG8_BAR
#undef PG8_SCHED
}
}
#define GAS __attribute__((address_space(1)))
#define LAS __attribute__((address_space(3)))
typedef unsigned short bf16;
typedef unsigned v4u __attribute__((ext_vector_type(4)));
typedef float f32x4 __attribute__((ext_vector_type(4)));
typedef short bf16x8 __attribute__((ext_vector_type(8)));
typedef GAS unsigned gu32;
typedef GAS unsigned long long gu64;
#define RLX_AGENT __ATOMIC_RELAXED, __HIP_MEMORY_SCOPE_AGENT
#define LDS_WAIT() asm volatile("s_waitcnt lgkmcnt(0)" ::: "memory")
#define VM_WAIT() asm volatile("s_waitcnt vmcnt(0)" ::: "memory")
__device__ __forceinline__ unsigned long long rt() { return __builtin_amdgcn_s_memrealtime(); }
__device__ __forceinline__ unsigned f2bf(float f) { unsigned u = __builtin_bit_cast(unsigned, f); return (u + 0x7fffu + ((u >> 16) & 1u)) >> 16; }
__device__ __forceinline__ unsigned pk2(float lo, float hi) { return f2bf(lo) | (f2bf(hi) << 16); }

namespace att {
typedef __attribute__((address_space(3))) const char* lds_cptr;
typedef __attribute__((address_space(3))) char* lds_ptr;
typedef __attribute__((address_space(3))) float* lds_fptr;
using s16x4 = __attribute__((ext_vector_type(4))) short;
using f32x16 = __attribute__((ext_vector_type(16))) float;
using u32x4 = __attribute__((ext_vector_type(4))) unsigned;
typedef short v4i16_t __attribute__((ext_vector_type(4)));
typedef float f32x2_t __attribute__((ext_vector_type(2))); typedef __bf16 bf16x2_t __attribute__((ext_vector_type(2)));
constexpr float C2 = 0.125f * 1.4426950408889634f;
__device__ __forceinline__ int crow(int r, int hi) { return (r & 3) + 8 * (r >> 2) + 4 * hi; }
__device__ __forceinline__ unsigned cvtpk_s(float lo, float hi) { f32x2_t v = {lo, hi}; bf16x2_t b = __builtin_convertvector(v, bf16x2_t); return __builtin_bit_cast(unsigned, b); }
__device__ __forceinline__ void glds16(const void* gsrc, unsigned lds_dst) { unsigned keep;
    asm volatile("s_mov_b32 %0, m0\n\ts_mov_b32 m0, %2\n\ts_nop 0\n\tglobal_load_lds_dwordx4 %1, off\n\ts_mov_b32 m0, %0" : "=&s"(keep) : "v"(gsrc), "s"(lds_dst) : "memory"); }
#define ATT_WAITV(N) asm volatile("s_waitcnt vmcnt(" #N ")" ::: "memory")
#define ATT_WAITL() asm volatile("s_waitcnt lgkmcnt(0)" ::: "memory")
#define ATT_BAR() asm volatile("s_waitcnt lgkmcnt(0)\n\ts_barrier" ::: "memory")
__device__ __forceinline__ s16x4 vtr(lds_cptr p) { return __builtin_bit_cast(s16x4, __builtin_amdgcn_ds_read_tr16_b64_v4i16((__attribute__((address_space(3))) v4i16_t*)p)); }

__device__ __forceinline__ int kswz(int row) { return (((row >> 1) & 1) << 2) | ((row >> 2) & 3); }
__device__ __forceinline__ void kread_offs(int (&ko)[4], int r32, int hi) {
#pragma unroll
    for (int d0 = 0; d0 < 4; ++d0) ko[d0] = r32 * 128 + (((2 * d0 + hi) ^ kswz(r32)) << 4);
}
__device__ __forceinline__ void qkt(f32x16& p0, f32x16& p1, lds_cptr kslot, const bf16x8* qr, const int (&ko)[4], float cinit) {
    f32x16 z;
#pragma unroll
    for (int r = 0; r < 16; ++r) z[r] = cinit;
    bf16x8 kf[8];
#pragma unroll
    for (int d0 = 0; d0 < 4; ++d0) { kf[2 * d0] = *(const __attribute__((address_space(3))) bf16x8*)(kslot + ko[d0]); kf[2 * d0 + 1] = *(const __attribute__((address_space(3))) bf16x8*)(kslot + ko[d0] + 4096); }
    __builtin_amdgcn_sched_barrier(0);
#pragma unroll
    for (int d0 = 0; d0 < 4; ++d0) {
        if (d0 == 0) { p0 = __builtin_amdgcn_mfma_f32_32x32x16_bf16(kf[0], qr[0], z, 0, 0, 0); p1 = __builtin_amdgcn_mfma_f32_32x32x16_bf16(kf[1], qr[0], z, 0, 0, 0); }
        else { p0 = __builtin_amdgcn_mfma_f32_32x32x16_bf16(kf[2 * d0], qr[d0], p0, 0, 0, 0); p1 = __builtin_amdgcn_mfma_f32_32x32x16_bf16(kf[2 * d0 + 1], qr[d0], p1, 0, 0, 0); }
    }
}
__device__ __forceinline__ int rowmax_bits(const f32x16& p0, const f32x16& p1) {
    int a, b;
    { const float f0 = p0[0], f1 = p1[0]; a = __float_as_int(f0); b = __float_as_int(f1); }
#pragma unroll
    for (int r = 1; r < 16; ++r) { const float f0 = p0[r], f1 = p1[r]; const int x = __float_as_int(f0), y = __float_as_int(f1); a = a > x ? a : x; b = b > y ? b : y; }
    const int m = a > b ? a : b;
    auto rr = __builtin_amdgcn_permlane32_swap((unsigned)m, (unsigned)m, false, false);
    return (int)rr[0] > (int)rr[1] ? (int)rr[0] : (int)rr[1];
}
__device__ __forceinline__ float rowmax(const f32x16& p0, const f32x16& p1) {
    float a = __builtin_fmaxf(p0[0], p1[0]), b = __builtin_fmaxf(p0[1], p1[1]);
#pragma unroll
    for (int r = 2; r < 16; r += 2) { a = __builtin_fmaxf(a, __builtin_fmaxf(p0[r], p1[r])); b = __builtin_fmaxf(b, __builtin_fmaxf(p0[r + 1], p1[r + 1])); }
    const float m = __builtin_fmaxf(a, b);
    auto rr = __builtin_amdgcn_permlane32_swap(__float_as_uint(m), __float_as_uint(m), false, false);
    return __builtin_fmaxf(__uint_as_float(rr[0]), __uint_as_float(rr[1]));
}
__device__ __forceinline__ float halfsum(float v) {
    auto rr = __builtin_amdgcn_permlane32_swap(__float_as_uint(v), __float_as_uint(v), false, false);
    return __uint_as_float(rr[0]) + __uint_as_float(rr[1]);
}
template <int NDB> __device__ __forceinline__ void vread_offs(int (&vo)[NDB][2], int lane) {
    const int hi = lane >> 5, g1 = (lane >> 4) & 1, q = (lane & 15) >> 2, p = lane & 3, cl = 2 * g1 + (p >> 1);
#pragma unroll
    for (int d0 = 0; d0 < NDB; ++d0)
#pragma unroll
        for (int h8 = 0; h8 < 2; ++h8) {
            const int row = 8 * h8 + 4 * hi + q, c = 4 * d0 + cl;
            if (NDB == 2) vo[d0][h8] = row * 128 + ((c ^ kswz(row)) << 4) + 8 * (p & 1);
            else vo[d0][h8] = row * 256 + ((c ^ ((row & 3) << 2)) << 4) + 8 * (p & 1);
        }
}
constexpr float SM_THR = 4.0f;
template <int NDB>
__device__ __forceinline__ void softmax_pv(f32x16& p0, f32x16& p1, float& m_run, float& l_run, bool first, f32x16 (&o)[NDB], lds_cptr vslot, const int (&vo)[NDB][2], lds_fptr wsf, int r32, int hi) {
    const int mb = rowmax_bits(p0, p1);
    if (__any(first || mb > __builtin_bit_cast(int, SM_THR))) {
        const float rm = rowmax(p0, p1);
        const float dl = first ? rm : __builtin_fmaxf(rm, 0.f);
        m_run += dl;
#pragma unroll
        for (int r = 0; r < 16; ++r) { p0[r] -= dl; p1[r] -= dl; }
        if (!first) {
            const float alpha = __builtin_amdgcn_exp2f(-dl);
            l_run *= alpha;
            if (hi == 0) wsf[r32] = alpha;
            ATT_WAITL();
#pragma unroll
            for (int g = 0; g < 4; ++g) {
                const f32x4 a4 = *(const __attribute__((address_space(3))) f32x4*)(wsf + 8 * g + 4 * hi);
#pragma unroll
                for (int d = 0; d < NDB; ++d) { o[d][4 * g + 0] *= a4[0]; o[d][4 * g + 1] *= a4[1]; o[d][4 * g + 2] *= a4[2]; o[d][4 * g + 3] *= a4[3]; }
            }
        }
    }
    float s = 0.f;
#pragma unroll
    for (int r = 0; r < 16; ++r) { p0[r] = __builtin_amdgcn_exp2f(p0[r]); p1[r] = __builtin_amdgcn_exp2f(p1[r]); s += p0[r] + p1[r]; }
    l_run += s;
    u32x4 pw[4];
#pragma unroll
    for (int k = 0; k < 2; ++k) { pw[k] = (u32x4){cvtpk_s(p0[8 * k], p0[8 * k + 1]), cvtpk_s(p0[8 * k + 2], p0[8 * k + 3]), cvtpk_s(p0[8 * k + 4], p0[8 * k + 5]), cvtpk_s(p0[8 * k + 6], p0[8 * k + 7])};
        pw[2 + k] = (u32x4){cvtpk_s(p1[8 * k], p1[8 * k + 1]), cvtpk_s(p1[8 * k + 2], p1[8 * k + 3]), cvtpk_s(p1[8 * k + 4], p1[8 * k + 5]), cvtpk_s(p1[8 * k + 6], p1[8 * k + 7])}; }
    s16x4 fa[8], fb[8];
#pragma unroll
    for (int ks = 0; ks < 4; ++ks) { fa[2 * ks] = vtr(vslot + vo[0][0] + ks * (1024 * NDB)); fa[2 * ks + 1] = vtr(vslot + vo[0][1] + ks * (1024 * NDB)); }
#pragma unroll
    for (int d0 = 0; d0 < NDB; ++d0) {
        __builtin_amdgcn_sched_barrier(0);
        if (d0 + 1 < NDB) {
#pragma unroll
            for (int ks = 0; ks < 4; ++ks) { if (d0 & 1) { fa[2 * ks] = vtr(vslot + vo[d0 + 1 < NDB ? d0 + 1 : 0][0] + ks * (1024 * NDB)); fa[2 * ks + 1] = vtr(vslot + vo[d0 + 1 < NDB ? d0 + 1 : 0][1] + ks * (1024 * NDB)); }
                else { fb[2 * ks] = vtr(vslot + vo[d0 + 1 < NDB ? d0 + 1 : 0][0] + ks * (1024 * NDB)); fb[2 * ks + 1] = vtr(vslot + vo[d0 + 1 < NDB ? d0 + 1 : 0][1] + ks * (1024 * NDB)); } }
        }
        __builtin_amdgcn_sched_barrier(0);
#pragma unroll
        for (int ks = 0; ks < 4; ++ks) {
            const s16x4 lo = (d0 & 1) ? fb[2 * ks] : fa[2 * ks], hh = (d0 & 1) ? fb[2 * ks + 1] : fa[2 * ks + 1];
            const bf16x8 vb = (bf16x8){lo[0], lo[1], lo[2], lo[3], hh[0], hh[1], hh[2], hh[3]};
            o[d0] = __builtin_amdgcn_mfma_f32_32x32x16_bf16(__builtin_bit_cast(bf16x8, pw[ks]), vb, o[d0], 0, 0, 0);
        }
    }
}
template <int NDB>
__device__ __forceinline__ void pv_only(f32x16 (&o)[NDB], const u32x4 (&pw)[4], lds_cptr vslot, const int (&vo)[NDB][2]) {
#pragma unroll
    for (int d0 = 0; d0 < NDB; ++d0)
#pragma unroll
        for (int ks = 0; ks < 4; ++ks) {
            const s16x4 lo = vtr(vslot + vo[d0][0] + ks * (1024 * NDB)), hh = vtr(vslot + vo[d0][1] + ks * (1024 * NDB));
            const bf16x8 vb = (bf16x8){lo[0], lo[1], lo[2], lo[3], hh[0], hh[1], hh[2], hh[3]};
            o[d0] = __builtin_amdgcn_mfma_f32_32x32x16_bf16(__builtin_bit_cast(bf16x8, pw[ks]), vb, o[d0], 0, 0, 0);
        }
}
template <int NDB>
__device__ __forceinline__ float finish_o(float l_run, f32x16 (&o)[NDB], lds_fptr wsf, int r32, int hi) {
    const float l = halfsum(l_run);
    if (hi == 0) wsf[32 + r32] = 1.0f / l;
    ATT_WAITL();
#pragma unroll
    for (int g = 0; g < 4; ++g) {
        const f32x4 a4 = *(const __attribute__((address_space(3))) f32x4*)(wsf + 32 + 8 * g + 4 * hi);
#pragma unroll
        for (int d = 0; d < NDB; ++d) { o[d][4 * g + 0] *= a4[0]; o[d][4 * g + 1] *= a4[1]; o[d][4 * g + 2] *= a4[2]; o[d][4 * g + 3] *= a4[3]; }
    }
    return l;
}
}

constexpr int NWAVES = 8;
constexpr int NB = 8, SEQ = 4096, DM = 1024, TT = NB * SEQ;
constexpr int MEMT = 256, MEMROWS = NB * MEMT;
constexpr int INW = 2560, SKVW = 4608, PQW = 2048, MKVW = 512;
constexpr int NEXP = 16384;
constexpr float EPS = 1e-5f;
constexpr int NPHASE = 25;

constexpr size_t MiB = 1u << 20;
constexpr size_t WS_CTL = 0, CTL_ZERO_BYTES = 1 * MiB;
constexpr size_t WS_WA = 1 * MiB, WS_WB = 11 * MiB, WS_WMKV = 21 * MiB, WS_WOUT = 25 * MiB, WS_WPQ = 33 * MiB, WS_WSKV = 49 * MiB, WS_PKEYS = 58 * MiB, WS_ROPE = 60 * MiB, WS_SS = 61 * MiB, WS_MEMKV = 63 * MiB;
constexpr size_t WS_PU = 96 * MiB, WS_PV = 160 * MiB;
constexpr int PROW = 544;
constexpr size_t WS_XN = 352 * MiB, WS_XB = 416 * MiB, WS_PROJ = 480 * MiB, WS_MIX = 640 * MiB, WS_SKV = 704 * MiB, WS_END = 992 * MiB;
constexpr size_t WS_MEMN = WS_SKV;
constexpr size_t WS_OG = 224 * MiB;
constexpr size_t WS_LSEG = 368 * MiB;
static_assert(WS_OG + (size_t)TT * 2304 * 2 <= WS_LSEG && WS_LSEG + (size_t)TT * 36 * 4 <= WS_XB + 64 * MiB && WS_OG >= WS_PV + 50 * MiB, "OG scratch");
constexpr int CW_BAR = 4096;

constexpr int RING_OFF = 0, RING_BYTES = 131072;
constexpr int LDSCTL_OFF = RING_BYTES, MISC_OFF = LDSCTL_OFF + 320;
constexpr int PEER_SCR = LDSCTL_OFF + 1024;
constexpr int LDS_BYTES = 163840;
static_assert(PEER_SCR + 8 * 2048 <= LDS_BYTES, "LDS map");

#define XB_TMO      128
#define XB_XCNT(j)  (256  + 64 * (j))
#define XB_XSUB(j)  (1280 + 64 * (j))
#define XB_XGEN(j)  (2304 + 64 * (j))
#define XB_TOP      3328
#define XB_TOPGEN   3392
#define XCD_BAR_WORDS 3456
#define XB_SPIN_CAP (1u << 18)

__device__ __forceinline__ unsigned xb_ld(unsigned* p)              { return __hip_atomic_load(p, __ATOMIC_RELAXED, __HIP_MEMORY_SCOPE_AGENT); }
__device__ __forceinline__ unsigned xb_add(unsigned* p, unsigned v) { return __hip_atomic_fetch_add(p, v, __ATOMIC_RELAXED, __HIP_MEMORY_SCOPE_AGENT); }
__device__ __forceinline__ unsigned xb_xcc_id() { return (unsigned)__builtin_amdgcn_s_getreg((3 << 11) | 20) & 0xFu; }
#define XB_SPIN(cond, bar) do { unsigned _sp = 0; while (cond) { __builtin_amdgcn_s_sleep(1); \
    if ((++_sp & 255u) == 0u) { if (xb_ld(&(bar)[XB_TMO])) break; if (_sp > XB_SPIN_CAP) { atomicAdd(&(bar)[XB_TMO], 1u); break; } } } } while (0)

struct XcdBarrier {
    unsigned* bar; unsigned x;
    volatile LAS unsigned* st;
};

__device__ __forceinline__ XcdBarrier xcd_barrier_post(unsigned* bar, volatile LAS unsigned* st) {
    XcdBarrier b; b.bar = bar; b.x = xb_xcc_id(); b.st = st;
    if (threadIdx.x == 0) (void)xb_add(&bar[XB_XCNT(b.x)], 1u);
    return b;
}
__device__ __forceinline__ void xcd_barrier_complete(unsigned* bar, unsigned x, unsigned& nloc, unsigned& nx) {
    const unsigned G = gridDim.x * gridDim.y * gridDim.z;
    unsigned sum, cnt, mine, sp = 0u;
    for (;;) {
        sum = 0u; cnt = 0u; mine = 0u;
#pragma unroll
        for (unsigned j = 0; j < 16; ++j) { const unsigned c = xb_ld(&bar[XB_XCNT(j)]); sum += c; cnt += (c > 0u) ? 1u : 0u; mine = (j == x) ? c : mine; }
        if (sum == G) break;
        __builtin_amdgcn_s_sleep(1);
        if ((++sp & 255u) == 0u) { if (xb_ld(&bar[XB_TMO])) break; if (sp > XB_SPIN_CAP) { atomicAdd(&bar[XB_TMO], 1u); break; } }
    }
    nloc = mine > 0u ? mine : 1u; nx = cnt > 0u ? cnt : 1u;
}

__device__ __forceinline__ void xcd_barrier(const XcdBarrier& b) {
    asm volatile("s_waitcnt vmcnt(0)" ::: "memory");
    __syncthreads();
    if (threadIdx.x == 0) {
        unsigned* bar = b.bar;
        __builtin_amdgcn_s_waitcnt(0);
        unsigned nloc = b.st[0], nx = b.st[1];
        if (nloc == 0u) { xcd_barrier_complete(bar, b.x, nloc, nx); b.st[0] = nloc; b.st[1] = nx; }
        const unsigned old = xb_add(&bar[XB_XSUB(b.x)], 1u);
        const unsigned gen = old / nloc;
        if (old + 1u == (gen + 1u) * nloc) {
            __builtin_amdgcn_fence(__ATOMIC_RELEASE, "agent");
            asm volatile("s_waitcnt vmcnt(0)" ::: "memory");
            const unsigned og = xb_add(&bar[XB_TOP], 1u);
            const unsigned tg = og / nx;
            if (og + 1u == (tg + 1u) * nx) xb_add(&bar[XB_TOPGEN], 1u);
            else XB_SPIN(xb_ld(&bar[XB_TOPGEN]) == tg, bar);
            __builtin_amdgcn_fence(__ATOMIC_ACQUIRE, "agent");
            xb_add(&bar[XB_XGEN(b.x)], 1u);
            asm volatile("s_waitcnt vmcnt(0)" ::: "memory");
        } else {
            XB_SPIN(xb_ld(&bar[XB_XGEN(b.x)]) == gen, bar);
            __builtin_amdgcn_fence(__ATOMIC_ACQUIRE, "agent");
            asm volatile("s_waitcnt vmcnt(0)" ::: "memory");
        }
    }
    __syncthreads();
}

struct Frame {
    LAS unsigned char* lds;
    volatile LAS unsigned* MISC;
    int tid, lane, wave, vcu, G, bx;
    const unsigned char __attribute__((address_space(4)))* ka;
};
__device__ __forceinline__ Frame make_frame() {
    extern __shared__ __attribute__((aligned(16))) unsigned char lds_dyn_[];
    Frame F; int tid = threadIdx.x, bx = blockIdx.x, G = gridDim.x;
    asm volatile("" : "+v"(tid)); asm volatile("" : "+s"(bx), "+s"(G));
    F.lds = (LAS unsigned char*)lds_dyn_; F.MISC = (volatile LAS unsigned*)(F.lds + MISC_OFF);
    F.tid = tid; F.lane = tid & 63; F.wave = __builtin_amdgcn_readfirstlane(tid >> 6);
    F.G = G; F.vcu = (G % 8 == 0) ? (bx % 8) * (G / 8) + bx / 8 : bx; F.bx = bx;
    F.ka = (const unsigned char __attribute__((address_space(4)))*)__builtin_amdgcn_kernarg_segment_ptr();
    return F;
}
__device__ __forceinline__ const unsigned char __attribute__((address_space(4)))* ka_fresh(const Frame& F) { const unsigned char __attribute__((address_space(4)))* p = F.ka; asm volatile("" : "+s"(p)); return p; }
#define KA_IN(kp, i) (*(const float* const __attribute__((address_space(4)))*)((kp) + 8 * (i)))
#define KA_OUT(kp) (*(float* const __attribute__((address_space(4)))*)((kp) + 144))
#define KA_WS(kp) (*(unsigned char* const __attribute__((address_space(4)))*)((kp) + 152))
#define WSP(T, off) ((T*)(ws_ + (off)))
__device__ __forceinline__ float wave_sum(float v) { return wave_sum_valu(v); }
__device__ __forceinline__ unsigned cvtpk(float lo, float hi) { return att::cvtpk_s(lo, hi); }

__device__ __forceinline__ void p0_transpose_item(const float* W, int K, int N, bf16* WT, const float* gain, LAS float* scr, int item, int lane) {
    const int nblk = N / 32, kb = item / nblk, nb = item % nblk, k0 = 64 * kb, n0 = 32 * nb;
#pragma unroll 8
    for (int i = 0; i < 32; ++i) { const int kk = 2 * i + (lane >> 5); float w = W[(size_t)(k0 + kk) * N + n0 + (lane & 31)]; if (gain) w *= gain[k0 + kk]; scr[kk * 33 + (lane & 31)] = w; }
    LDS_WAIT(); asm volatile("" ::: "memory");
    const int c = lane & 7;
#pragma unroll
    for (int j = 0; j < 4; ++j) { const int n = (lane >> 3) + 8 * j; const LAS float* s = scr + (8 * c) * 33 + n;
        v4u o; o.x = cvtpk(s[0 * 33], s[1 * 33]); o.y = cvtpk(s[2 * 33], s[3 * 33]); o.z = cvtpk(s[4 * 33], s[5 * 33]); o.w = cvtpk(s[6 * 33], s[7 * 33]);
        *(GAS v4u*)(WT + (size_t)(n0 + n) * K + k0 + 8 * c) = o; }
    LDS_WAIT(); asm volatile("" ::: "memory");
}
__device__ __forceinline__ void cvt_row(const float* src, bf16* dst, int lane) {
    const GAS f32x4* s = (const GAS f32x4*)src + lane; GAS unsigned long long* d = (GAS unsigned long long*)dst + lane;
    f32x4 v[4];
#pragma unroll
    for (int j = 0; j < 4; ++j) v[j] = s[64 * j];
#pragma unroll
    for (int j = 0; j < 4; ++j) d[64 * j] = (unsigned long long)cvtpk(v[j].x, v[j].y) | ((unsigned long long)cvtpk(v[j].z, v[j].w) << 32);
}
template <bool PERM> __device__ __forceinline__ void cvt_2rows_fp4(const float* src, unsigned char* dst, int lane) {
    const int l = lane & 31, h = lane >> 5;
    const GAS f32x4* s = (const GAS f32x4*)(src + (size_t)h * DM + 32 * l);
    f32x4 v[8]; float am = 0.f;
#pragma unroll
    for (int j = 0; j < 8; ++j) { v[j] = s[j]; am = __builtin_fmaxf(am, __builtin_fmaxf(__builtin_fmaxf(__builtin_fabsf(v[j].x), __builtin_fabsf(v[j].y)), __builtin_fmaxf(__builtin_fabsf(v[j].z), __builtin_fabsf(v[j].w)))); }
    const unsigned tb = __float_as_uint(am * (1.0f / 6.0f));
    int eb = (int)(tb >> 23) + ((tb & 0x7fffffu) ? 1 : 0); eb = eb < 1 ? 1 : (eb > 254 ? 254 : eb);
    const float sc = __uint_as_float((unsigned)eb << 23);
    unsigned p[4];
#pragma unroll
    for (int k = 0; k < 4; ++k) { unsigned w = 0u;
        w = __builtin_amdgcn_cvt_scalef32_pk_fp4_f32(w, v[2 * k].x, v[2 * k].y, sc, 0); w = __builtin_amdgcn_cvt_scalef32_pk_fp4_f32(w, v[2 * k].z, v[2 * k].w, sc, 1);
        w = __builtin_amdgcn_cvt_scalef32_pk_fp4_f32(w, v[2 * k + 1].x, v[2 * k + 1].y, sc, 2); w = __builtin_amdgcn_cvt_scalef32_pk_fp4_f32(w, v[2 * k + 1].z, v[2 * k + 1].w, sc, 3); p[k] = w; }
    unsigned char* d = dst + (size_t)h * PROW;
    *(GAS v4u*)(d + 16 * l) = (v4u){p[0], p[1], p[2], p[3]};
    d[512 + (PERM ? 8 * (l & 3) + (l >> 2) : l)] = (unsigned char)eb;
}
__device__ __forceinline__ void rms_row(const float* xrow, const float* g, bf16* orow, bf16* cp, int lane) {
    const GAS f32x4* xr = (const GAS f32x4*)xrow + lane; const GAS f32x4* gr = (const GAS f32x4*)g + lane;
    f32x4 v[4]; float s = 0.f;
#pragma unroll
    for (int j = 0; j < 4; ++j) { v[j] = xr[64 * j]; s += (v[j].x * v[j].x + v[j].y * v[j].y) + (v[j].z * v[j].z + v[j].w * v[j].w); }
    if (cp) { GAS unsigned long long* c = (GAS unsigned long long*)cp + lane;
#pragma unroll
        for (int j = 0; j < 4; ++j) c[64 * j] = (unsigned long long)cvtpk(v[j].x, v[j].y) | ((unsigned long long)cvtpk(v[j].z, v[j].w) << 32); }
    const float rstd = 1.0f / sqrtf(wave_sum(s) * (1.f / DM) + EPS);
    GAS unsigned long long* o8 = (GAS unsigned long long*)orow + lane;
#pragma unroll
    for (int j = 0; j < 4; ++j) { const f32x4 gg = gr[64 * j]; o8[64 * j] = (unsigned long long)cvtpk(v[j].x * rstd * gg.x, v[j].y * rstd * gg.y) | ((unsigned long long)cvtpk(v[j].z * rstd * gg.z, v[j].w * rstd * gg.w) << 32); }
}
__device__ __forceinline__ void p0_prologue(Frame& F) {
    const auto kp_ = ka_fresh(F); unsigned char* const ws_ = KA_WS(kp_); float* const out_ = KA_OUT(kp_);
#define FIN(i) KA_IN(kp_, i)
    LAS float* scr = (LAS float*)(F.lds + RING_OFF + F.wave * 16384);
    const int gw = F.vcu * NWAVES + F.wave, NGW = F.G * NWAVES, lane = F.lane;
    constexpr int I_IN = 16 * (INW / 32), I_MKV = 16 * (MKVW / 32), I_OUT = 16 * (DM / 32), I_PQ = 16 * (PQW / 32), I_SKV = 16 * (SKVW / 32);
    constexpr int E0 = 2 * I_IN, E1 = E0 + 2 * I_IN, E2 = E1 + 4 * I_MKV, E3 = E2 + 4 * I_OUT, E4 = E3 + 4 * I_PQ, E5 = E4 + I_SKV;
    for (int it = gw; it < E5; it += NGW) {
        if (it < E0) { const int l = it / I_IN, r = it % I_IN; p0_transpose_item(FIN(3) + (size_t)l * DM * INW, DM, INW, WSP(bf16, WS_WA) + (size_t)l * INW * DM, nullptr, scr, r, lane); }
        else if (it < E1) { const int q = it - E0, l = q / I_IN, r = q % I_IN; p0_transpose_item(FIN(6) + (size_t)l * DM * INW, DM, INW, WSP(bf16, WS_WB) + (size_t)l * INW * DM, nullptr, scr, r, lane); }
        else if (it < E2) { const int q = it - E1, l = q / I_MKV, r = q % I_MKV; p0_transpose_item(FIN(8) + (size_t)l * DM * MKVW, DM, MKVW, WSP(bf16, WS_WMKV) + (size_t)l * MKVW * DM, nullptr, scr, r, lane); }
        else if (it < E3) { const int q = it - E2, l = q / I_OUT, r = q % I_OUT; p0_transpose_item(FIN(9) + (size_t)l * DM * DM, DM, DM, WSP(bf16, WS_WOUT) + (size_t)l * DM * DM, nullptr, scr, r, lane); }
        else if (it < E4) { const int q = it - E3, l = q / I_PQ, r = q % I_PQ; p0_transpose_item(FIN(11) + (size_t)l * DM * PQW, DM, PQW, WSP(bf16, WS_WPQ) + (size_t)l * PQW * DM, FIN(10) + l * DM, scr, r, lane); }
        else { const int r = it - E4; p0_transpose_item(FIN(16), DM, SKVW, WSP(bf16, WS_WSKV), nullptr, scr, r, lane); }
    }
    for (int r2 = gw; r2 < 2 * NEXP; r2 += NGW) { cvt_2rows_fp4<true>(FIN(13) + (size_t)r2 * 2 * DM, WSP(unsigned char, WS_PU) + (size_t)r2 * 2 * PROW, lane); cvt_2rows_fp4<false>(FIN(14) + (size_t)r2 * 2 * DM, WSP(unsigned char, WS_PV) + (size_t)r2 * 2 * PROW, lane); }
    for (int r = gw; r < 1024; r += NGW) cvt_row(FIN(12) + (size_t)r * 1024, WSP(bf16, WS_PKEYS) + (size_t)r * 1024, lane);
    for (int e = gw * 64 + lane; e < SEQ * 8; e += NGW * 64) { const int t = e >> 3, i = e & 7;
        const double ang = (double)t * pow(500000.0, -(double)i / 8.0);
        WSP(float, WS_ROPE)[t * 16 + i] = (float)cos(ang); WSP(float, WS_ROPE)[t * 16 + 8 + i] = (float)sin(ang); }
    for (int r = gw; r < 4 * MEMROWS; r += NGW) { const int l = r / MEMROWS, m = r % MEMROWS; rms_row(FIN(1) + (size_t)m * DM, FIN(7) + l * DM, WSP(bf16, WS_MEMN) + (size_t)r * DM, nullptr, lane); }
    for (int m = gw; m < TT; m += NGW) rms_row(FIN(0) + (size_t)m * DM, FIN(2), WSP(bf16, WS_XN) + (size_t)m * DM, WSP(bf16, WS_XB) + (size_t)m * DM, lane);
}
#undef FIN

__device__ __forceinline__ void diff_unit(Frame& F, int b, int h, int ib, const bf16* PROJ, bf16* MIX, float lam, float oml, const float* subg) {
    using namespace att;
    const int lane = F.lane, r32 = lane & 31, hi = lane >> 5, w = F.wave, p = w >> 2, wq = w & 3;
    const lds_cptr L = (lds_cptr)(F.lds + RING_OFF);
    const unsigned lds0 = (unsigned)(uintptr_t)(F.lds + RING_OFF);
    lds_fptr wsf = (lds_fptr)(F.lds + RING_OFF + 98304 + w * 256);
    const size_t rb = (size_t)b * SEQ;
    const bf16* Qw = PROJ + (rb + 128 * ib + 32 * wq + r32) * INW + (2 * h + p) * 64;
    const bf16* Kg = PROJ + rb * INW + 768 + (2 * h) * 64;
    const bf16* Vg = PROJ + rb * INW + 1536 + h * 128;
    const int NT = 2 * (ib + 1);
    const int krow_ = 8 * w + (lane >> 3), kch_ = (lane & 7) ^ kswz(krow_);
    const bf16* ksrc0 = Kg + (size_t)krow_ * INW + kch_ * 8;
    const bf16* ksrc1 = ksrc0 + 64;
    const int vrow_ = 8 * w + (lane >> 4), vch_ = (lane & 15) ^ ((vrow_ & 3) << 2);
    const bf16* vsrc0 = Vg + (size_t)vrow_ * INW + vch_ * 8;
    const bf16* vsrc1 = vsrc0 + (size_t)4 * INW;
#define DIFF_ISSUE(t, slot) do { const size_t go_ = (size_t)(t) * 64 * INW; const unsigned sb_ = lds0 + (slot) * 32768; \
        glds16(ksrc0 + go_, (unsigned)__builtin_amdgcn_readfirstlane(sb_ + w * 1024)); glds16(ksrc1 + go_, (unsigned)__builtin_amdgcn_readfirstlane(sb_ + 8192 + w * 1024)); \
        glds16(vsrc0 + go_, (unsigned)__builtin_amdgcn_readfirstlane(sb_ + 16384 + w * 2048)); glds16(vsrc1 + go_, (unsigned)__builtin_amdgcn_readfirstlane(sb_ + 16384 + w * 2048 + 1024)); } while (0)
    DIFF_ISSUE(0, 0); DIFF_ISSUE(1, 1);
    bf16x8 qr[4];
#pragma unroll
    for (int d0 = 0; d0 < 4; ++d0) qr[d0] = *(const bf16x8*)(Qw + d0 * 16 + hi * 8);
    asm volatile("" : "+v"(qr[0]), "+v"(qr[1]), "+v"(qr[2]), "+v"(qr[3]));
    float m_run = 0.f, l_run = 0.f; f32x16 o[4];
#pragma unroll
    for (int d = 0; d < 4; ++d) o[d] = f32x16{};
    const int qrel = 32 * wq + r32; int ko[4], vo[4][2]; kread_offs(ko, r32, hi); vread_offs<4>(vo, lane);
    int sl = 0;
    for (int t = 0; t < NT; ++t) {
        if (t + 1 < NT) ATT_WAITV(4); else ATT_WAITV(0);
        ATT_BAR();
        if (t + 2 < NT) DIFF_ISSUE(t + 2, (sl >= 1 ? sl - 1 : 2));
        const lds_cptr S = L + sl * 32768;
        f32x16 p0, p1;
        qkt(p0, p1, S + p * 8192, qr, ko, -m_run);
        const int jb = t - (NT - 2);
        if (jb >= 0) { const int kb = 64 * jb + 4 * hi;
#pragma unroll
            for (int r = 0; r < 16; ++r) { const int kv = kb + (r & 3) + 8 * (r >> 2); if (kv > qrel) p0[r] = -INFINITY; if (kv + 32 > qrel) p1[r] = -INFINITY; } }
        softmax_pv<4>(p0, p1, m_run, l_run, t == 0, o, S + 16384, vo, wsf, r32, hi);
        sl = sl == 2 ? 0 : sl + 1;
    }
#undef DIFF_ISSUE
    finish_o<4>(l_run, o, wsf, r32, hi);
    ATT_BAR();
    lds_fptr X = (lds_fptr)(F.lds + RING_OFF) + wq * 4096;
    if (p == 1) {
#pragma unroll
        for (int d = 0; d < 4; ++d)
#pragma unroll
            for (int r = 0; r < 16; ++r) X[(d * 16 + r) * 64 + lane] = o[d][r];
    }
    ATT_BAR();
    if (p == 0) {
        float ss[16];
#pragma unroll
        for (int r = 0; r < 16; ++r) ss[r] = 0.f;
#pragma unroll
        for (int d = 0; d < 4; ++d)
#pragma unroll
            for (int r = 0; r < 16; ++r) { const float v = o[d][r] - lam * X[(d * 16 + r) * 64 + lane]; o[d][r] = v; ss[r] += v * v; }
#pragma unroll
        for (int r = 0; r < 16; ++r) {
            float s = ss[r];
            s = half32_sum(s);
            ss[r] = oml / sqrtf(s * (1.f / 128.f) + EPS);
        }
        LAS unsigned short* stg = (LAS unsigned short*)(F.lds + RING_OFF + 65536 + wq * 8192);
#pragma unroll
        for (int d = 0; d < 4; ++d) { const float g = subg[32 * d + r32];
#pragma unroll
            for (int r = 0; r < 16; ++r) { const unsigned short hb = (unsigned short)(cvtpk(o[d][r] * ss[r] * g, 0.f) & 0xffffu); stg[crow(r, hi) * 128 + 32 * d + r32] = hb; } }
        ATT_WAITL();
        bf16* Ow = MIX + (rb + 128 * ib + 32 * wq) * DM + h * 128;
#pragma unroll
        for (int i = 0; i < 8; ++i) { const int idx = i * 64 + lane, row = idx >> 4, ch = idx & 15;
            const u32x4 v = *(const LAS u32x4*)(stg + row * 128 + ch * 8); *(u32x4*)(Ow + (size_t)row * DM + ch * 8) = v; }
    }
    ATT_BAR();
}

constexpr int WP_STRIDE = 16384;
struct MemMap {
    int base;
    __device__ __forceinline__ int nt() const { return 4; }
    __device__ __forceinline__ int first() const { return 0; }
    __device__ __forceinline__ int krow(int tt, int j) const { return base + 64 * tt + j; }
    __device__ __forceinline__ void mask(int, att::f32x16&, att::f32x16&, int, int) const {}
};
struct DilMap {
    int rowbase, d, res, m0, ks, Lm1;
    __device__ __forceinline__ int nt() const { return 3; }
    __device__ __forceinline__ int first() const { return ks + 64 <= 0 ? (ks + 128 <= 0 ? 2 : 1) : 0; }
    __device__ __forceinline__ int krow(int tt, int j) const { int mp = ks + 64 * tt + j; mp = mp < 0 ? 0 : (mp > Lm1 ? Lm1 : mp); return rowbase + mp * d + res; }
    __device__ __forceinline__ void mask(int tt, att::f32x16& p0, att::f32x16& p1, int r32, int hi) const {
        const int m = m0 + r32, kb = ks + 64 * tt + 4 * hi;
#pragma unroll
        for (int r = 0; r < 16; ++r) { const int mp = kb + (r & 3) + 8 * (r >> 2);
            if (mp < 0 || mp > m || mp < m - 128) p0[r] = -INFINITY;
            if (mp + 32 < 0 || mp + 32 > m || mp + 32 < m - 128) p1[r] = -INFINITY; }
    }
};
template <class KM>
__device__ __forceinline__ void win_attn(Frame& F, const KM& km, const bf16* qp, const bf16* Kg, int pitchK, const bf16* Vg, int pitchV, att::f32x16 (&o)[2], float& m_out, float& l_out) {
    using namespace att;
    const int lane = F.lane, r32 = lane & 31, hi = lane >> 5, w = F.wave;
    const unsigned kdst = (unsigned)(uintptr_t)(F.lds + RING_OFF + w * WP_STRIDE), vdst = kdst + 8192;
    const lds_cptr Ks = (lds_cptr)(F.lds + RING_OFF + w * WP_STRIDE), Vs = Ks + 8192;
    lds_fptr wsf = (lds_fptr)(F.lds + PEER_SCR + w * 256);
    bf16x8 qr[4];
#pragma unroll
    for (int d0 = 0; d0 < 4; ++d0) qr[d0] = *(const bf16x8*)(qp + d0 * 16 + hi * 8);
    asm volatile("" : "+v"(qr[0]), "+v"(qr[1]), "+v"(qr[2]), "+v"(qr[3]));
    float m_run = 0.f, l_run = 0.f;
    o[0] = f32x16{}; o[1] = f32x16{};
    int ko[4], vo[2][2]; kread_offs(ko, r32, hi); vread_offs<2>(vo, lane);
#define WP_ISSUE_K(tt) do { _Pragma("unroll") for (int i_ = 0; i_ < 8; ++i_) { const int row_ = 8 * i_ + (lane >> 3); \
        glds16(Kg + (size_t)km.krow(tt, row_) * pitchK + (((lane & 7) ^ kswz(row_)) << 3), (unsigned)__builtin_amdgcn_readfirstlane(kdst + i_ * 1024)); } } while (0)
#define WP_ISSUE_V(tt) do { _Pragma("unroll") for (int i_ = 0; i_ < 8; ++i_) { const int row_ = 8 * i_ + (lane >> 3); \
        glds16(Vg + (size_t)km.krow(tt, row_) * pitchV + (((lane & 7) ^ kswz(row_)) << 3), (unsigned)__builtin_amdgcn_readfirstlane(vdst + i_ * 1024)); } } while (0)
    const int t0 = km.first(), nt = km.nt();
    ATT_WAITL();
    WP_ISSUE_K(t0); WP_ISSUE_V(t0);
    for (int tt = t0; tt < nt; ++tt) {
        ATT_WAITV(8);
        f32x16 p0, p1;
        qkt(p0, p1, Ks, qr, ko, -m_run);
        if (tt + 1 < nt) { ATT_WAITL(); WP_ISSUE_K(tt + 1); ATT_WAITV(8); } else { ATT_WAITV(0); }
        km.mask(tt, p0, p1, r32, hi);
        softmax_pv<2>(p0, p1, m_run, l_run, tt == t0, o, Vs, vo, wsf, r32, hi);
        if (tt + 1 < nt) { ATT_WAITL(); WP_ISSUE_V(tt + 1); }
    }
#undef WP_ISSUE_K
#undef WP_ISSUE_V
    l_out = finish_o<2>(l_run, o, wsf, r32, hi);
    m_out = m_run;
}
template <class RowOff>
__device__ __forceinline__ void win_store(Frame& F, const att::f32x16 (&o)[2], bf16* dst, const RowOff& rowoff) {
    using namespace att;
    const int lane = F.lane, r32 = lane & 31, hi = lane >> 5;
    LAS unsigned short* stg = (LAS unsigned short*)(F.lds + RING_OFF + F.wave * WP_STRIDE);
    ATT_WAITL();
#pragma unroll
    for (int r = 0; r < 16; ++r) { const int orow = crow(r, hi);
#pragma unroll
        for (int d0 = 0; d0 < 2; ++d0) stg[orow * 64 + d0 * 32 + r32] = (unsigned short)(cvtpk(o[d0][r], 0.f) & 0xffffu); }
    ATT_WAITL();
#pragma unroll
    for (int i = 0; i < 4; ++i) { const int row = i * 8 + (lane >> 3), ch = lane & 7; const u32x4 v = *(const LAS u32x4*)(stg + row * 64 + ch * 8); *(u32x4*)(dst + rowoff(row) + ch * 8) = v; }
    ATT_WAITL();
}
__device__ __forceinline__ void mem_attn_all(Frame& F, const bf16* PROJ, const bf16* MKV, bf16* MIX) {
    const int gw = F.vcu * NWAVES + F.wave, NGW = F.G * NWAVES, r32 = F.lane & 31;
    for (int qb = gw; qb < NB * 4 * (SEQ / 32); qb += NGW) {
        const int blk = qb % (SEQ / 32), mh = (qb / (SEQ / 32)) & 3, b = qb / (4 * (SEQ / 32));
        const size_t row0 = (size_t)b * SEQ + 32 * blk;
        MemMap km{b * MEMT};
        att::f32x16 o[2]; float m_, l_;
        win_attn(F, km, PROJ + (row0 + r32) * INW + 2304 + mh * 64, MKV + mh * 64, MKVW, MKV + 256 + mh * 64, MKVW, o, m_, l_);
        win_store(F, o, MIX + row0 * DM + 768 + mh * 64, [](int i) { return (size_t)i * DM; });
    }
}
__device__ __forceinline__ void dil_strip(Frame& F, int b, int head, int res, int s, int d, const bf16* PROJ, const bf16* SKV, bf16* OG, float* LSEG) {
    using namespace att;
    const int lane = F.lane, r32 = lane & 31, hi = lane >> 5, w = F.wave;
    const lds_cptr L = (lds_cptr)(F.lds + RING_OFF);
    const unsigned lds0 = (unsigned)(uintptr_t)(F.lds + RING_OFF);
    lds_fptr wsf = (lds_fptr)(F.lds + PEER_SCR + w * 256);
    const int rb = b * SEQ, Lm1 = SEQ / d - 1, kb0 = 256 * s - 128, m0 = 256 * s + 32 * w;
    const bf16* Kg = SKV + head * 64; const bf16* Vg = Kg + 2304;
    {   const int row_ = 8 * w + (lane >> 3), co_ = ((lane & 7) ^ kswz(row_)) << 3;
#pragma unroll
        for (int j = 0; j < 6; ++j) if (kb0 + 64 * j + 64 > 0) {
            int mp = kb0 + 64 * j + row_; mp = mp < 0 ? 0 : (mp > Lm1 ? Lm1 : mp);
            const size_t go = (size_t)(rb + mp * d + res) * SKVW + co_;
            glds16(Kg + go, (unsigned)__builtin_amdgcn_readfirstlane(lds0 + j * 16384 + w * 1024)); glds16(Vg + go, (unsigned)__builtin_amdgcn_readfirstlane(lds0 + j * 16384 + 8192 + w * 1024)); } }
    const size_t qrow = (size_t)rb + (size_t)(m0 + r32) * d + res;
    bf16x8 qr[4];
#pragma unroll
    for (int d0 = 0; d0 < 4; ++d0) qr[d0] = *(const bf16x8*)(PROJ + qrow * INW + head * 64 + d0 * 16 + hi * 8);
    asm volatile("" : "+v"(qr[0]), "+v"(qr[1]), "+v"(qr[2]), "+v"(qr[3]));
    int ko[4], vo[2][2]; kread_offs(ko, r32, hi); vread_offs<2>(vo, lane);
    ATT_WAITV(0); ATT_BAR();
    float m_run = 0.f, l_run = 0.f; f32x16 o[2]; o[0] = f32x16{}; o[1] = f32x16{};
    DilMap km{rb, d, res, m0, kb0, Lm1};
    bool first = true;
    for (int jj = 0; jj < 3; ++jj) {
        const int j = (w >> 1) + jj;
        if (kb0 + 64 * j + 64 <= 0) continue;
        f32x16 p0, p1;
        qkt(p0, p1, L + j * 16384, qr, ko, -m_run);
        km.mask(j, p0, p1, r32, hi);
        softmax_pv<2>(p0, p1, m_run, l_run, first, o, L + j * 16384 + 8192, vo, wsf, r32, hi);
        first = false;
    }
    const float l = finish_o<2>(l_run, o, wsf, r32, hi);
    {   LAS unsigned short* stg = (LAS unsigned short*)(F.lds + RING_OFF + 98304 + w * 4096);
#pragma unroll
        for (int r = 0; r < 16; ++r) { const int orow = crow(r, hi);
#pragma unroll
            for (int d0 = 0; d0 < 2; ++d0) stg[orow * 64 + d0 * 32 + r32] = (unsigned short)(cvtpk(o[d0][r], 0.f) & 0xffffu); }
        ATT_WAITL();
        bf16* dst = OG + ((size_t)rb + (size_t)m0 * d + res) * 2304 + head * 64;
#pragma unroll
        for (int i = 0; i < 4; ++i) { const int row = i * 8 + (lane >> 3), ch = lane & 7; const u32x4 v = *(const LAS u32x4*)(stg + row * 64 + ch * 8); *(u32x4*)(dst + (size_t)row * d * 2304 + ch * 8) = v; }
        if (hi == 0) LSEG[qrow * 36 + head] = m_run + __builtin_amdgcn_logf(l); }
    ATT_BAR();
}
__device__ __forceinline__ void dil_combine_all(Frame& F, const bf16* OG, const float* LSEG, bf16* MIX) {
    const int gt = F.vcu * (NWAVES * 64) + F.tid, NT_ = F.G * NWAVES * 64;
    for (int it = gt; it < TT * 12; it += NT_) {
        const int row = it / 12, j = it - row * 12;
        const float* lp = LSEG + (size_t)row * 36 + j; const float l0 = lp[0], l1 = lp[12], l2 = lp[24];
        const float mx = __builtin_fmaxf(l0, __builtin_fmaxf(l1, l2));
        float a0 = __builtin_amdgcn_exp2f(l0 - mx), a1 = __builtin_amdgcn_exp2f(l1 - mx), a2 = __builtin_amdgcn_exp2f(l2 - mx);
        const float inv = 1.0f / (a0 + a1 + a2); a0 *= inv; a1 *= inv; a2 *= inv;
        const v4u* g0 = (const v4u*)(OG + (size_t)row * 2304 + j * 64); const v4u* g1 = g0 + 12 * 8; const v4u* g2 = g1 + 12 * 8;
        v4u* dst = (v4u*)(MIX + (size_t)row * DM + j * 64);
#pragma unroll
        for (int c = 0; c < 8; ++c) {
            const v4u x = g0[c], y = g1[c], z = g2[c]; v4u r;
#pragma unroll
            for (int k = 0; k < 4; ++k) {
                const unsigned xk = x[k], yk = y[k], zk = z[k];
                const float lo = a0 * __uint_as_float(xk << 16) + a1 * __uint_as_float(yk << 16) + a2 * __uint_as_float(zk << 16);
                const float hh = a0 * __uint_as_float(xk & 0xffff0000u) + a1 * __uint_as_float(yk & 0xffff0000u) + a2 * __uint_as_float(zk & 0xffff0000u);
                r[k] = cvtpk(lo, hh);
            }
            dst[c] = r;
        }
    }
}
#ifndef REPMASK
#define REPMASK 0
#endif
#define NREP(b) (((REPMASK) & (b)) ? 2 : 1)

#define CEX(a, b) do { const float hi_ = __builtin_fmaxf(a, b), lo_ = __builtin_fminf(a, b); a = hi_; b = lo_; } while (0)
template <int K, int J> __device__ __forceinline__ void bstage(float (&a)[16]) {
#pragma unroll
    for (int i = 0; i < 16; ++i) { constexpr int k = K, j = J; const int l = i ^ j; if (l > i) { if ((i & k) == 0) CEX(a[i], a[l]); else CEX(a[l], a[i]); } }
}
__device__ __forceinline__ void sort16_desc(float (&a)[16]) {
    bstage<2, 1>(a); bstage<4, 2>(a); bstage<4, 1>(a); bstage<8, 4>(a); bstage<8, 2>(a); bstage<8, 1>(a); bstage<16, 8>(a); bstage<16, 4>(a); bstage<16, 2>(a); bstage<16, 1>(a);
}
__device__ __forceinline__ void merge16(float (&a)[16], const float (&b)[16]) {
#pragma unroll
    for (int i = 0; i < 16; ++i) a[i] = __builtin_fmaxf(a[i], b[15 - i]);
    bstage<16, 8>(a); bstage<16, 4>(a); bstage<16, 2>(a); bstage<16, 1>(a);
}
__device__ __forceinline__ void top16_of_64(const float (&v)[64], float (&out)[16]) {
    float c1[16], c2[16], c3[16];
#pragma unroll
    for (int i = 0; i < 16; ++i) { out[i] = v[i]; c1[i] = v[16 + i]; }
    sort16_desc(out); sort16_desc(c1); merge16(out, c1);
#pragma unroll
    for (int i = 0; i < 16; ++i) { c2[i] = v[32 + i]; c3[i] = v[48 + i]; }
    sort16_desc(c2); sort16_desc(c3); merge16(c2, c3); merge16(out, c2);
}
struct CandTab { int pos[16][16]; int inv[64]; int n;
    constexpr CandTab() : pos{}, inv{}, n(0) { for (int q = 0; q < 64; ++q) inv[q] = -1; for (int a = 0; a < 16; ++a) for (int b = 0; b < 16; ++b) { if ((a + 1) * (b + 1) <= 16) { pos[a][b] = n; inv[n] = a * 16 + b; ++n; } else pos[a][b] = -1; } } };
static constexpr CandTab kCand{};
static_assert(kCand.n == 50, "50 candidate pairs");
__device__ __forceinline__ float gelu1(float v) { pg8::f32x2 t = {v, v}; return pg8::gelu_pk(t).x; }
__device__ __forceinline__ float half32_max(float v) {
    v = dpp_maxc<0xB1>(v); v = dpp_maxc<0x4E>(v); v = dpp_maxc<0x141>(v); v = dpp_maxc<0x140>(v);
    auto r = __builtin_amdgcn_permlane16_swap(__float_as_uint(v), __float_as_uint(v), false, false); return __builtin_fmaxf(__uint_as_float(r[0]), __uint_as_float(r[1]));
}

__device__ __forceinline__ void peer_phase(Frame& F, int l) {
    using att::f32x16; using att::crow;
    const int lane = F.lane, r32 = lane & 31, hi = lane >> 5, w = F.wave;
    const auto kp_ = ka_fresh(F); unsigned char* const ws_ = KA_WS(kp_); float* const out_ = KA_OUT(kp_);
    const bf16* PQ = WSP(bf16, WS_PROJ);
    const bf16* keys = WSP(bf16, WS_PKEYS) + (size_t)l * 16 * 128 * 128;
    const unsigned char* U6 = WSP(unsigned char, WS_PU) + (size_t)l * NEXP * PROW;
    const unsigned char* V6 = WSP(unsigned char, WS_PV) + (size_t)l * NEXP * PROW;
    LAS unsigned* ids = (LAS unsigned*)(F.lds + RING_OFF);
    const unsigned kbuf = (unsigned)(uintptr_t)(F.lds + RING_OFF + 65536 + (w >> 2) * 32768);
    const att::lds_cptr KB = (att::lds_cptr)(F.lds + RING_OFF + 65536 + (w >> 2) * 32768);
    LAS unsigned char* scr = F.lds + PEER_SCR + w * 2048 + lane * 32;
    const float* gf = KA_IN(kp_, 10) + l * DM;
    for (int tile = F.bx; tile < TT / 128; tile += F.G) {
        {
            const int tokl = 32 * (w & 3) + r32; const size_t tok = (size_t)tile * 128 + tokl;
#define KEYS_ISSUE(gi) do { const bf16* kg_ = keys + (size_t)((4 * (w >> 2)) * 2 + (gi)) * 16384; int ln_ = lane; asm volatile("" : "+v"(ln_)); _Pragma("unroll") for (int i_ = 0; i_ < 8; ++i_) { const int q_ = 8 * (w & 3) + i_, row_ = 4 * q_ + (ln_ >> 4); \
                att::glds16(kg_ + row_ * 128 + (((ln_ & 15) ^ (row_ & 15)) << 3), (unsigned)__builtin_amdgcn_readfirstlane(kbuf + q_ * 1024)); } } while (0)
            for (int rep_ = 0; rep_ < NREP(256); ++rep_) {
            KEYS_ISSUE(0);
            bf16x8 bq[8];
            { const bf16* qp = PQ + tok * PQW + (4 * (w >> 2)) * 256 + hi * 8;
#pragma unroll
              for (int ks = 0; ks < 8; ++ks) bq[ks] = *(const bf16x8*)(qp + ks * 16); }
            for (int hh = 0; hh < 4; ++hh) {
                const int h = 4 * (w >> 2) + hh;
                float L0[16], L1[16];
#pragma unroll
                for (int p = 0; p < 2; ++p) {
                    asm volatile("" : "+v"(bq[0]), "+v"(bq[1]), "+v"(bq[2]), "+v"(bq[3]), "+v"(bq[4]), "+v"(bq[5]), "+v"(bq[6]), "+v"(bq[7]));
                    ATT_WAITV(0); ATT_BAR();
                    f32x16 acc[4];
#pragma unroll
                    for (int kb = 0; kb < 4; ++kb) acc[kb] = f32x16{};
                    const int kro = r32 * 256, ksw = r32 & 15;
#pragma unroll
                    for (int ks = 0; ks < 8; ++ks) {
#pragma unroll
                        for (int kb = 0; kb < 4; ++kb) { const bf16x8 ak = *(const __attribute__((address_space(3))) bf16x8*)(KB + kb * 8192 + kro + (((2 * ks + hi) ^ ksw) << 4)); acc[kb] = __builtin_amdgcn_mfma_f32_32x32x16_bf16(ak, bq[ks], acc[kb], 0, 0, 0); } }
                    asm volatile("" : "+v"(acc[0]), "+v"(acc[1]), "+v"(acc[2]), "+v"(acc[3]));
                    ATT_BAR();
                    if (hh * 2 + p + 1 < 8) { KEYS_ISSUE(hh * 2 + p + 1);
                        const bf16* qp = PQ + tok * PQW + (4 * (w >> 2)) * 256 + (hh * 2 + p + 1) * 128 + hi * 8;
#pragma unroll
                        for (int ks = 0; ks < 8; ++ks) bq[ks] = *(const bf16x8*)(qp + ks * 16); }
                    float t[16];
#pragma unroll
                    for (int kb = 0; kb < 4; ++kb) { float c[16];
#pragma unroll
                        for (int r = 0; r < 16; ++r) c[r] = __uint_as_float((__float_as_uint(acc[kb][r]) & ~127u) | (unsigned)(kb * 32 + (r & 3) + 8 * (r >> 2)));
                        sort16_desc(c);
                        if (kb == 0) {
#pragma unroll
                            for (int r = 0; r < 16; ++r) t[r] = c[r];
                        } else merge16(t, c); }
                    float a[16], b[16];
#pragma unroll
                    for (int i = 0; i < 16; ++i) { auto rr = __builtin_amdgcn_permlane32_swap(__float_as_uint(t[i]), __float_as_uint(t[i]), false, false); a[i] = __uint_as_float(rr[0]); b[i] = __uint_as_float(rr[1] | 4u); }
                    merge16(a, b);
#pragma unroll
                    for (int i = 0; i < 16; ++i) { if (p == 0) L0[i] = a[i]; else L1[i] = a[i]; }
                }
#pragma unroll
                for (int q = 0; q < 4; ++q) {
                    ((LAS unsigned*)scr)[q] = (__float_as_uint(L0[4 * q]) & 127u) | ((__float_as_uint(L0[4 * q + 1]) & 127u) << 8) | ((__float_as_uint(L0[4 * q + 2]) & 127u) << 16) | ((__float_as_uint(L0[4 * q + 3]) & 127u) << 24);
                    ((LAS unsigned*)scr)[4 + q] = (__float_as_uint(L1[4 * q]) & 127u) | ((__float_as_uint(L1[4 * q + 1]) & 127u) << 8) | ((__float_as_uint(L1[4 * q + 2]) & 127u) << 16) | ((__float_as_uint(L1[4 * q + 3]) & 127u) << 24);
                }
                float sel[16];
#pragma unroll
                for (int ch = 0; ch < 4; ++ch) { float c[16];
#pragma unroll
                    for (int q = 0; q < 16; ++q) { constexpr int dummy = 0; const int code = kCand.inv[ch * 16 + q];
                        c[q] = code >= 0 ? __uint_as_float((__float_as_uint(L0[code >= 0 ? (code >> 4) : 0] + L1[code >= 0 ? (code & 15) : 0]) & ~255u) | (unsigned)(code >= 0 ? code : 0)) : -INFINITY; }
                    sort16_desc(c);
                    if (ch == 0) {
#pragma unroll
                        for (int q = 0; q < 16; ++q) sel[q] = c[q];
                    } else merge16(sel, c); }
                asm volatile("s_waitcnt lgkmcnt(0)" ::: "memory");
                float ev[16]; unsigned eid[16]; float esum = 0.f;
                const float s0 = __uint_as_float(__float_as_uint(sel[0]) & ~255u);
#pragma unroll
                for (int k = 0; k < 16; ++k) { const unsigned bits = __float_as_uint(sel[k]); const unsigned code = bits & 255u;
                    const unsigned i1 = scr[code >> 4], i2 = scr[16 + (code & 15u)];
                    eid[k] = i1 * 128u + i2; ev[k] = __expf(__uint_as_float(bits & ~255u) - s0); esum += ev[k]; }
                const float rinv = 1.0f / esum;
                asm volatile("s_waitcnt lgkmcnt(0)" ::: "memory");
#pragma unroll
                for (int k = 0; k < 8; ++k) { const unsigned idv = hi ? eid[k + 8] : eid[k]; const float gv = (hi ? ev[k + 8] : ev[k]) * rinv;
                    ids[tokl * 128 + h * 16 + 8 * hi + k] = idv | (cvtpk(0.f, gv) & 0xffff0000u); }
            }
            }
#undef KEYS_ISSUE
        }
        __syncthreads();
        {
        const Frame F2 = make_frame(); const int lane = F2.lane, w = F2.wave, bl = lane & 31, hf = lane >> 5;
        typedef __bf16 bf2 __attribute__((ext_vector_type(2))); typedef float f32x2_t __attribute__((ext_vector_type(2)));
        {   LAS unsigned* lst = ids + w * 2048; unsigned ent[16][2];
#pragma unroll
            for (int t = 0; t < 16; ++t) { ent[t][0] = lst[t * 128 + lane]; ent[t][1] = lst[t * 128 + 64 + lane]; }
            asm volatile("s_waitcnt lgkmcnt(0)" ::: "memory");
#pragma unroll
            for (int t = 0; t < 16; ++t) {
                LAS unsigned* L = lst + t * 128; const unsigned q0 = ent[t][0], q1 = ent[t][1]; const int r0 = (int)((q0 >> 10) & 15u), r1 = (int)((q1 >> 10) & 15u);
                int base = 0;
                for (int r = 0; r < 16; ++r) {
                    const unsigned long long m0 = __ballot(r0 == r), m1 = __ballot(r1 == r); const int c0 = __popcll(m0);
                    if (r0 == r) L[base + __builtin_amdgcn_mbcnt_hi((unsigned)(m0 >> 32), __builtin_amdgcn_mbcnt_lo((unsigned)m0, 0))] = q0;
                    if (r1 == r) L[base + c0 + __builtin_amdgcn_mbcnt_hi((unsigned)(m1 >> 32), __builtin_amdgcn_mbcnt_lo((unsigned)m1, 0))] = q1;
                    base += c0 + __popcll(m1);
                }
            }
            asm volatile("s_waitcnt lgkmcnt(0)" ::: "memory");
        }
        const __amdgpu_buffer_rsrc_t rsu = __builtin_amdgcn_make_buffer_rsrc((void*)U6, 0, NEXP * PROW, 0x00020000), rsv = __builtin_amdgcn_make_buffer_rsrc((void*)V6, 0, NEXP * PROW, 0x00020000);
        {
            const int ci = lane & 15, cg = lane >> 4;
            const unsigned xq8 = (unsigned)(uintptr_t)(F2.lds + RING_OFF + 65536 + w * 8192);
            const bool wr = ((ci & 7) == 0) && ((cg >> 1) == (ci >> 3));
            typedef int v8i_t __attribute__((ext_vector_type(8))); typedef unsigned v2u_t __attribute__((ext_vector_type(2)));
            for (int h = 0; h < 2; ++h) {
                int eb_v = 127;
                for (int p = 0; p < 4; ++p) {
                    const int tokl = 16 * w + 8 * h + 2 * p + hf; const size_t tok = (size_t)tile * 128 + tokl;
                    const bf16* xrow = WSP(bf16, WS_XB) + tok * DM + 32 * bl;
            {   v4u xw[4]; float ssq = 0.f; f32x4 x[8];
#pragma unroll
                for (int j = 0; j < 4; ++j) xw[j] = ((const v4u*)xrow)[j];
#pragma unroll
                for (int j = 0; j < 4; ++j) { const unsigned a_ = xw[j].x, b_ = xw[j].y, c_ = xw[j].z, d_ = xw[j].w;
                    x[2 * j] = (f32x4){__uint_as_float(a_ << 16), __uint_as_float(a_ & 0xffff0000u), __uint_as_float(b_ << 16), __uint_as_float(b_ & 0xffff0000u)};
                    x[2 * j + 1] = (f32x4){__uint_as_float(c_ << 16), __uint_as_float(c_ & 0xffff0000u), __uint_as_float(d_ << 16), __uint_as_float(d_ & 0xffff0000u)}; }
#pragma unroll
                for (int j = 0; j < 8; ++j) ssq += (x[j][0] * x[j][0] + x[j][1] * x[j][1]) + (x[j][2] * x[j][2] + x[j][3] * x[j][3]);
                const float rstd = 1.0f / sqrtf(half32_sum(ssq) * (1.f / DM) + EPS);
                float am = 0.f;
#pragma unroll
                for (int j = 0; j < 8; ++j) { const f32x4 gg = ((const f32x4*)(gf + 32 * bl))[j]; x[j] = x[j] * rstd * gg;
                    am = __builtin_fmaxf(am, __builtin_fmaxf(__builtin_fmaxf(__builtin_fabsf(x[j][0]), __builtin_fabsf(x[j][1])), __builtin_fmaxf(__builtin_fabsf(x[j][2]), __builtin_fabsf(x[j][3])))); }
                am = __builtin_fmaxf(half32_max(am), 1e-30f);
                auto rr = __builtin_amdgcn_permlane32_swap(__float_as_uint(am), __float_as_uint(am), false, false);
                const int ebA = (int)(rr[0] >> 23), ebB = (int)(rr[1] >> 23), ebO = hf ? ebB : ebA;
                const float mult = __uint_as_float((unsigned)(261 - ebO) << 23);
                if (lane == 2 * p) eb_v = ebA; if (lane == 2 * p + 1) eb_v = ebB;
                unsigned q8[8];
#pragma unroll
                for (int j = 0; j < 8; ++j) { int p_ = __builtin_amdgcn_cvt_pk_fp8_f32(x[j][0] * mult, x[j][1] * mult, 0, false); p_ = __builtin_amdgcn_cvt_pk_fp8_f32(x[j][2] * mult, x[j][3] * mult, p_, true); q8[j] = (unsigned)p_; }
                { const unsigned xo_ = xq8 + (2 * p + hf) * 1024 + bl * 32; *(LAS v4u*)(uintptr_t)xo_ = (v4u){q8[0], q8[1], q8[2], q8[3]}; *(LAS v4u*)(uintptr_t)(xo_ + 16) = (v4u){q8[4], q8[5], q8[6], q8[7]}; }
                asm volatile("s_waitcnt lgkmcnt(0)" ::: "memory");
            }
                }
                asm volatile("s_waitcnt lgkmcnt(0)" ::: "memory");
                v4u a0, a1, a2, a3, a4, a5, a6, a7, b0, b1, b2, b3, b4, b5, b6, b7, c0, c1, c2, c3, c4, c5, c6, c7, d0, d1, d2, d3, d4, d5, d6, d7; v2u_t sa, sb, sc, sd;
#define U_REQ(B0, B1, B2, B3, B4, B5, B6, B7, S, k_) do { const int G_ = (k_) >> 2, p_ = (k_) & 3; \
                    const unsigned e_ = ids[(16 * w + 8 * h + 2 * p_ + (ci >> 3)) * 128 + 8 * G_ + (ci & 7)] & 0x3fffu; const int uo_ = (int)(e_ * (unsigned)PROW) + 16 * cg; \
                    B0 = __builtin_bit_cast(v4u, __builtin_amdgcn_raw_buffer_load_b128(rsu, uo_, 0, 0)); B1 = __builtin_bit_cast(v4u, __builtin_amdgcn_raw_buffer_load_b128(rsu, uo_ + 64, 0, 0)); \
                    B2 = __builtin_bit_cast(v4u, __builtin_amdgcn_raw_buffer_load_b128(rsu, uo_ + 128, 0, 0)); B3 = __builtin_bit_cast(v4u, __builtin_amdgcn_raw_buffer_load_b128(rsu, uo_ + 192, 0, 0)); \
                    B4 = __builtin_bit_cast(v4u, __builtin_amdgcn_raw_buffer_load_b128(rsu, uo_ + 256, 0, 0)); B5 = __builtin_bit_cast(v4u, __builtin_amdgcn_raw_buffer_load_b128(rsu, uo_ + 320, 0, 0)); \
                    B6 = __builtin_bit_cast(v4u, __builtin_amdgcn_raw_buffer_load_b128(rsu, uo_ + 384, 0, 0)); B7 = __builtin_bit_cast(v4u, __builtin_amdgcn_raw_buffer_load_b128(rsu, uo_ + 448, 0, 0)); \
                    S = __builtin_bit_cast(v2u_t, __builtin_amdgcn_raw_buffer_load_b64(rsu, uo_ + 512 - 8 * cg, 0, 0)); } while (0)
#define MF1(UB, S, j_) do { const v4u x0_ = *(const LAS v4u*)(uintptr_t)(xrd_ + 128 * (j_)), x1_ = *(const LAS v4u*)(uintptr_t)(xrd_ + 128 * (j_) + 64);     \
                    const v8i_t a_ = {(int)UB.x, (int)UB.y, (int)UB.z, (int)UB.w, 0, 0, 0, 0}, b_ = {(int)x0_.x, (int)x0_.y, (int)x0_.z, (int)x0_.w, (int)x1_.x, (int)x1_.y, (int)x1_.z, (int)x1_.w}; \
                    D_ = __builtin_amdgcn_mfma_scale_f32_16x16x128_f8f6f4(a_, b_, D_, 4, 0, (j_) & 3, (int)S[(j_) >> 2], 0, sbx_); } while (0)
#define STEP(C0, C1, C2, C3, C4, C5, C6, C7, SC_, N0, N1, N2, N3, N4, N5, N6, N7, SN_, k_) do { \
                    { const int k2_ = (k_) + 3 < 64 ? (k_) + 3 : 63; U_REQ(N0, N1, N2, N3, N4, N5, N6, N7, SN_, k2_); } \
                    const int G_ = (k_) >> 2, p_ = (k_) & 3; const int ebA_ = __builtin_amdgcn_readlane(eb_v, 2 * p_), ebB_ = __builtin_amdgcn_readlane(eb_v, 2 * p_ + 1); \
                    const int sbx_ = ((ci >> 3) ? ebB_ : ebA_) - 7; const unsigned xrd_ = xq8 + (2 * p_ + (ci >> 3)) * 1024 + cg * 16; \
                    f32x4 D_ = {0.f, 0.f, 0.f, 0.f}; \
                    MF1(C0, SC_, 0); MF1(C1, SC_, 1); MF1(C2, SC_, 2); MF1(C3, SC_, 3); MF1(C4, SC_, 4); MF1(C5, SC_, 5); MF1(C6, SC_, 6); MF1(C7, SC_, 7); \
                    { float d0_ = D_[0], d1_ = D_[1], d2_ = D_[2], d3_ = D_[3]; asm volatile("" : "+v"(d0_), "+v"(d1_), "+v"(d2_), "+v"(d3_)); D_ = (f32x4){d0_, d1_, d2_, d3_}; }     \
                    LAS unsigned* idc_ = ids + (16 * w + 8 * h + 2 * p_ + hf) * 128 + 8 * G_ + 4 * (cg & 1);       \
                    const v4u q_ = *(const LAS v4u*)idc_; pg8::f32x2 t0_ = {D_[0], D_[1]}, t1_ = {D_[2], D_[3]}; t0_ = pg8::gelu_pk(t0_); t1_ = pg8::gelu_pk(t1_); \
                    const v4u n_ = {(q_.x & 0xffffu) | (cvtpk(0.f, __uint_as_float(q_.x & 0xffff0000u) * t0_.x) & 0xffff0000u), (q_.y & 0xffffu) | (cvtpk(0.f, __uint_as_float(q_.y & 0xffff0000u) * t0_.y) & 0xffff0000u), \
                                    (q_.z & 0xffffu) | (cvtpk(0.f, __uint_as_float(q_.z & 0xffff0000u) * t1_.x) & 0xffff0000u), (q_.w & 0xffffu) | (cvtpk(0.f, __uint_as_float(q_.w & 0xffff0000u) * t1_.y) & 0xffff0000u)}; \
                    if (wr) *(LAS v4u*)idc_ = n_; } while (0)
                U_REQ(a0, a1, a2, a3, a4, a5, a6, a7, sa, 0); U_REQ(b0, b1, b2, b3, b4, b5, b6, b7, sb, 1); U_REQ(c0, c1, c2, c3, c4, c5, c6, c7, sc, 2);
#pragma nounroll
                for (int k = 0; k < 64; k += 4) {
                    STEP(a0, a1, a2, a3, a4, a5, a6, a7, sa, d0, d1, d2, d3, d4, d5, d6, d7, sd, k);
                    STEP(b0, b1, b2, b3, b4, b5, b6, b7, sb, a0, a1, a2, a3, a4, a5, a6, a7, sa, k + 1);
                    STEP(c0, c1, c2, c3, c4, c5, c6, c7, sc, b0, b1, b2, b3, b4, b5, b6, b7, sb, k + 2);
                    STEP(d0, d1, d2, d3, d4, d5, d6, d7, sd, c0, c1, c2, c3, c4, c5, c6, c7, sc, k + 3);
                }
#undef STEP
#undef MF1
#undef U_REQ
                asm volatile("s_waitcnt lgkmcnt(0)" ::: "memory");
            }
        }

        for (int pp = 0; pp < 8; ++pp) {
            const int tokl = 16 * w + 2 * pp + hf; const size_t tok = (size_t)tile * 128 + tokl;
            bf16* xrow = WSP(bf16, WS_XB) + tok * DM + 32 * bl;
            float acc[32];
#pragma unroll
            for (int i = 0; i < 32; ++i) acc[i] = 0.f;
            const LAS unsigned* idp = ids + tokl * 128;
            v4u vb0, vb1, vb2, vb3, vb4, vb5, vb6, vb7; unsigned vs0, vs1, vs2, vs3, vs4, vs5, vs6, vs7;
#define V_LD(VB, VS, ent) do { const unsigned e_ = (ent) & 0x3fffu; const int ro_ = (int)(e_ * (unsigned)PROW) + 16 * bl; \
                VB = __builtin_bit_cast(v4u, __builtin_amdgcn_raw_buffer_load_b128(rsv, ro_, 0, 0)); VS = (unsigned)__builtin_amdgcn_raw_buffer_load_b8(rsv, ro_ + 512 - 15 * bl, 0, 0); } while (0)
#define V_FMA(VB, VS, ent) do { const float c_ = __uint_as_float((ent) & 0xffff0000u), sv_ = __uint_as_float(VS << 23); \
                _Pragma("unroll") for (int k_ = 0; k_ < 4; ++k_) { const unsigned vw_ = VB[k_]; \
                    { const f32x2_t f_ = __builtin_amdgcn_cvt_scalef32_pk_f32_fp4(vw_, sv_, 0); acc[8 * k_] += c_ * f_.x; acc[8 * k_ + 1] += c_ * f_.y; } \
                    { const f32x2_t f_ = __builtin_amdgcn_cvt_scalef32_pk_f32_fp4(vw_, sv_, 1); acc[8 * k_ + 2] += c_ * f_.x; acc[8 * k_ + 3] += c_ * f_.y; } \
                    { const f32x2_t f_ = __builtin_amdgcn_cvt_scalef32_pk_f32_fp4(vw_, sv_, 2); acc[8 * k_ + 4] += c_ * f_.x; acc[8 * k_ + 5] += c_ * f_.y; } \
                    { const f32x2_t f_ = __builtin_amdgcn_cvt_scalef32_pk_f32_fp4(vw_, sv_, 3); acc[8 * k_ + 6] += c_ * f_.x; acc[8 * k_ + 7] += c_ * f_.y; } } } while (0)
            { const v4u e4_ = *(const LAS v4u*)idp, e5_ = *(const LAS v4u*)(idp + 4); V_LD(vb0, vs0, e4_.x); V_LD(vb1, vs1, e4_.y); V_LD(vb2, vs2, e4_.z); V_LD(vb3, vs3, e4_.w); V_LD(vb4, vs4, e5_.x); V_LD(vb5, vs5, e5_.y); V_LD(vb6, vs6, e5_.z); V_LD(vb7, vs7, e5_.w); }
#pragma nounroll
            for (int G = 0; G < 16; ++G) {
                const int Gn = G + 1 < 16 ? G + 1 : 15;
                const v4u ca = *(const LAS v4u*)(idp + 8 * G), cb = *(const LAS v4u*)(idp + 8 * G + 4), na = *(const LAS v4u*)(idp + 8 * Gn), nb = *(const LAS v4u*)(idp + 8 * Gn + 4);
#define OPAQUE_ONE(x) int x; asm volatile("s_mov_b32 %0, 1" : "=s"(x))
                { OPAQUE_ONE(t_); if (t_) { V_FMA(vb0, vs0, ca.x); } V_LD(vb0, vs0, na.x); }
                { OPAQUE_ONE(t_); if (t_) { V_FMA(vb1, vs1, ca.y); } V_LD(vb1, vs1, na.y); }
                { OPAQUE_ONE(t_); if (t_) { V_FMA(vb2, vs2, ca.z); } V_LD(vb2, vs2, na.z); }
                { OPAQUE_ONE(t_); if (t_) { V_FMA(vb3, vs3, ca.w); } V_LD(vb3, vs3, na.w); }
                { OPAQUE_ONE(t_); if (t_) { V_FMA(vb4, vs4, cb.x); } V_LD(vb4, vs4, nb.x); }
                { OPAQUE_ONE(t_); if (t_) { V_FMA(vb5, vs5, cb.y); } V_LD(vb5, vs5, nb.y); }
                { OPAQUE_ONE(t_); if (t_) { V_FMA(vb6, vs6, cb.z); } V_LD(vb6, vs6, nb.z); }
                { OPAQUE_ONE(t_); if (t_) { V_FMA(vb7, vs7, cb.w); } V_LD(vb7, vs7, nb.w); }
#undef OPAQUE_ONE
            }
#undef V_LD
#undef V_FMA
            f32x4 y[8]; float s2_ = 0.f;
            { v4u xo[4];
#pragma unroll
              for (int j = 0; j < 4; ++j) xo[j] = ((const v4u*)xrow)[j];
#pragma unroll
              for (int j = 0; j < 4; ++j) { const unsigned a_ = xo[j].x, b_ = xo[j].y, c_ = xo[j].z, d_ = xo[j].w;
                y[2 * j] = (f32x4){__uint_as_float(a_ << 16) + acc[8 * j], __uint_as_float(a_ & 0xffff0000u) + acc[8 * j + 1], __uint_as_float(b_ << 16) + acc[8 * j + 2], __uint_as_float(b_ & 0xffff0000u) + acc[8 * j + 3]};
                y[2 * j + 1] = (f32x4){__uint_as_float(c_ << 16) + acc[8 * j + 4], __uint_as_float(c_ & 0xffff0000u) + acc[8 * j + 5], __uint_as_float(d_ << 16) + acc[8 * j + 6], __uint_as_float(d_ & 0xffff0000u) + acc[8 * j + 7]}; }
#pragma unroll
              for (int j = 0; j < 8; ++j) s2_ += (y[j][0] * y[j][0] + y[j][1] * y[j][1]) + (y[j][2] * y[j][2] + y[j][3] * y[j][3]); }
            const float r2 = 1.0f / sqrtf(half32_sum(s2_) * (1.f / DM) + EPS);
            const int eo = 32 * bl;
            if (l < 3) {
#pragma unroll
                for (int j = 0; j < 4; ++j) ((v4u*)xrow)[j] = (v4u){cvtpk(y[2 * j][0], y[2 * j][1]), cvtpk(y[2 * j][2], y[2 * j][3]), cvtpk(y[2 * j + 1][0], y[2 * j + 1][1]), cvtpk(y[2 * j + 1][2], y[2 * j + 1][3])};
                { const float* gn = KA_IN(kp_, 2) + (l + 1) * DM + eo; bf16* xn = WSP(bf16, WS_XN) + tok * DM + eo;
#pragma unroll
                  for (int j = 0; j < 4; ++j) { const f32x4 n0 = y[2 * j] * r2 * ((const f32x4*)gn)[2 * j], n1 = y[2 * j + 1] * r2 * ((const f32x4*)gn)[2 * j + 1]; ((v4u*)xn)[j] = (v4u){cvtpk(n0[0], n0[1]), cvtpk(n0[2], n0[3]), cvtpk(n1[0], n1[1]), cvtpk(n1[2], n1[3])}; } }
                if (l == 1) { const float* gs = KA_IN(kp_, 15) + eo; bf16* xs = WSP(bf16, WS_MIX) + tok * DM + eo;
#pragma unroll
                  for (int j = 0; j < 4; ++j) { const f32x4 n0 = y[2 * j] * r2 * ((const f32x4*)gs)[2 * j], n1 = y[2 * j + 1] * r2 * ((const f32x4*)gs)[2 * j + 1]; ((v4u*)xs)[j] = (v4u){cvtpk(n0[0], n0[1]), cvtpk(n0[2], n0[3]), cvtpk(n1[0], n1[1]), cvtpk(n1[2], n1[3])}; } }
            } else {
                const float* gn = KA_IN(kp_, 17) + eo; float* oh = out_ + tok * DM + eo;
#pragma unroll
                for (int j = 0; j < 8; ++j) ((f32x4*)oh)[j] = y[j] * r2 * ((const f32x4*)gn)[j];
            }
        }
        }
        __syncthreads();
    }
}

struct Args { const float* in[18]; float* out; unsigned char* ws; int ph_lo, ph_hi; };
__global__ void __launch_bounds__(NWAVES * 64, 2) hyb_fwd(Args args) {
    { Frame F = make_frame();
      for (int u = F.tid; u < 1024 / 4; u += NWAVES * 64) ((LAS unsigned*)(F.lds + LDSCTL_OFF))[u] = 0u; }
    __syncthreads();
    const int lo = args.ph_lo, hi = args.ph_hi;
    if (hi - lo > 1) { Frame F = make_frame(); const auto kp_ = ka_fresh(F); (void)xcd_barrier_post((unsigned*)(KA_WS(kp_) + WS_CTL) + CW_BAR, F.MISC + 8); }
#ifndef PHMASK
#define PHMASK 0xff
#endif

#define PHM(b) ((PHMASK & (b)) != 0)
#define IN(k) (lo <= (k) && (k) < hi)
#define SEAM(k) do { if (IN(k) && IN((k) + 1)) { Frame F = make_frame(); const auto kq_ = ka_fresh(F); XcdBarrier b_; b_.bar = (unsigned*)(KA_WS(kq_) + WS_CTL) + CW_BAR; b_.x = xb_xcc_id(); b_.st = F.MISC + 8; xcd_barrier(b_); if (NREP(512) == 2) xcd_barrier(b_); } } while (0)

    if (PHM(1) && IN(0)) { for (int rep_ = 0; rep_ < NREP(1); ++rep_) { Frame F = make_frame(); p0_prologue(F); } }
    SEAM(0);
    for (int l = 0; l < 4; ++l) {
        const int pb = 1 + 6 * l;
        if (PHM(2) && IN(pb)) {
            const int njobs = (l == 0) ? 5 : (l == 2 ? 2 : 1);
            for (int rep_ = 0; rep_ < NREP(2); ++rep_)
            for (int jb = 0; jb < njobs; ++jb) {
                Frame F = make_frame(); const auto kp_ = ka_fresh(F); unsigned char* const ws_ = KA_WS(kp_);
                pg8::Gemm g; pg8::EpiProj E; int cid = F.bx;
                E.rope = WSP(float, WS_ROPE); E.sc = att::C2; E.hm = 0; E.hs = 0;
                const bool is_skv = (l == 2 && jb == 0), is_proj = (l == 2) ? (jb == 1) : (jb == 0);
                if (is_skv) { g = pg8::Gemm{WSP(pg8::bf16_t, WS_MIX), WSP(pg8::bf16_t, WS_WSKV), TT, SKVW, DM}; E.O = WSP(pg8::bf16_t, WS_SKV); E.ldc = SKVW; E.rope_lim = 9; E.scale_lim = 0; E.scale_tile = -1; }
                else if (is_proj) { g = pg8::Gemm{WSP(pg8::bf16_t, WS_XN), (l < 2 ? WSP(pg8::bf16_t, WS_WA) + (size_t)l * INW * DM : WSP(pg8::bf16_t, WS_WB) + (size_t)(l - 2) * INW * DM), TT, INW, DM};
                    E.O = WSP(pg8::bf16_t, WS_PROJ); E.ldc = INW; E.rope_lim = (l < 2) ? 6 : 9; E.scale_lim = (l < 2) ? 3 : 9; E.scale_tile = 9; }
                else { const int lm = jb - 1; g = pg8::Gemm{WSP(pg8::bf16_t, WS_MEMN) + (size_t)lm * MEMROWS * DM, WSP(pg8::bf16_t, WS_WMKV) + (size_t)lm * MKVW * DM, MEMROWS, MKVW, DM};
                    E.O = WSP(pg8::bf16_t, WS_MEMKV) + (size_t)lm * MEMROWS * MKVW; E.ldc = MKVW; E.rope_lim = 0; E.scale_lim = 0; E.scale_tile = -1; cid = (int)((F.bx + F.G - 16 * lm) % F.G); }
                pg8::StaticOrder S; S.init(g.M, g.N, F.G, cid);
                pg8::gemm_phase<pg8::EpiProj, pg8::StaticOrder, true, true>(F.lds + RING_OFF, g, S, E);
                __syncthreads();
            }
        }
        SEAM(pb);
        if (IN(pb + 1)) {
            Frame F = make_frame(); const auto kp_ = ka_fresh(F); unsigned char* const ws_ = KA_WS(kp_);
            const bf16* PROJ = WSP(bf16, WS_PROJ); bf16* MIX = WSP(bf16, WS_MIX);
            if (PHM(4) && l < 2) {
                for (int rep_ = 0; rep_ < NREP(4); ++rep_) {
                const float li = 0.8f - 0.6f * expf(-0.3f * (float)l);
                const float* lp = KA_IN(kp_, 4) + l * 256;
                const float d01 = wave_sum(lp[F.lane] * lp[64 + F.lane]), d23 = wave_sum(lp[128 + F.lane] * lp[192 + F.lane]);
                const float lam = expf(d01) - expf(d23) + li;
                const float* subg = KA_IN(kp_, 5) + l * 128;
                const int nper = (768 + F.G - 1) / F.G;
                for (int k = 0; k < nper; ++k) {
                    const int P = F.vcu * nper + k; if (P >= 768) break;
                    const int bh = P >> 4, s = P & 15;
                    diff_unit(F, bh / 6, bh % 6, s, PROJ, MIX, lam, 1.0f - li, subg);
                    diff_unit(F, bh / 6, bh % 6, 31 - s, PROJ, MIX, lam, 1.0f - li, subg);
                }
                }
            } else if (PHM(8)) {
                for (int rep2_ = 0; rep2_ < NREP(8); ++rep2_) {
                const bf16* SKV = WSP(bf16, WS_SKV);
                const int nper = (4608 + F.G - 1) / F.G;
                for (int k = 0; k < nper; ++k) {
                    const int U = F.vcu * nper + k; if (U >= 4608) break;
                    const int w16 = U & 15, bh = U >> 4, head = bh % 36, b = bh / 36, g = head / 12;
                    const int d = g == 0 ? 1 : (g == 1 ? 4 : 16), res = g == 0 ? 0 : (g == 1 ? (w16 >> 2) : w16), s = g == 0 ? w16 : (g == 1 ? (w16 & 3) : 0);
                    dil_strip(F, b, head, res, s, d, PROJ, SKV, WSP(bf16, WS_OG), WSP(float, WS_LSEG));
                }
                }
            }
            if (l < 2) { for (int rep3_ = 0; rep3_ < NREP(16); ++rep3_) if (PHM(16)) mem_attn_all(F, PROJ, WSP(bf16, WS_MEMKV) + (size_t)l * MEMROWS * MKVW, MIX); }
            asm volatile("s_waitcnt vmcnt(0) lgkmcnt(0)" ::: "memory"); __syncthreads();
        }
        SEAM(pb + 1);
        if (IN(pb + 2) && l >= 2) {
            Frame F = make_frame(); const auto kp_ = ka_fresh(F); unsigned char* const ws_ = KA_WS(kp_);
            if (PHM(8)) dil_combine_all(F, WSP(bf16, WS_OG), WSP(float, WS_LSEG), WSP(bf16, WS_MIX));
            for (int rep3_ = 0; rep3_ < NREP(16); ++rep3_) if (PHM(16)) mem_attn_all(F, WSP(bf16, WS_PROJ), WSP(bf16, WS_MEMKV) + (size_t)l * MEMROWS * MKVW, WSP(bf16, WS_MIX));
            asm volatile("s_waitcnt vmcnt(0) lgkmcnt(0)" ::: "memory"); __syncthreads();
        }
        if (l >= 2) SEAM(pb + 2);
        if (PHM(32) && IN(pb + 3)) {
            Frame F = make_frame(); const auto kp_ = ka_fresh(F); unsigned char* const ws_ = KA_WS(kp_);
            pg8::Gemm g{WSP(pg8::bf16_t, WS_MIX), WSP(pg8::bf16_t, WS_WOUT) + (size_t)l * DM * DM, TT, DM, DM};
            pg8::EpiRes E{WSP(pg8::bf16_t, WS_XB), WSP(float, WS_SS), DM};
            pg8::StaticOrder S; S.init(TT, DM, F.G, F.bx);
            pg8::gemm_phase<pg8::EpiRes, pg8::StaticOrder, true, true>(F.lds + RING_OFF, g, S, E);
            __syncthreads();
        }
        SEAM(pb + 3);
        if (PHM(64) && IN(pb + 4)) {
            Frame F = make_frame(); const auto kp_ = ka_fresh(F); unsigned char* const ws_ = KA_WS(kp_);
            pg8::Gemm g{WSP(pg8::bf16_t, WS_XB), WSP(pg8::bf16_t, WS_WPQ) + (size_t)l * PQW * DM, TT, PQW, DM};
            pg8::EpiScaleRow E{WSP(pg8::bf16_t, WS_PROJ), PQW, WSP(float, WS_SS), EPS};
            pg8::StaticOrder S; S.init(TT, PQW, F.G, F.bx);
            for (int rep_ = 0; rep_ < NREP(64); ++rep_) {
            pg8::gemm_phase<pg8::EpiScaleRow, pg8::StaticOrder, true, true>(F.lds + RING_OFF, g, S, E);
            __syncthreads(); }
        }
        SEAM(pb + 4);
        if (PHM(128) && IN(pb + 5)) { Frame F = make_frame(); peer_phase(F, l); }
        SEAM(pb + 5);
    }
#undef IN
#undef SEAM
}

#ifndef HYB_N_LAUNCHES
#define HYB_N_LAUNCHES 1
#endif
extern "C" void kernel_launch(void* const* d_in, const int* in_sizes, int n_in, void* d_out, int out_size, void* d_ws, size_t ws_size, hipStream_t stream) {
    static int grid = 0;
    if (grid == 0) {
        if (n_in != 18 || out_size != TT * DM || ws_size < WS_END) { fprintf(stderr, "kernel_launch: unexpected shapes (n_in %d, out %d, ws %zu)\n", n_in, out_size, ws_size); grid = -1; return; }
        int dev = 0, cus = 0, per_cu = 0;
        if (hipGetDevice(&dev) != hipSuccess || hipDeviceGetAttribute(&cus, hipDeviceAttributeMultiprocessorCount, dev) != hipSuccess) { grid = -1; return; }
        if (hipFuncSetAttribute((const void*)hyb_fwd, hipFuncAttributeMaxDynamicSharedMemorySize, LDS_BYTES) != hipSuccess) { fprintf(stderr, "kernel_launch: hipFuncSetAttribute failed\n"); grid = -1; return; }
        if (hipOccupancyMaxActiveBlocksPerMultiprocessor(&per_cu, (const void*)hyb_fwd, NWAVES * 64, LDS_BYTES) != hipSuccess || per_cu < 1) { fprintf(stderr, "kernel_launch: occupancy query says %d\n", per_cu); }
        (void)hipGetLastError();
        grid = cus;
    }
    if (grid < 0) return;
    (void)hipMemsetAsync((char*)d_ws + WS_CTL, 0, CTL_ZERO_BYTES, stream);
    Args a{};
    for (int i = 0; i < 18; ++i) a.in[i] = (const float*)d_in[i];
    a.out = (float*)d_out; a.ws = (unsigned char*)d_ws;
    if (HYB_N_LAUNCHES == 1) { a.ph_lo = 0; a.ph_hi = NPHASE; hipLaunchKernelGGL(hyb_fwd, dim3(grid), dim3(NWAVES * 64), LDS_BYTES, stream, a); }
    else { for (int p = 0; p < NPHASE; ++p) { a.ph_lo = p; a.ph_hi = p + 1; hipLaunchKernelGGL(hyb_fwd, dim3(grid), dim3(NWAVES * 64), LDS_BYTES, stream, a); } }
}
```

```cpp
#include <hip/hip_runtime.h>
#include <cstdio>
#include <cstdint>
#include <cmath>
template <int CTRL> __device__ __forceinline__ float dpp_addc(float v) { return v + __uint_as_float((unsigned)__builtin_amdgcn_update_dpp(0, (int)__float_as_uint(v), CTRL, 0xf, 0xf, true)); }
template <int CTRL> __device__ __forceinline__ float dpp_maxc(float v) { return __builtin_fmaxf(v, __uint_as_float((unsigned)__builtin_amdgcn_update_dpp(0, (int)__float_as_uint(v), CTRL, 0xf, 0xf, true))); }
__device__ __forceinline__ float xor16_sum(float v) { auto r = __builtin_amdgcn_permlane16_swap(__float_as_uint(v), __float_as_uint(v), false, false); return __uint_as_float(r[0]) + __uint_as_float(r[1]); }
__device__ __forceinline__ float xor32_sum(float v) { auto r = __builtin_amdgcn_permlane32_swap(__float_as_uint(v), __float_as_uint(v), false, false); return __uint_as_float(r[0]) + __uint_as_float(r[1]); }
__device__ __forceinline__ float xor16_get(float v, bool odd_row) { auto r = __builtin_amdgcn_permlane16_swap(__float_as_uint(v), __float_as_uint(v), false, false); return __uint_as_float(odd_row ? r[0] : r[1]); }
__device__ __forceinline__ float row16_sum(float v) { v = dpp_addc<0xB1>(v); v = dpp_addc<0x4E>(v); v = dpp_addc<0x141>(v); return dpp_addc<0x140>(v); }
__device__ __forceinline__ float half32_sum(float v) { return xor16_sum(row16_sum(v)); }
__device__ __forceinline__ float wave_sum_valu(float v) { return xor32_sum(half32_sum(v)); }
__device__ __forceinline__ float wave_max_valu(float v) {
    v = dpp_maxc<0xB1>(v); v = dpp_maxc<0x4E>(v); v = dpp_maxc<0x141>(v); v = dpp_maxc<0x140>(v);
    { auto r = __builtin_amdgcn_permlane16_swap(__float_as_uint(v), __float_as_uint(v), false, false); v = __builtin_fmaxf(__uint_as_float(r[0]), __uint_as_float(r[1])); }
    { auto r = __builtin_amdgcn_permlane32_swap(__float_as_uint(v), __float_as_uint(v), false, false); v = __builtin_fmaxf(__uint_as_float(r[0]), __uint_as_float(r[1])); }
    return v;
}
namespace pg8 {
#define PG8_LAS __attribute__((address_space(3)))
typedef unsigned short bf16_t;
typedef short bf16x8 __attribute__((ext_vector_type(8)));
typedef float f32x4 __attribute__((ext_vector_type(4)));
typedef unsigned u32x4 __attribute__((ext_vector_type(4)));
constexpr int BM = 256, BK = 64, HALF = 128, HTB = HALF * BK * 2  , STAGE_BYTES = 8 * HTB, NXCD = 8, WGM = 8;

__host__ __device__ __forceinline__ int lds_byte(int r, int c) { const int st = (r >> 4) * 2 + (c >> 5), rr = r & 15, cc = c & 31, ob = rr * 64 + cc * 2; return st * 1024 + (ob ^ (((ob >> 9) & 1) << 5)); }
__host__ __device__ __forceinline__ void stage_rc(int b, int& R, int& C) { const int st = b / 1024, sb = b % 1024, swz = sb ^ (((sb >> 9) & 1) << 5); R = (st >> 1) * 16 + swz / 64; C = (st & 1) * 32 + (swz % 64) / 2; }
__host__ __device__ __forceinline__ int perm32(int rho) { const int n = rho >> 4, i = rho & 15; return 8 * (i >> 2) + 4 * n + (i & 3); }

struct Unit { int pm, pn; };
struct Gemm { const bf16_t* A; const bf16_t* Bt; int M, N, K; };

struct StaticOrder {
    int nM, nN, nwg, G, c;
    __host__ __device__ void init(int M, int N, int G_, int c_) { nM = M / BM; nN = N / BM; nwg = nM * nN; G = G_; c = c_; }
    __host__ __device__ bool next(int i, Unit& u) const {
        const long L = (long)i * G + c; if (L >= nwg) return false;
        int wgid = (int)L; { const int q = nwg / NXCD, r = nwg % NXCD, xcd = wgid % NXCD, off = wgid / NXCD; wgid = (xcd < r ? xcd * (q + 1) : r * (q + 1) + (xcd - r) * q) + off; }
        const int nig = WGM * nN, gid = wgid / nig, fm = gid * WGM, gsz = (nM - fm) < WGM ? (nM - fm) : WGM;
        u.pm = fm + ((wgid % nig) % gsz); u.pn = (wgid % nig) / gsz; return true;
    }
    __device__ __forceinline__ void a_ready(const Unit&) const {}
    __device__ __forceinline__ void done(const Unit&) const {}
};

__device__ __forceinline__ unsigned cvt_pk_bf16(float lo, float hi) { unsigned r; asm volatile("v_cvt_pk_bf16_f32 %0, %1, %2" : "=v"(r) : "v"(lo), "v"(hi)); return r; }
typedef float f32x2 __attribute__((ext_vector_type(2)));
__device__ __forceinline__ f32x2 gelu_pk(f32x2 v) {
    const f32x2 av = __builtin_elementwise_abs(v), d = av * 0.2316418882f + 1.0f;
    f32x2 t; t.x = __builtin_amdgcn_rcpf(d.x); t.y = __builtin_amdgcn_rcpf(d.y);
    f32x2 q = t * 0.5307027145f + (-0.7265760135f); q = q * t + 0.7107068705f; q = q * t + (-0.142248368f); q = q * t + 0.127414796f; q = q * t;
    const f32x2 s = (v * v) * (-0.72134752044f);
    f32x2 e; e.x = __builtin_amdgcn_exp2f(s.x); e.y = __builtin_amdgcn_exp2f(s.y);
    const f32x2 m = v * (q * e), r = v - m;
    f32x2 o; o.x = v.x < 0.f ? m.x : r.x; o.y = v.y < 0.f ? m.y : r.y; return o;
}


struct EpiProj {
    static constexpr bool PERM = true, AFTER_DRAIN = false;
    bf16_t* O; int ldc; const float* rope; int rope_lim, scale_lim, scale_tile; float sc; int hm; size_t hs;
    __device__ __forceinline__ void operator()(const f32x4 (&acc)[2][2][4][2], const Unit& u, int wr, int wc, int fr, int fq) const {
        const int row0 = u.pm * BM + wr * 64 + fr, col0 = u.pn * BM + wc * 32 + 8 * fq;
        const bool do_rope = (u.pn < rope_lim) && ((wc & 1) == 0);
        const float s = (u.pn < scale_lim || u.pn == scale_tile) ? sc : 1.f;
        const float sg = (fq == 0) ? -1.f : 1.f;
#pragma unroll
        for (int ai = 0; ai < 2; ++ai)
#pragma unroll
            for (int m = 0; m < 4; ++m) {
                const int row = row0 + ai * HALF + m * 16;
                f32x4 c0 = {1.f, 1.f, 1.f, 1.f}, c1 = c0, s0 = {0.f, 0.f, 0.f, 0.f}, s1 = s0;
                if (do_rope) { const f32x4* rp = (const f32x4*)(rope + (size_t)(row & 4095) * 16); c0 = rp[0]; c1 = rp[1]; s0 = rp[2]; s1 = rp[3]; }
                bf16_t* rowp = hm ? O + ((size_t)(row >> 12) * hm + (col0 >> 6)) * hs + (size_t)(row & 4095) * 64 + (col0 & 63) : O + (size_t)row * ldc + col0;
                const size_t bjstep = hm ? 2 * hs : (size_t)HALF;
#pragma unroll
                for (int bj = 0; bj < 2; ++bj) {
                    f32x4 v0 = acc[ai][bj][m][0], v1 = acc[ai][bj][m][1];
                    if (do_rope) {
                        f32x4 p0, p1;
#pragma unroll
                        for (int j = 0; j < 4; ++j) { p0[j] = xor16_get(v0[j], (fq & 1) != 0); p1[j] = xor16_get(v1[j], (fq & 1) != 0); }
                        if (fq < 2) { v0 = v0 * c0 + (p0 * s0) * sg; v1 = v1 * c1 + (p1 * s1) * sg; }
                    }
                    v0 = v0 * s; v1 = v1 * s;
                    u32x4 w; w.x = cvt_pk_bf16(v0[0], v0[1]); w.y = cvt_pk_bf16(v0[2], v0[3]); w.z = cvt_pk_bf16(v1[0], v1[1]); w.w = cvt_pk_bf16(v1[2], v1[3]);
                    *(u32x4*)(rowp + bj * bjstep) = w;
                }
            }
    }
};
struct EpiRes {
    static constexpr bool PERM = true, AFTER_DRAIN = false;
    bf16_t* XR; float* SS; int ldc;
    __device__ __forceinline__ void operator()(const f32x4 (&acc)[2][2][4][2], const Unit& u, int wr, int wc, int fr, int fq) const {
        const int row0 = u.pm * BM + wr * 64 + fr, col0 = u.pn * BM + wc * 32 + 8 * fq;
#pragma unroll
        for (int ai = 0; ai < 2; ++ai)
#pragma unroll
            for (int m = 0; m < 4; ++m) {
                const int row = row0 + ai * HALF + m * 16;
                float q = 0.f;
#pragma unroll
                for (int bj = 0; bj < 2; ++bj) {
                    bf16_t* xp = XR + (size_t)row * ldc + col0 + bj * HALF;
                    const u32x4 xw = *(const u32x4*)xp;
                    f32x4 x0 = {__uint_as_float(xw.x << 16), __uint_as_float(xw.x & 0xffff0000u), __uint_as_float(xw.y << 16), __uint_as_float(xw.y & 0xffff0000u)};
                    f32x4 x1 = {__uint_as_float(xw.z << 16), __uint_as_float(xw.z & 0xffff0000u), __uint_as_float(xw.w << 16), __uint_as_float(xw.w & 0xffff0000u)};
                    x0 = x0 + acc[ai][bj][m][0]; x1 = x1 + acc[ai][bj][m][1];
                    u32x4 w; w.x = cvt_pk_bf16(x0[0], x0[1]); w.y = cvt_pk_bf16(x0[2], x0[3]); w.z = cvt_pk_bf16(x1[0], x1[1]); w.w = cvt_pk_bf16(x1[2], x1[3]);
                    *(u32x4*)xp = w;
                    q += (x0[0] * x0[0] + x0[1] * x0[1]) + (x0[2] * x0[2] + x0[3] * x0[3]) + (x1[0] * x1[0] + x1[1] * x1[1]) + (x1[2] * x1[2] + x1[3] * x1[3]);
                }
                q = xor32_sum(xor16_sum(q));
                if (fq == 0) SS[(size_t)row * 16 + u.pn * 4 + wc] = q;
            }
    }
};
struct EpiScaleRow {
    static constexpr bool PERM = true, AFTER_DRAIN = false;
    bf16_t* O; int ldc; const float* SS; float eps;
    __device__ __forceinline__ void operator()(const f32x4 (&acc)[2][2][4][2], const Unit& u, int wr, int wc, int fr, int fq) const {
        const int row0 = u.pm * BM + wr * 64 + fr, col0 = u.pn * BM + wc * 32 + 8 * fq;
#pragma unroll
        for (int ai = 0; ai < 2; ++ai)
#pragma unroll
            for (int m = 0; m < 4; ++m) {
                const int row = row0 + ai * HALF + m * 16;
                const f32x4* sp = (const f32x4*)(SS + (size_t)row * 16);
                const f32x4 a = sp[0], b = sp[1], c = sp[2], d = sp[3];
                const float tot = (((a[0] + a[1]) + (a[2] + a[3])) + ((b[0] + b[1]) + (b[2] + b[3]))) + (((c[0] + c[1]) + (c[2] + c[3])) + ((d[0] + d[1]) + (d[2] + d[3])));
                const float rs = 1.0f / sqrtf(tot * (1.0f / 1024.0f) + eps);
                bf16_t* rowp = O + (size_t)row * ldc + col0;
#pragma unroll
                for (int bj = 0; bj < 2; ++bj) {
                    const f32x4 v0 = acc[ai][bj][m][0] * rs, v1 = acc[ai][bj][m][1] * rs;
                    u32x4 w; w.x = cvt_pk_bf16(v0[0], v0[1]); w.y = cvt_pk_bf16(v0[2], v0[3]); w.z = cvt_pk_bf16(v1[0], v1[1]); w.w = cvt_pk_bf16(v1[2], v1[3]);
                    *(u32x4*)(rowp + bj * HALF) = w;
                }
            }
    }
};

template <class Epi, class Sched, bool ALIGN_EPI = false, bool SP2 = false>
__device__ __forceinline__ void gemm_phase(PG8_LAS unsigned char* lds, const Gemm g, const Sched& S, const Epi& E) {
    int tid_ = threadIdx.x; asm volatile("" : "+v"(tid_));
    const int tid = tid_, wid = __builtin_amdgcn_readfirstlane(tid >> 6), lane = tid & 63, wr = wid >> 2, wc = wid & 3, fr = lane & 15, fq = lane >> 4;
    const int K = g.K, nt = K / BK;
    unsigned voffA[2], voffB[2];
#pragma unroll
    for (int i = 0; i < 2; ++i) { int R, C; stage_rc(tid * 16 + i * 8192, R, C); const int Rb = Epi::PERM ? ((R & ~31) + perm32(R & 31)) : R;
        voffA[i] = (unsigned)(R * K + C) * 2u; voffB[i] = (unsigned)(Rb * K + C) * 2u; }
    const size_t kstep = (size_t)(BK * 2);
    const size_t hstep = (size_t)HALF * K * 2;
    const size_t tstep = 2 * hstep;
    const unsigned ldsw = (unsigned)wid * 1024u;
    const int aoff = lds_byte(wr * 64 + fr, fq * 8), boff = lds_byte(wc * 32 + fr, fq * 8);
#define PG8_SA(b, h) (((b) * 2 + (h)) * HTB)
#define PG8_SB(b, h) ((4 + (b) * 2 + (h)) * HTB)
#define PG8_STAGE(bufoff, gbase, voff) do { _Pragma("unroll") for (int _i = 0; _i < 2; ++_i) \
        __builtin_amdgcn_global_load_lds((const unsigned*)((const char*)(gbase) + (voff)[_i]), (PG8_LAS unsigned*)(lds + (bufoff) + ldsw + _i * 8192), 16, 0, 0); } while (0)
#define PG8_LDA(dst, b, h) do { _Pragma("unroll") for (int m = 0; m < 4; ++m) _Pragma("unroll") for (int k = 0; k < 2; ++k) dst[m][k] = *(const PG8_LAS bf16x8*)(lds + PG8_SA(b, h) + aoff + m * 2048 + k * 1024); } while (0)
#define PG8_LDB(dst, b, h) do { _Pragma("unroll") for (int n = 0; n < 2; ++n) _Pragma("unroll") for (int k = 0; k < 2; ++k) dst[n][k] = *(const PG8_LAS bf16x8*)(lds + PG8_SB(b, h) + boff + n * 2048 + k * 1024); } while (0)
#define PG8_MMA(ai, bj, At, Bt) do { __builtin_amdgcn_s_setprio(1); _Pragma("unroll") for (int m = 0; m < 4; ++m) _Pragma("unroll") for (int n = 0; n < 2; ++n) _Pragma("unroll") for (int k = 0; k < 2; ++k) \
        acc[ai][bj][m][n] = __builtin_amdgcn_mfma_f32_16x16x32_bf16(Bt[n][k], At[m][k], acc[ai][bj][m][n], 0, 0, 0); __builtin_amdgcn_s_setprio(0); } while (0)
#define PG8_WAIT_V(n) asm volatile("s_waitcnt vmcnt(" #n ")" ::: "memory")
#define PG8_WAIT_L(n) asm volatile("s_waitcnt lgkmcnt(" #n ")" ::: "memory")
#define PG8_BAR __builtin_amdgcn_s_barrier()
#define PG8_SCHED __builtin_amdgcn_sched_barrier(0)
    Unit cur, nxt; int ui = 0;
    if (!S.next(0, cur)) return;
    f32x4 acc[2][2][4][2];
#pragma unroll
    for (int a = 0; a < 2; ++a)
#pragma unroll
        for (int b = 0; b < 2; ++b)
#pragma unroll
            for (int m = 0; m < 4; ++m)
#pragma unroll
                for (int n = 0; n < 2; ++n) acc[a][b][m][n] = (f32x4){0.f, 0.f, 0.f, 0.f};
    bf16x8 At[4][2], B0[2][2], B1[2][2];
    const char* cA = (const char*)g.A + (size_t)cur.pm * tstep; const char* cB = (const char*)g.Bt + (size_t)cur.pn * tstep;
    S.a_ready(cur);
    if constexpr (SP2) {
        PG8_STAGE(PG8_SB(0, 0), cB, voffB); PG8_STAGE(PG8_SB(0, 1), cB + hstep, voffB); PG8_STAGE(PG8_SA(0, 0), cA, voffA); PG8_STAGE(PG8_SA(0, 1), cA + hstep, voffA);
        if (wr == 1) PG8_BAR;
        PG8_WAIT_V(2); PG8_BAR;
        PG8_STAGE(PG8_SB(1, 0), cB + kstep, voffB); PG8_STAGE(PG8_SA(1, 0), cA + kstep, voffA); PG8_STAGE(PG8_SB(1, 1), cB + hstep + kstep, voffB);
        PG8_WAIT_V(6); PG8_BAR;
    } else {
        PG8_STAGE(PG8_SB(0, 0), cB, voffB); PG8_STAGE(PG8_SA(0, 0), cA, voffA); PG8_STAGE(PG8_SB(0, 1), cB + hstep, voffB); PG8_STAGE(PG8_SA(0, 1), cA + hstep, voffA);
        if (wr == 1) PG8_BAR;
        PG8_WAIT_V(4); PG8_BAR;
        PG8_STAGE(PG8_SB(1, 0), cB + kstep, voffB); PG8_STAGE(PG8_SA(1, 0), cA + kstep, voffA); PG8_STAGE(PG8_SB(1, 1), cB + hstep + kstep, voffB);
        PG8_WAIT_V(6); PG8_BAR;
    }
    for (;;) {
        const bool has_next = S.next(ui + 1, nxt);
        const char* nA = has_next ? (const char*)g.A + (size_t)nxt.pm * tstep : cA; const char* nB = has_next ? (const char*)g.Bt + (size_t)nxt.pn * tstep : cB;
        for (int t = 0; t < nt; t += 2) {
            const bool last = (t == nt - 2);
            const char* a1 = cA + (size_t)(t + 1) * kstep;
            const char* a2 = last ? nA : cA + (size_t)(t + 2) * kstep; const char* b2 = last ? nB : cB + (size_t)(t + 2) * kstep;
            const char* a3 = a2 + kstep; const char* b3 = b2 + kstep;
            if (last && has_next) S.a_ready(nxt);
            if constexpr (SP2) {
            PG8_LDB(B0, 0, 0); PG8_LDB(B1, 0, 1); PG8_SCHED; PG8_LDA(At, 0, 0); PG8_STAGE(PG8_SA(1, 1), a1 + hstep, voffA);
            PG8_WAIT_V(8); PG8_WAIT_L(0); PG8_BAR; PG8_MMA(0, 0, At, B0); PG8_MMA(0, 1, At, B1); PG8_BAR; PG8_SCHED;
            PG8_LDA(At, 0, 1); PG8_STAGE(PG8_SB(0, 0), b2, voffB); PG8_STAGE(PG8_SB(0, 1), b2 + hstep, voffB); PG8_STAGE(PG8_SA(0, 0), a2, voffA);
            PG8_WAIT_V(8); PG8_WAIT_L(0); PG8_BAR; PG8_MMA(1, 0, At, B0); PG8_MMA(1, 1, At, B1); PG8_BAR; PG8_SCHED;
            PG8_LDB(B0, 1, 0); PG8_LDB(B1, 1, 1); PG8_SCHED; PG8_LDA(At, 1, 0); PG8_STAGE(PG8_SA(0, 1), a2 + hstep, voffA);
            PG8_WAIT_V(8); PG8_WAIT_L(0); PG8_BAR; PG8_MMA(0, 0, At, B0); PG8_MMA(0, 1, At, B1); PG8_BAR; PG8_SCHED;
            PG8_LDA(At, 1, 1); PG8_STAGE(PG8_SB(1, 0), b3, voffB); PG8_STAGE(PG8_SB(1, 1), b3 + hstep, voffB); PG8_STAGE(PG8_SA(1, 0), a3, voffA);
            PG8_WAIT_V(8); PG8_WAIT_L(0); PG8_BAR; PG8_MMA(1, 0, At, B0); PG8_MMA(1, 1, At, B1); PG8_BAR; PG8_SCHED;
            } else {
            PG8_LDB(B0, 0, 0); PG8_SCHED; PG8_LDA(At, 0, 0); PG8_STAGE(PG8_SA(1, 1), a1 + hstep, voffA);
            PG8_WAIT_L(8); PG8_BAR; PG8_WAIT_L(0); PG8_MMA(0, 0, At, B0); PG8_BAR; PG8_SCHED;
            PG8_LDB(B1, 0, 1); PG8_STAGE(PG8_SB(0, 0), b2, voffB);
            PG8_BAR; PG8_WAIT_L(0); PG8_MMA(0, 1, At, B1); PG8_BAR;
            PG8_LDA(At, 0, 1); PG8_STAGE(PG8_SA(0, 0), a2, voffA);
            PG8_BAR; PG8_WAIT_L(0); PG8_MMA(1, 0, At, B0); PG8_BAR; PG8_SCHED;
            PG8_STAGE(PG8_SB(0, 1), b2 + hstep, voffB);
            PG8_WAIT_V(6); PG8_BAR; PG8_MMA(1, 1, At, B1); PG8_BAR;
            PG8_LDB(B0, 1, 0); PG8_SCHED; PG8_LDA(At, 1, 0); PG8_STAGE(PG8_SA(0, 1), a2 + hstep, voffA);
            PG8_WAIT_L(8); PG8_BAR; PG8_WAIT_L(0); PG8_MMA(0, 0, At, B0); PG8_BAR; PG8_SCHED;
            PG8_LDB(B1, 1, 1); PG8_STAGE(PG8_SB(1, 0), b3, voffB);
            PG8_BAR; PG8_WAIT_L(0); PG8_MMA(0, 1, At, B1); PG8_BAR;
            PG8_LDA(At, 1, 1); PG8_STAGE(PG8_SA(1, 0), a3, voffA);
            PG8_BAR; PG8_WAIT_L(0); PG8_MMA(1, 0, At, B0); PG8_BAR; PG8_SCHED;
            PG8_STAGE(PG8_SB(1, 1), b3 + hstep, voffB);
            PG8_WAIT_V(6); PG8_BAR; PG8_MMA(1, 1, At, B1); PG8_BAR;
            }
        }
        if constexpr (ALIGN_EPI) { if (wr == 0) PG8_BAR; }
        if constexpr (!Epi::AFTER_DRAIN) { E(acc, cur, wr, wc, fr, fq); S.done(cur); }
        if (!has_next) break;
#pragma unroll
        for (int a = 0; a < 2; ++a)
#pragma unroll
            for (int b = 0; b < 2; ++b)
#pragma unroll
                for (int m = 0; m < 4; ++m)
#pragma unroll
                    for (int n = 0; n < 2; ++n) acc[a][b][m][n] = (f32x4){0.f, 0.f, 0.f, 0.f};
        cur = nxt; cA = nA; cB = nB; ++ui;
        if constexpr (ALIGN_EPI) { if (wr == 1) PG8_BAR; }
    }
    PG8_WAIT_V(0);
    if constexpr (!ALIGN_EPI) { if (wr == 0) PG8_BAR; }
    PG8_BAR;
    if constexpr (Epi::AFTER_DRAIN) { E.fused(acc, cur, wr, wc, fr, fq, lds, wid, lane); S.done(cur); }
#undef PG8_SA
#undef PG8_SB
#undef PG8_STAGE
#undef PG8_LDA
#undef PG8_LDB
#undef PG8_MMA
#undef PG8_WAIT_V
#undef PG8_WAIT_L
#undef PG8_BAR
#undef PG8_SCHED
}
}
#define GAS __attribute__((address_space(1)))
#define LAS __attribute__((address_space(3)))
typedef unsigned short bf16;
typedef unsigned v4u __attribute__((ext_vector_type(4)));
typedef float f32x4 __attribute__((ext_vector_type(4)));
typedef short bf16x8 __attribute__((ext_vector_type(8)));
typedef GAS unsigned gu32;
typedef GAS unsigned long long gu64;
#define RLX_AGENT __ATOMIC_RELAXED, __HIP_MEMORY_SCOPE_AGENT
#define LDS_WAIT() asm volatile("s_waitcnt lgkmcnt(0)" ::: "memory")
#define VM_WAIT() asm volatile("s_waitcnt vmcnt(0)" ::: "memory")
__device__ __forceinline__ unsigned long long rt() { return __builtin_amdgcn_s_memrealtime(); }
__device__ __forceinline__ unsigned f2bf(float f) { unsigned u = __builtin_bit_cast(unsigned, f); return (u + 0x7fffu + ((u >> 16) & 1u)) >> 16; }
__device__ __forceinline__ unsigned pk2(float lo, float hi) { return f2bf(lo) | (f2bf(hi) << 16); }

namespace att {
typedef __attribute__((address_space(3))) const char* lds_cptr;
typedef __attribute__((address_space(3))) char* lds_ptr;
typedef __attribute__((address_space(3))) float* lds_fptr;
using s16x4 = __attribute__((ext_vector_type(4))) short;
using f32x16 = __attribute__((ext_vector_type(16))) float;
using u32x4 = __attribute__((ext_vector_type(4))) unsigned;
typedef short v4i16_t __attribute__((ext_vector_type(4)));
typedef float f32x2_t __attribute__((ext_vector_type(2))); typedef __bf16 bf16x2_t __attribute__((ext_vector_type(2)));
constexpr float C2 = 0.125f * 1.4426950408889634f;
__device__ __forceinline__ int crow(int r, int hi) { return (r & 3) + 8 * (r >> 2) + 4 * hi; }
__device__ __forceinline__ unsigned cvtpk_s(float lo, float hi) { f32x2_t v = {lo, hi}; bf16x2_t b = __builtin_convertvector(v, bf16x2_t); return __builtin_bit_cast(unsigned, b); }
__device__ __forceinline__ void glds16(const void* gsrc, unsigned lds_dst) { unsigned keep;
    asm volatile("s_mov_b32 %0, m0\n\ts_mov_b32 m0, %2\n\ts_nop 0\n\tglobal_load_lds_dwordx4 %1, off\n\ts_mov_b32 m0, %0" : "=&s"(keep) : "v"(gsrc), "s"(lds_dst) : "memory"); }
#define ATT_WAITV(N) asm volatile("s_waitcnt vmcnt(" #N ")" ::: "memory")
#define ATT_WAITL() asm volatile("s_waitcnt lgkmcnt(0)" ::: "memory")
#define ATT_BAR() asm volatile("s_waitcnt lgkmcnt(0)\n\ts_barrier" ::: "memory")
__device__ __forceinline__ s16x4 vtr(lds_cptr p) { return __builtin_bit_cast(s16x4, __builtin_amdgcn_ds_read_tr16_b64_v4i16((__attribute__((address_space(3))) v4i16_t*)p)); }

__device__ __forceinline__ int kswz(int row) { return (((row >> 1) & 1) << 2) | ((row >> 2) & 3); }
__device__ __forceinline__ void kread_offs(int (&ko)[4], int r32, int hi) {
#pragma unroll
    for (int d0 = 0; d0 < 4; ++d0) ko[d0] = r32 * 128 + (((2 * d0 + hi) ^ kswz(r32)) << 4);
}
__device__ __forceinline__ void qkt(f32x16& p0, f32x16& p1, lds_cptr kslot, const bf16x8* qr, const int (&ko)[4], float cinit) {
    f32x16 z;
#pragma unroll
    for (int r = 0; r < 16; ++r) z[r] = cinit;
    bf16x8 kf[8];
#pragma unroll
    for (int d0 = 0; d0 < 4; ++d0) { kf[2 * d0] = *(const __attribute__((address_space(3))) bf16x8*)(kslot + ko[d0]); kf[2 * d0 + 1] = *(const __attribute__((address_space(3))) bf16x8*)(kslot + ko[d0] + 4096); }
    __builtin_amdgcn_sched_barrier(0);
#pragma unroll
    for (int d0 = 0; d0 < 4; ++d0) {
        if (d0 == 0) { p0 = __builtin_amdgcn_mfma_f32_32x32x16_bf16(kf[0], qr[0], z, 0, 0, 0); p1 = __builtin_amdgcn_mfma_f32_32x32x16_bf16(kf[1], qr[0], z, 0, 0, 0); }
        else { p0 = __builtin_amdgcn_mfma_f32_32x32x16_bf16(kf[2 * d0], qr[d0], p0, 0, 0, 0); p1 = __builtin_amdgcn_mfma_f32_32x32x16_bf16(kf[2 * d0 + 1], qr[d0], p1, 0, 0, 0); }
    }
}
__device__ __forceinline__ int rowmax_bits(const f32x16& p0, const f32x16& p1) {
    int a, b;
    { const float f0 = p0[0], f1 = p1[0]; a = __float_as_int(f0); b = __float_as_int(f1); }
#pragma unroll
    for (int r = 1; r < 16; ++r) { const float f0 = p0[r], f1 = p1[r]; const int x = __float_as_int(f0), y = __float_as_int(f1); a = a > x ? a : x; b = b > y ? b : y; }
    const int m = a > b ? a : b;
    auto rr = __builtin_amdgcn_permlane32_swap((unsigned)m, (unsigned)m, false, false);
    return (int)rr[0] > (int)rr[1] ? (int)rr[0] : (int)rr[1];
}
__device__ __forceinline__ float rowmax(const f32x16& p0, const f32x16& p1) {
    float a = __builtin_fmaxf(p0[0], p1[0]), b = __builtin_fmaxf(p0[1], p1[1]);
#pragma unroll
    for (int r = 2; r < 16; r += 2) { a = __builtin_fmaxf(a, __builtin_fmaxf(p0[r], p1[r])); b = __builtin_fmaxf(b, __builtin_fmaxf(p0[r + 1], p1[r + 1])); }
    const float m = __builtin_fmaxf(a, b);
    auto rr = __builtin_amdgcn_permlane32_swap(__float_as_uint(m), __float_as_uint(m), false, false);
    return __builtin_fmaxf(__uint_as_float(rr[0]), __uint_as_float(rr[1]));
}
__device__ __forceinline__ float halfsum(float v) {
    auto rr = __builtin_amdgcn_permlane32_swap(__float_as_uint(v), __float_as_uint(v), false, false);
    return __uint_as_float(rr[0]) + __uint_as_float(rr[1]);
}
template <int NDB> __device__ __forceinline__ void vread_offs(int (&vo)[NDB][2], int lane) {
    const int hi = lane >> 5, g1 = (lane >> 4) & 1, q = (lane & 15) >> 2, p = lane & 3, cl = 2 * g1 + (p >> 1);
#pragma unroll
    for (int d0 = 0; d0 < NDB; ++d0)
#pragma unroll
        for (int h8 = 0; h8 < 2; ++h8) {
            const int row = 8 * h8 + 4 * hi + q, c = 4 * d0 + cl;
            if (NDB == 2) vo[d0][h8] = row * 128 + ((c ^ kswz(row)) << 4) + 8 * (p & 1);
            else vo[d0][h8] = row * 256 + ((c ^ ((row & 3) << 2)) << 4) + 8 * (p & 1);
        }
}
constexpr float SM_THR = 4.0f;
template <int NDB>
__device__ __forceinline__ void softmax_pv(f32x16& p0, f32x16& p1, float& m_run, float& l_run, bool first, f32x16 (&o)[NDB], lds_cptr vslot, const int (&vo)[NDB][2], lds_fptr wsf, int r32, int hi) {
    const int mb = rowmax_bits(p0, p1);
    if (__any(first || mb > __builtin_bit_cast(int, SM_THR))) {
        const float rm = rowmax(p0, p1);
        const float dl = first ? rm : __builtin_fmaxf(rm, 0.f);
        m_run += dl;
#pragma unroll
        for (int r = 0; r < 16; ++r) { p0[r] -= dl; p1[r] -= dl; }
        if (!first) {
            const float alpha = __builtin_amdgcn_exp2f(-dl);
            l_run *= alpha;
            if (hi == 0) wsf[r32] = alpha;
            ATT_WAITL();
#pragma unroll
            for (int g = 0; g < 4; ++g) {
                const f32x4 a4 = *(const __attribute__((address_space(3))) f32x4*)(wsf + 8 * g + 4 * hi);
#pragma unroll
                for (int d = 0; d < NDB; ++d) { o[d][4 * g + 0] *= a4[0]; o[d][4 * g + 1] *= a4[1]; o[d][4 * g + 2] *= a4[2]; o[d][4 * g + 3] *= a4[3]; }
            }
        }
    }
    float s = 0.f;
#pragma unroll
    for (int r = 0; r < 16; ++r) { p0[r] = __builtin_amdgcn_exp2f(p0[r]); p1[r] = __builtin_amdgcn_exp2f(p1[r]); s += p0[r] + p1[r]; }
    l_run += s;
    u32x4 pw[4];
#pragma unroll
    for (int k = 0; k < 2; ++k) { pw[k] = (u32x4){cvtpk_s(p0[8 * k], p0[8 * k + 1]), cvtpk_s(p0[8 * k + 2], p0[8 * k + 3]), cvtpk_s(p0[8 * k + 4], p0[8 * k + 5]), cvtpk_s(p0[8 * k + 6], p0[8 * k + 7])};
        pw[2 + k] = (u32x4){cvtpk_s(p1[8 * k], p1[8 * k + 1]), cvtpk_s(p1[8 * k + 2], p1[8 * k + 3]), cvtpk_s(p1[8 * k + 4], p1[8 * k + 5]), cvtpk_s(p1[8 * k + 6], p1[8 * k + 7])}; }
    s16x4 fa[8], fb[8];
#pragma unroll
    for (int ks = 0; ks < 4; ++ks) { fa[2 * ks] = vtr(vslot + vo[0][0] + ks * (1024 * NDB)); fa[2 * ks + 1] = vtr(vslot + vo[0][1] + ks * (1024 * NDB)); }
#pragma unroll
    for (int d0 = 0; d0 < NDB; ++d0) {
        __builtin_amdgcn_sched_barrier(0);
        if (d0 + 1 < NDB) {
#pragma unroll
            for (int ks = 0; ks < 4; ++ks) { if (d0 & 1) { fa[2 * ks] = vtr(vslot + vo[d0 + 1 < NDB ? d0 + 1 : 0][0] + ks * (1024 * NDB)); fa[2 * ks + 1] = vtr(vslot + vo[d0 + 1 < NDB ? d0 + 1 : 0][1] + ks * (1024 * NDB)); }
                else { fb[2 * ks] = vtr(vslot + vo[d0 + 1 < NDB ? d0 + 1 : 0][0] + ks * (1024 * NDB)); fb[2 * ks + 1] = vtr(vslot + vo[d0 + 1 < NDB ? d0 + 1 : 0][1] + ks * (1024 * NDB)); } }
        }
        __builtin_amdgcn_sched_barrier(0);
#pragma unroll
        for (int ks = 0; ks < 4; ++ks) {
            const s16x4 lo = (d0 & 1) ? fb[2 * ks] : fa[2 * ks], hh = (d0 & 1) ? fb[2 * ks + 1] : fa[2 * ks + 1];
            const bf16x8 vb = (bf16x8){lo[0], lo[1], lo[2], lo[3], hh[0], hh[1], hh[2], hh[3]};
            o[d0] = __builtin_amdgcn_mfma_f32_32x32x16_bf16(__builtin_bit_cast(bf16x8, pw[ks]), vb, o[d0], 0, 0, 0);
        }
    }
}
template <int NDB>
__device__ __forceinline__ void pv_only(f32x16 (&o)[NDB], const u32x4 (&pw)[4], lds_cptr vslot, const int (&vo)[NDB][2]) {
#pragma unroll
    for (int d0 = 0; d0 < NDB; ++d0)
#pragma unroll
        for (int ks = 0; ks < 4; ++ks) {
            const s16x4 lo = vtr(vslot + vo[d0][0] + ks * (1024 * NDB)), hh = vtr(vslot + vo[d0][1] + ks * (1024 * NDB));
            const bf16x8 vb = (bf16x8){lo[0], lo[1], lo[2], lo[3], hh[0], hh[1], hh[2], hh[3]};
            o[d0] = __builtin_amdgcn_mfma_f32_32x32x16_bf16(__builtin_bit_cast(bf16x8, pw[ks]), vb, o[d0], 0, 0, 0);
        }
}
template <int NDB>
__device__ __forceinline__ float finish_o(float l_run, f32x16 (&o)[NDB], lds_fptr wsf, int r32, int hi) {
    const float l = halfsum(l_run);
    if (hi == 0) wsf[32 + r32] = 1.0f / l;
    ATT_WAITL();
#pragma unroll
    for (int g = 0; g < 4; ++g) {
        const f32x4 a4 = *(const __attribute__((address_space(3))) f32x4*)(wsf + 32 + 8 * g + 4 * hi);
#pragma unroll
        for (int d = 0; d < NDB; ++d) { o[d][4 * g + 0] *= a4[0]; o[d][4 * g + 1] *= a4[1]; o[d][4 * g + 2] *= a4[2]; o[d][4 * g + 3] *= a4[3]; }
    }
    return l;
}
}

constexpr int NWAVES = 8;
constexpr int NB = 8, SEQ = 4096, DM = 1024, TT = NB * SEQ;
constexpr int MEMT = 256, MEMROWS = NB * MEMT;
constexpr int INW = 2560, SKVW = 4608, PQW = 2048, MKVW = 512;
constexpr int NEXP = 16384;
constexpr float EPS = 1e-5f;
constexpr int NPHASE = 25;

constexpr size_t MiB = 1u << 20;
constexpr size_t WS_CTL = 0, CTL_ZERO_BYTES = 1 * MiB;
constexpr size_t WS_WA = 1 * MiB, WS_WB = 11 * MiB, WS_WMKV = 21 * MiB, WS_WOUT = 25 * MiB, WS_WPQ = 33 * MiB, WS_WSKV = 49 * MiB, WS_PKEYS = 58 * MiB, WS_ROPE = 60 * MiB, WS_SS = 61 * MiB, WS_MEMKV = 63 * MiB;
constexpr size_t WS_PU = 96 * MiB, WS_PV = 160 * MiB;
constexpr int PROW = 544;
constexpr size_t WS_XN = 352 * MiB, WS_XB = 416 * MiB, WS_PROJ = 480 * MiB, WS_MIX = 640 * MiB, WS_SKV = 704 * MiB, WS_END = 992 * MiB;
constexpr size_t WS_MEMN = WS_SKV;
constexpr size_t WS_OG = 224 * MiB;
constexpr size_t WS_LSEG = 368 * MiB;
static_assert(WS_OG + (size_t)TT * 2304 * 2 <= WS_LSEG && WS_LSEG + (size_t)TT * 36 * 4 <= WS_XB + 64 * MiB && WS_OG >= WS_PV + 50 * MiB, "OG scratch");
constexpr int CW_BAR = 4096;

constexpr int RING_OFF = 0, RING_BYTES = 131072;
constexpr int LDSCTL_OFF = RING_BYTES, MISC_OFF = LDSCTL_OFF + 320;
constexpr int PEER_SCR = LDSCTL_OFF + 1024;
constexpr int LDS_BYTES = 163840;
static_assert(PEER_SCR + 8 * 2048 <= LDS_BYTES, "LDS map");

#define XB_TMO      128
#define XB_XCNT(j)  (256  + 64 * (j))
#define XB_XSUB(j)  (1280 + 64 * (j))
#define XB_XGEN(j)  (2304 + 64 * (j))
#define XB_TOP      3328
#define XB_TOPGEN   3392
#define XCD_BAR_WORDS 3456
#define XB_SPIN_CAP (1u << 18)

__device__ __forceinline__ unsigned xb_ld(unsigned* p)              { return __hip_atomic_load(p, __ATOMIC_RELAXED, __HIP_MEMORY_SCOPE_AGENT); }
__device__ __forceinline__ unsigned xb_add(unsigned* p, unsigned v) { return __hip_atomic_fetch_add(p, v, __ATOMIC_RELAXED, __HIP_MEMORY_SCOPE_AGENT); }
__device__ __forceinline__ unsigned xb_xcc_id() { return (unsigned)__builtin_amdgcn_s_getreg((3 << 11) | 20) & 0xFu; }
#define XB_SPIN(cond, bar) do { unsigned _sp = 0; while (cond) { __builtin_amdgcn_s_sleep(1); \
    if ((++_sp & 255u) == 0u) { if (xb_ld(&(bar)[XB_TMO])) break; if (_sp > XB_SPIN_CAP) { atomicAdd(&(bar)[XB_TMO], 1u); break; } } } } while (0)

struct XcdBarrier {
    unsigned* bar; unsigned x;
    volatile LAS unsigned* st;
};

__device__ __forceinline__ XcdBarrier xcd_barrier_post(unsigned* bar, volatile LAS unsigned* st) {
    XcdBarrier b; b.bar = bar; b.x = xb_xcc_id(); b.st = st;
    if (threadIdx.x == 0) (void)xb_add(&bar[XB_XCNT(b.x)], 1u);
    return b;
}
__device__ __forceinline__ void xcd_barrier_complete(unsigned* bar, unsigned x, unsigned& nloc, unsigned& nx) {
    const unsigned G = gridDim.x * gridDim.y * gridDim.z;
    unsigned sum, cnt, mine, sp = 0u;
    for (;;) {
        sum = 0u; cnt = 0u; mine = 0u;
#pragma unroll
        for (unsigned j = 0; j < 16; ++j) { const unsigned c = xb_ld(&bar[XB_XCNT(j)]); sum += c; cnt += (c > 0u) ? 1u : 0u; mine = (j == x) ? c : mine; }
        if (sum == G) break;
        __builtin_amdgcn_s_sleep(1);
        if ((++sp & 255u) == 0u) { if (xb_ld(&bar[XB_TMO])) break; if (sp > XB_SPIN_CAP) { atomicAdd(&bar[XB_TMO], 1u); break; } }
    }
    nloc = mine > 0u ? mine : 1u; nx = cnt > 0u ? cnt : 1u;
}

__device__ __forceinline__ void xcd_barrier(const XcdBarrier& b) {
    asm volatile("s_waitcnt vmcnt(0)" ::: "memory");
    __syncthreads();
    if (threadIdx.x == 0) {
        unsigned* bar = b.bar;
        __builtin_amdgcn_s_waitcnt(0);
        unsigned nloc = b.st[0], nx = b.st[1];
        if (nloc == 0u) { xcd_barrier_complete(bar, b.x, nloc, nx); b.st[0] = nloc; b.st[1] = nx; }
        const unsigned old = xb_add(&bar[XB_XSUB(b.x)], 1u);
        const unsigned gen = old / nloc;
        if (old + 1u == (gen + 1u) * nloc) {
            __builtin_amdgcn_fence(__ATOMIC_RELEASE, "agent");
            asm volatile("s_waitcnt vmcnt(0)" ::: "memory");
            const unsigned og = xb_add(&bar[XB_TOP], 1u);
            const unsigned tg = og / nx;
            if (og + 1u == (tg + 1u) * nx) xb_add(&bar[XB_TOPGEN], 1u);
            else XB_SPIN(xb_ld(&bar[XB_TOPGEN]) == tg, bar);
            __builtin_amdgcn_fence(__ATOMIC_ACQUIRE, "agent");
            xb_add(&bar[XB_XGEN(b.x)], 1u);
            asm volatile("s_waitcnt vmcnt(0)" ::: "memory");
        } else {
            XB_SPIN(xb_ld(&bar[XB_XGEN(b.x)]) == gen, bar);
            __builtin_amdgcn_fence(__ATOMIC_ACQUIRE, "agent");
            asm volatile("s_waitcnt vmcnt(0)" ::: "memory");
        }
    }
    __syncthreads();
}

struct Frame {
    LAS unsigned char* lds;
    volatile LAS unsigned* MISC;
    int tid, lane, wave, vcu, G, bx;
    const unsigned char __attribute__((address_space(4)))* ka;
};
__device__ __forceinline__ Frame make_frame() {
    extern __shared__ __attribute__((aligned(16))) unsigned char lds_dyn_[];
    Frame F; int tid = threadIdx.x, bx = blockIdx.x, G = gridDim.x;
    asm volatile("" : "+v"(tid)); asm volatile("" : "+s"(bx), "+s"(G));
    F.lds = (LAS unsigned char*)lds_dyn_; F.MISC = (volatile LAS unsigned*)(F.lds + MISC_OFF);
    F.tid = tid; F.lane = tid & 63; F.wave = __builtin_amdgcn_readfirstlane(tid >> 6);
    F.G = G; F.vcu = (G % 8 == 0) ? (bx % 8) * (G / 8) + bx / 8 : bx; F.bx = bx;
    F.ka = (const unsigned char __attribute__((address_space(4)))*)__builtin_amdgcn_kernarg_segment_ptr();
    return F;
}
__device__ __forceinline__ const unsigned char __attribute__((address_space(4)))* ka_fresh(const Frame& F) { const unsigned char __attribute__((address_space(4)))* p = F.ka; asm volatile("" : "+s"(p)); return p; }
#define KA_IN(kp, i) (*(const float* const __attribute__((address_space(4)))*)((kp) + 8 * (i)))
#define KA_OUT(kp) (*(float* const __attribute__((address_space(4)))*)((kp) + 144))
#define KA_WS(kp) (*(unsigned char* const __attribute__((address_space(4)))*)((kp) + 152))
#define WSP(T, off) ((T*)(ws_ + (off)))
__device__ __forceinline__ float wave_sum(float v) { return wave_sum_valu(v); }
__device__ __forceinline__ unsigned cvtpk(float lo, float hi) { return att::cvtpk_s(lo, hi); }

__device__ __forceinline__ void p0_transpose_item(const float* W, int K, int N, bf16* WT, const float* gain, LAS float* scr, int item, int lane) {
    const int nblk = N / 32, kb = item / nblk, nb = item % nblk, k0 = 64 * kb, n0 = 32 * nb;
#pragma unroll 8
    for (int i = 0; i < 32; ++i) { const int kk = 2 * i + (lane >> 5); float w = W[(size_t)(k0 + kk) * N + n0 + (lane & 31)]; if (gain) w *= gain[k0 + kk]; scr[kk * 33 + (lane & 31)] = w; }
    LDS_WAIT(); asm volatile("" ::: "memory");
    const int c = lane & 7;
#pragma unroll
    for (int j = 0; j < 4; ++j) { const int n = (lane >> 3) + 8 * j; const LAS float* s = scr + (8 * c) * 33 + n;
        v4u o; o.x = cvtpk(s[0 * 33], s[1 * 33]); o.y = cvtpk(s[2 * 33], s[3 * 33]); o.z = cvtpk(s[4 * 33], s[5 * 33]); o.w = cvtpk(s[6 * 33], s[7 * 33]);
        *(GAS v4u*)(WT + (size_t)(n0 + n) * K + k0 + 8 * c) = o; }
    LDS_WAIT(); asm volatile("" ::: "memory");
}
__device__ __forceinline__ void cvt_row(const float* src, bf16* dst, int lane) {
    const GAS f32x4* s = (const GAS f32x4*)src + lane; GAS unsigned long long* d = (GAS unsigned long long*)dst + lane;
    f32x4 v[4];
#pragma unroll
    for (int j = 0; j < 4; ++j) v[j] = s[64 * j];
#pragma unroll
    for (int j = 0; j < 4; ++j) d[64 * j] = (unsigned long long)cvtpk(v[j].x, v[j].y) | ((unsigned long long)cvtpk(v[j].z, v[j].w) << 32);
}
template <bool PERM> __device__ __forceinline__ void cvt_2rows_fp4(const float* src, unsigned char* dst, int lane) {
    const int l = lane & 31, h = lane >> 5;
    const GAS f32x4* s = (const GAS f32x4*)(src + (size_t)h * DM + 32 * l);
    f32x4 v[8]; float am = 0.f;
#pragma unroll
    for (int j = 0; j < 8; ++j) { v[j] = s[j]; am = __builtin_fmaxf(am, __builtin_fmaxf(__builtin_fmaxf(__builtin_fabsf(v[j].x), __builtin_fabsf(v[j].y)), __builtin_fmaxf(__builtin_fabsf(v[j].z), __builtin_fabsf(v[j].w)))); }
    const unsigned tb = __float_as_uint(am * (1.0f / 6.0f));
    int eb = (int)(tb >> 23) + ((tb & 0x7fffffu) ? 1 : 0); eb = eb < 1 ? 1 : (eb > 254 ? 254 : eb);
    const float sc = __uint_as_float((unsigned)eb << 23);
    unsigned p[4];
#pragma unroll
    for (int k = 0; k < 4; ++k) { unsigned w = 0u;
        w = __builtin_amdgcn_cvt_scalef32_pk_fp4_f32(w, v[2 * k].x, v[2 * k].y, sc, 0); w = __builtin_amdgcn_cvt_scalef32_pk_fp4_f32(w, v[2 * k].z, v[2 * k].w, sc, 1);
        w = __builtin_amdgcn_cvt_scalef32_pk_fp4_f32(w, v[2 * k + 1].x, v[2 * k + 1].y, sc, 2); w = __builtin_amdgcn_cvt_scalef32_pk_fp4_f32(w, v[2 * k + 1].z, v[2 * k + 1].w, sc, 3); p[k] = w; }
    unsigned char* d = dst + (size_t)h * PROW;
    *(GAS v4u*)(d + 16 * l) = (v4u){p[0], p[1], p[2], p[3]};
    d[512 + (PERM ? 8 * (l & 3) + (l >> 2) : l)] = (unsigned char)eb;
}
__device__ __forceinline__ void rms_row(const float* xrow, const float* g, bf16* orow, bf16* cp, int lane) {
    const GAS f32x4* xr = (const GAS f32x4*)xrow + lane; const GAS f32x4* gr = (const GAS f32x4*)g + lane;
    f32x4 v[4]; float s = 0.f;
#pragma unroll
    for (int j = 0; j < 4; ++j) { v[j] = xr[64 * j]; s += (v[j].x * v[j].x + v[j].y * v[j].y) + (v[j].z * v[j].z + v[j].w * v[j].w); }
    if (cp) { GAS unsigned long long* c = (GAS unsigned long long*)cp + lane;
#pragma unroll
        for (int j = 0; j < 4; ++j) c[64 * j] = (unsigned long long)cvtpk(v[j].x, v[j].y) | ((unsigned long long)cvtpk(v[j].z, v[j].w) << 32); }
    const float rstd = 1.0f / sqrtf(wave_sum(s) * (1.f / DM) + EPS);
    GAS unsigned long long* o8 = (GAS unsigned long long*)orow + lane;
#pragma unroll
    for (int j = 0; j < 4; ++j) { const f32x4 gg = gr[64 * j]; o8[64 * j] = (unsigned long long)cvtpk(v[j].x * rstd * gg.x, v[j].y * rstd * gg.y) | ((unsigned long long)cvtpk(v[j].z * rstd * gg.z, v[j].w * rstd * gg.w) << 32); }
}
__device__ __forceinline__ void p0_prologue(Frame& F) {
    const auto kp_ = ka_fresh(F); unsigned char* const ws_ = KA_WS(kp_); float* const out_ = KA_OUT(kp_);
#define FIN(i) KA_IN(kp_, i)
    LAS float* scr = (LAS float*)(F.lds + RING_OFF + F.wave * 16384);
    const int gw = F.vcu * NWAVES + F.wave, NGW = F.G * NWAVES, lane = F.lane;
    constexpr int I_IN = 16 * (INW / 32), I_MKV = 16 * (MKVW / 32), I_OUT = 16 * (DM / 32), I_PQ = 16 * (PQW / 32), I_SKV = 16 * (SKVW / 32);
    constexpr int E0 = 2 * I_IN, E1 = E0 + 2 * I_IN, E2 = E1 + 4 * I_MKV, E3 = E2 + 4 * I_OUT, E4 = E3 + 4 * I_PQ, E5 = E4 + I_SKV;
    for (int it = gw; it < E5; it += NGW) {
        if (it < E0) { const int l = it / I_IN, r = it % I_IN; p0_transpose_item(FIN(3) + (size_t)l * DM * INW, DM, INW, WSP(bf16, WS_WA) + (size_t)l * INW * DM, nullptr, scr, r, lane); }
        else if (it < E1) { const int q = it - E0, l = q / I_IN, r = q % I_IN; p0_transpose_item(FIN(6) + (size_t)l * DM * INW, DM, INW, WSP(bf16, WS_WB) + (size_t)l * INW * DM, nullptr, scr, r, lane); }
        else if (it < E2) { const int q = it - E1, l = q / I_MKV, r = q % I_MKV; p0_transpose_item(FIN(8) + (size_t)l * DM * MKVW, DM, MKVW, WSP(bf16, WS_WMKV) + (size_t)l * MKVW * DM, nullptr, scr, r, lane); }
        else if (it < E3) { const int q = it - E2, l = q / I_OUT, r = q % I_OUT; p0_transpose_item(FIN(9) + (size_t)l * DM * DM, DM, DM, WSP(bf16, WS_WOUT) + (size_t)l * DM * DM, nullptr, scr, r, lane); }
        else if (it < E4) { const int q = it - E3, l = q / I_PQ, r = q % I_PQ; p0_transpose_item(FIN(11) + (size_t)l * DM * PQW, DM, PQW, WSP(bf16, WS_WPQ) + (size_t)l * PQW * DM, FIN(10) + l * DM, scr, r, lane); }
        else { const int r = it - E4; p0_transpose_item(FIN(16), DM, SKVW, WSP(bf16, WS_WSKV), nullptr, scr, r, lane); }
    }
    for (int r2 = gw; r2 < 2 * NEXP; r2 += NGW) { cvt_2rows_fp4<true>(FIN(13) + (size_t)r2 * 2 * DM, WSP(unsigned char, WS_PU) + (size_t)r2 * 2 * PROW, lane); cvt_2rows_fp4<false>(FIN(14) + (size_t)r2 * 2 * DM, WSP(unsigned char, WS_PV) + (size_t)r2 * 2 * PROW, lane); }
    for (int r = gw; r < 1024; r += NGW) cvt_row(FIN(12) + (size_t)r * 1024, WSP(bf16, WS_PKEYS) + (size_t)r * 1024, lane);
    for (int e = gw * 64 + lane; e < SEQ * 8; e += NGW * 64) { const int t = e >> 3, i = e & 7;
        const double ang = (double)t * pow(500000.0, -(double)i / 8.0);
        WSP(float, WS_ROPE)[t * 16 + i] = (float)cos(ang); WSP(float, WS_ROPE)[t * 16 + 8 + i] = (float)sin(ang); }
    for (int r = gw; r < 4 * MEMROWS; r += NGW) { const int l = r / MEMROWS, m = r % MEMROWS; rms_row(FIN(1) + (size_t)m * DM, FIN(7) + l * DM, WSP(bf16, WS_MEMN) + (size_t)r * DM, nullptr, lane); }
    for (int m = gw; m < TT; m += NGW) rms_row(FIN(0) + (size_t)m * DM, FIN(2), WSP(bf16, WS_XN) + (size_t)m * DM, WSP(bf16, WS_XB) + (size_t)m * DM, lane);
}
#undef FIN

__device__ __forceinline__ void diff_unit(Frame& F, int b, int h, int ib, const bf16* PROJ, bf16* MIX, float lam, float oml, const float* subg) {
    using namespace att;
    const int lane = F.lane, r32 = lane & 31, hi = lane >> 5, w = F.wave, p = w >> 2, wq = w & 3;
    const lds_cptr L = (lds_cptr)(F.lds + RING_OFF);
    const unsigned lds0 = (unsigned)(uintptr_t)(F.lds + RING_OFF);
    lds_fptr wsf = (lds_fptr)(F.lds + RING_OFF + 98304 + w * 256);
    const size_t rb = (size_t)b * SEQ;
    const bf16* Qw = PROJ + (rb + 128 * ib + 32 * wq + r32) * INW + (2 * h + p) * 64;
    const bf16* Kg = PROJ + rb * INW + 768 + (2 * h) * 64;
    const bf16* Vg = PROJ + rb * INW + 1536 + h * 128;
    const int NT = 2 * (ib + 1);
    const int krow_ = 8 * w + (lane >> 3), kch_ = (lane & 7) ^ kswz(krow_);
    const bf16* ksrc0 = Kg + (size_t)krow_ * INW + kch_ * 8;
    const bf16* ksrc1 = ksrc0 + 64;
    const int vrow_ = 8 * w + (lane >> 4), vch_ = (lane & 15) ^ ((vrow_ & 3) << 2);
    const bf16* vsrc0 = Vg + (size_t)vrow_ * INW + vch_ * 8;
    const bf16* vsrc1 = vsrc0 + (size_t)4 * INW;
#define DIFF_ISSUE(t, slot) do { const size_t go_ = (size_t)(t) * 64 * INW; const unsigned sb_ = lds0 + (slot) * 32768; \
        glds16(ksrc0 + go_, (unsigned)__builtin_amdgcn_readfirstlane(sb_ + w * 1024)); glds16(ksrc1 + go_, (unsigned)__builtin_amdgcn_readfirstlane(sb_ + 8192 + w * 1024)); \
        glds16(vsrc0 + go_, (unsigned)__builtin_amdgcn_readfirstlane(sb_ + 16384 + w * 2048)); glds16(vsrc1 + go_, (unsigned)__builtin_amdgcn_readfirstlane(sb_ + 16384 + w * 2048 + 1024)); } while (0)
    DIFF_ISSUE(0, 0); DIFF_ISSUE(1, 1);
    bf16x8 qr[4];
#pragma unroll
    for (int d0 = 0; d0 < 4; ++d0) qr[d0] = *(const bf16x8*)(Qw + d0 * 16 + hi * 8);
    asm volatile("" : "+v"(qr[0]), "+v"(qr[1]), "+v"(qr[2]), "+v"(qr[3]));
    float m_run = 0.f, l_run = 0.f; f32x16 o[4];
#pragma unroll
    for (int d = 0; d < 4; ++d) o[d] = f32x16{};
    const int qrel = 32 * wq + r32; int ko[4], vo[4][2]; kread_offs(ko, r32, hi); vread_offs<4>(vo, lane);
    int sl = 0;
    for (int t = 0; t < NT; ++t) {
        if (t + 1 < NT) ATT_WAITV(4); else ATT_WAITV(0);
        ATT_BAR();
        if (t + 2 < NT) DIFF_ISSUE(t + 2, (sl >= 1 ? sl - 1 : 2));
        const lds_cptr S = L + sl * 32768;
        f32x16 p0, p1;
        qkt(p0, p1, S + p * 8192, qr, ko, -m_run);
        const int jb = t - (NT - 2);
        if (jb >= 0) { const int kb = 64 * jb + 4 * hi;
#pragma unroll
            for (int r = 0; r < 16; ++r) { const int kv = kb + (r & 3) + 8 * (r >> 2); if (kv > qrel) p0[r] = -INFINITY; if (kv + 32 > qrel) p1[r] = -INFINITY; } }
        softmax_pv<4>(p0, p1, m_run, l_run, t == 0, o, S + 16384, vo, wsf, r32, hi);
        sl = sl == 2 ? 0 : sl + 1;
    }
#undef DIFF_ISSUE
    finish_o<4>(l_run, o, wsf, r32, hi);
    ATT_BAR();
    lds_fptr X = (lds_fptr)(F.lds + RING_OFF) + wq * 4096;
    if (p == 1) {
#pragma unroll
        for (int d = 0; d < 4; ++d)
#pragma unroll
            for (int r = 0; r < 16; ++r) X[(d * 16 + r) * 64 + lane] = o[d][r];
    }
    ATT_BAR();
    if (p == 0) {
        float ss[16];
#pragma unroll
        for (int r = 0; r < 16; ++r) ss[r] = 0.f;
#pragma unroll
        for (int d = 0; d < 4; ++d)
#pragma unroll
            for (int r = 0; r < 16; ++r) { const float v = o[d][r] - lam * X[(d * 16 + r) * 64 + lane]; o[d][r] = v; ss[r] += v * v; }
#pragma unroll
        for (int r = 0; r < 16; ++r) {
            float s = ss[r];
            s = half32_sum(s);
            ss[r] = oml / sqrtf(s * (1.f / 128.f) + EPS);
        }
        LAS unsigned short* stg = (LAS unsigned short*)(F.lds + RING_OFF + 65536 + wq * 8192);
#pragma unroll
        for (int d = 0; d < 4; ++d) { const float g = subg[32 * d + r32];
#pragma unroll
            for (int r = 0; r < 16; ++r) { const unsigned short hb = (unsigned short)(cvtpk(o[d][r] * ss[r] * g, 0.f) & 0xffffu); stg[crow(r, hi) * 128 + 32 * d + r32] = hb; } }
        ATT_WAITL();
        bf16* Ow = MIX + (rb + 128 * ib + 32 * wq) * DM + h * 128;
#pragma unroll
        for (int i = 0; i < 8; ++i) { const int idx = i * 64 + lane, row = idx >> 4, ch = idx & 15;
            const u32x4 v = *(const LAS u32x4*)(stg + row * 128 + ch * 8); *(u32x4*)(Ow + (size_t)row * DM + ch * 8) = v; }
    }
    ATT_BAR();
}

constexpr int WP_STRIDE = 16384;
struct MemMap {
    int base;
    __device__ __forceinline__ int nt() const { return 4; }
    __device__ __forceinline__ int first() const { return 0; }
    __device__ __forceinline__ int krow(int tt, int j) const { return base + 64 * tt + j; }
    __device__ __forceinline__ void mask(int, att::f32x16&, att::f32x16&, int, int) const {}
};
struct DilMap {
    int rowbase, d, res, m0, ks, Lm1;
    __device__ __forceinline__ int nt() const { return 3; }
    __device__ __forceinline__ int first() const { return ks + 64 <= 0 ? (ks + 128 <= 0 ? 2 : 1) : 0; }
    __device__ __forceinline__ int krow(int tt, int j) const { int mp = ks + 64 * tt + j; mp = mp < 0 ? 0 : (mp > Lm1 ? Lm1 : mp); return rowbase + mp * d + res; }
    __device__ __forceinline__ void mask(int tt, att::f32x16& p0, att::f32x16& p1, int r32, int hi) const {
        const int m = m0 + r32, kb = ks + 64 * tt + 4 * hi;
#pragma unroll
        for (int r = 0; r < 16; ++r) { const int mp = kb + (r & 3) + 8 * (r >> 2);
            if (mp < 0 || mp > m || mp < m - 128) p0[r] = -INFINITY;
            if (mp + 32 < 0 || mp + 32 > m || mp + 32 < m - 128) p1[r] = -INFINITY; }
    }
};
template <class KM>
__device__ __forceinline__ void win_attn(Frame& F, const KM& km, const bf16* qp, const bf16* Kg, int pitchK, const bf16* Vg, int pitchV, att::f32x16 (&o)[2], float& m_out, float& l_out) {
    using namespace att;
    const int lane = F.lane, r32 = lane & 31, hi = lane >> 5, w = F.wave;
    const unsigned kdst = (unsigned)(uintptr_t)(F.lds + RING_OFF + w * WP_STRIDE), vdst = kdst + 8192;
    const lds_cptr Ks = (lds_cptr)(F.lds + RING_OFF + w * WP_STRIDE), Vs = Ks + 8192;
    lds_fptr wsf = (lds_fptr)(F.lds + PEER_SCR + w * 256);
    bf16x8 qr[4];
#pragma unroll
    for (int d0 = 0; d0 < 4; ++d0) qr[d0] = *(const bf16x8*)(qp + d0 * 16 + hi * 8);
    asm volatile("" : "+v"(qr[0]), "+v"(qr[1]), "+v"(qr[2]), "+v"(qr[3]));
    float m_run = 0.f, l_run = 0.f;
    o[0] = f32x16{}; o[1] = f32x16{};
    int ko[4], vo[2][2]; kread_offs(ko, r32, hi); vread_offs<2>(vo, lane);
#define WP_ISSUE_K(tt) do { _Pragma("unroll") for (int i_ = 0; i_ < 8; ++i_) { const int row_ = 8 * i_ + (lane >> 3); \
        glds16(Kg + (size_t)km.krow(tt, row_) * pitchK + (((lane & 7) ^ kswz(row_)) << 3), (unsigned)__builtin_amdgcn_readfirstlane(kdst + i_ * 1024)); } } while (0)
#define WP_ISSUE_V(tt) do { _Pragma("unroll") for (int i_ = 0; i_ < 8; ++i_) { const int row_ = 8 * i_ + (lane >> 3); \
        glds16(Vg + (size_t)km.krow(tt, row_) * pitchV + (((lane & 7) ^ kswz(row_)) << 3), (unsigned)__builtin_amdgcn_readfirstlane(vdst + i_ * 1024)); } } while (0)
    const int t0 = km.first(), nt = km.nt();
    ATT_WAITL();
    WP_ISSUE_K(t0); WP_ISSUE_V(t0);
    for (int tt = t0; tt < nt; ++tt) {
        ATT_WAITV(8);
        f32x16 p0, p1;
        qkt(p0, p1, Ks, qr, ko, -m_run);
        if (tt + 1 < nt) { ATT_WAITL(); WP_ISSUE_K(tt + 1); ATT_WAITV(8); } else { ATT_WAITV(0); }
        km.mask(tt, p0, p1, r32, hi);
        softmax_pv<2>(p0, p1, m_run, l_run, tt == t0, o, Vs, vo, wsf, r32, hi);
        if (tt + 1 < nt) { ATT_WAITL(); WP_ISSUE_V(tt + 1); }
    }
#undef WP_ISSUE_K
#undef WP_ISSUE_V
    l_out = finish_o<2>(l_run, o, wsf, r32, hi);
    m_out = m_run;
}
template <class RowOff>
__device__ __forceinline__ void win_store(Frame& F, const att::f32x16 (&o)[2], bf16* dst, const RowOff& rowoff) {
    using namespace att;
    const int lane = F.lane, r32 = lane & 31, hi = lane >> 5;
    LAS unsigned short* stg = (LAS unsigned short*)(F.lds + RING_OFF + F.wave * WP_STRIDE);
    ATT_WAITL();
#pragma unroll
    for (int r = 0; r < 16; ++r) { const int orow = crow(r, hi);
#pragma unroll
        for (int d0 = 0; d0 < 2; ++d0) stg[orow * 64 + d0 * 32 + r32] = (unsigned short)(cvtpk(o[d0][r], 0.f) & 0xffffu); }
    ATT_WAITL();
#pragma unroll
    for (int i = 0; i < 4; ++i) { const int row = i * 8 + (lane >> 3), ch = lane & 7; const u32x4 v = *(const LAS u32x4*)(stg + row * 64 + ch * 8); *(u32x4*)(dst + rowoff(row) + ch * 8) = v; }
    ATT_WAITL();
}
__device__ __forceinline__ void mem_attn_all(Frame& F, const bf16* PROJ, const bf16* MKV, bf16* MIX) {
    const int gw = F.vcu * NWAVES + F.wave, NGW = F.G * NWAVES, r32 = F.lane & 31;
    for (int qb = gw; qb < NB * 4 * (SEQ / 32); qb += NGW) {
        const int blk = qb % (SEQ / 32), mh = (qb / (SEQ / 32)) & 3, b = qb / (4 * (SEQ / 32));
        const size_t row0 = (size_t)b * SEQ + 32 * blk;
        MemMap km{b * MEMT};
        att::f32x16 o[2]; float m_, l_;
        win_attn(F, km, PROJ + (row0 + r32) * INW + 2304 + mh * 64, MKV + mh * 64, MKVW, MKV + 256 + mh * 64, MKVW, o, m_, l_);
        win_store(F, o, MIX + row0 * DM + 768 + mh * 64, [](int i) { return (size_t)i * DM; });
    }
}
__device__ __forceinline__ void dil_strip(Frame& F, int b, int head, int res, int s, int d, const bf16* PROJ, const bf16* SKV, bf16* OG, float* LSEG) {
    using namespace att;
    const int lane = F.lane, r32 = lane & 31, hi = lane >> 5, w = F.wave;
    const lds_cptr L = (lds_cptr)(F.lds + RING_OFF);
    const unsigned lds0 = (unsigned)(uintptr_t)(F.lds + RING_OFF);
    lds_fptr wsf = (lds_fptr)(F.lds + PEER_SCR + w * 256);
    const int rb = b * SEQ, Lm1 = SEQ / d - 1, kb0 = 256 * s - 128, m0 = 256 * s + 32 * w;
    const bf16* Kg = SKV + head * 64; const bf16* Vg = Kg + 2304;
    {   const int row_ = 8 * w + (lane >> 3), co_ = ((lane & 7) ^ kswz(row_)) << 3;
#pragma unroll
        for (int j = 0; j < 6; ++j) if (kb0 + 64 * j + 64 > 0) {
            int mp = kb0 + 64 * j + row_; mp = mp < 0 ? 0 : (mp > Lm1 ? Lm1 : mp);
            const size_t go = (size_t)(rb + mp * d + res) * SKVW + co_;
            glds16(Kg + go, (unsigned)__builtin_amdgcn_readfirstlane(lds0 + j * 16384 + w * 1024)); glds16(Vg + go, (unsigned)__builtin_amdgcn_readfirstlane(lds0 + j * 16384 + 8192 + w * 1024)); } }
    const size_t qrow = (size_t)rb + (size_t)(m0 + r32) * d + res;
    bf16x8 qr[4];
#pragma unroll
    for (int d0 = 0; d0 < 4; ++d0) qr[d0] = *(const bf16x8*)(PROJ + qrow * INW + head * 64 + d0 * 16 + hi * 8);
    asm volatile("" : "+v"(qr[0]), "+v"(qr[1]), "+v"(qr[2]), "+v"(qr[3]));
    int ko[4], vo[2][2]; kread_offs(ko, r32, hi); vread_offs<2>(vo, lane);
    ATT_WAITV(0); ATT_BAR();
    float m_run = 0.f, l_run = 0.f; f32x16 o[2]; o[0] = f32x16{}; o[1] = f32x16{};
    DilMap km{rb, d, res, m0, kb0, Lm1};
    bool first = true;
    for (int jj = 0; jj < 3; ++jj) {
        const int j = (w >> 1) + jj;
        if (kb0 + 64 * j + 64 <= 0) continue;
        f32x16 p0, p1;
        qkt(p0, p1, L + j * 16384, qr, ko, -m_run);
        km.mask(j, p0, p1, r32, hi);
        softmax_pv<2>(p0, p1, m_run, l_run, first, o, L + j * 16384 + 8192, vo, wsf, r32, hi);
        first = false;
    }
    const float l = finish_o<2>(l_run, o, wsf, r32, hi);
    {   LAS unsigned short* stg = (LAS unsigned short*)(F.lds + RING_OFF + 98304 + w * 4096);
#pragma unroll
        for (int r = 0; r < 16; ++r) { const int orow = crow(r, hi);
#pragma unroll
            for (int d0 = 0; d0 < 2; ++d0) stg[orow * 64 + d0 * 32 + r32] = (unsigned short)(cvtpk(o[d0][r], 0.f) & 0xffffu); }
        ATT_WAITL();
        bf16* dst = OG + ((size_t)rb + (size_t)m0 * d + res) * 2304 + head * 64;
#pragma unroll
        for (int i = 0; i < 4; ++i) { const int row = i * 8 + (lane >> 3), ch = lane & 7; const u32x4 v = *(const LAS u32x4*)(stg + row * 64 + ch * 8); *(u32x4*)(dst + (size_t)row * d * 2304 + ch * 8) = v; }
        if (hi == 0) LSEG[qrow * 36 + head] = m_run + __builtin_amdgcn_logf(l); }
    ATT_BAR();
}
__device__ __forceinline__ void dil_combine_all(Frame& F, const bf16* OG, const float* LSEG, bf16* MIX) {
    const int gt = F.vcu * (NWAVES * 64) + F.tid, NT_ = F.G * NWAVES * 64;
    for (int it = gt; it < TT * 12; it += NT_) {
        const int row = it / 12, j = it - row * 12;
        const float* lp = LSEG + (size_t)row * 36 + j; const float l0 = lp[0], l1 = lp[12], l2 = lp[24];
        const float mx = __builtin_fmaxf(l0, __builtin_fmaxf(l1, l2));
        float a0 = __builtin_amdgcn_exp2f(l0 - mx), a1 = __builtin_amdgcn_exp2f(l1 - mx), a2 = __builtin_amdgcn_exp2f(l2 - mx);
        const float inv = 1.0f / (a0 + a1 + a2); a0 *= inv; a1 *= inv; a2 *= inv;
        const v4u* g0 = (const v4u*)(OG + (size_t)row * 2304 + j * 64); const v4u* g1 = g0 + 12 * 8; const v4u* g2 = g1 + 12 * 8;
        v4u* dst = (v4u*)(MIX + (size_t)row * DM + j * 64);
#pragma unroll
        for (int c = 0; c < 8; ++c) {
            const v4u x = g0[c], y = g1[c], z = g2[c]; v4u r;
#pragma unroll
            for (int k = 0; k < 4; ++k) {
                const unsigned xk = x[k], yk = y[k], zk = z[k];
                const float lo = a0 * __uint_as_float(xk << 16) + a1 * __uint_as_float(yk << 16) + a2 * __uint_as_float(zk << 16);
                const float hh = a0 * __uint_as_float(xk & 0xffff0000u) + a1 * __uint_as_float(yk & 0xffff0000u) + a2 * __uint_as_float(zk & 0xffff0000u);
                r[k] = cvtpk(lo, hh);
            }
            dst[c] = r;
        }
    }
}
#ifndef REPMASK
#define REPMASK 0
#endif
#define NREP(b) (((REPMASK) & (b)) ? 2 : 1)

#define CEX(a, b) do { const float hi_ = __builtin_fmaxf(a, b), lo_ = __builtin_fminf(a, b); a = hi_; b = lo_; } while (0)
template <int K, int J> __device__ __forceinline__ void bstage(float (&a)[16]) {
#pragma unroll
    for (int i = 0; i < 16; ++i) { constexpr int k = K, j = J; const int l = i ^ j; if (l > i) { if ((i & k) == 0) CEX(a[i], a[l]); else CEX(a[l], a[i]); } }
}
__device__ __forceinline__ void sort16_desc(float (&a)[16]) {
    bstage<2, 1>(a); bstage<4, 2>(a); bstage<4, 1>(a); bstage<8, 4>(a); bstage<8, 2>(a); bstage<8, 1>(a); bstage<16, 8>(a); bstage<16, 4>(a); bstage<16, 2>(a); bstage<16, 1>(a);
}
__device__ __forceinline__ void merge16(float (&a)[16], const float (&b)[16]) {
#pragma unroll
    for (int i = 0; i < 16; ++i) a[i] = __builtin_fmaxf(a[i], b[15 - i]);
    bstage<16, 8>(a); bstage<16, 4>(a); bstage<16, 2>(a); bstage<16, 1>(a);
}
__device__ __forceinline__ void top16_of_64(const float (&v)[64], float (&out)[16]) {
    float c1[16], c2[16], c3[16];
#pragma unroll
    for (int i = 0; i < 16; ++i) { out[i] = v[i]; c1[i] = v[16 + i]; }
    sort16_desc(out); sort16_desc(c1); merge16(out, c1);
#pragma unroll
    for (int i = 0; i < 16; ++i) { c2[i] = v[32 + i]; c3[i] = v[48 + i]; }
    sort16_desc(c2); sort16_desc(c3); merge16(c2, c3); merge16(out, c2);
}
struct CandTab { int pos[16][16]; int inv[64]; int n;
    constexpr CandTab() : pos{}, inv{}, n(0) { for (int q = 0; q < 64; ++q) inv[q] = -1; for (int a = 0; a < 16; ++a) for (int b = 0; b < 16; ++b) { if ((a + 1) * (b + 1) <= 16) { pos[a][b] = n; inv[n] = a * 16 + b; ++n; } else pos[a][b] = -1; } } };
static constexpr CandTab kCand{};
static_assert(kCand.n == 50, "50 candidate pairs");
__device__ __forceinline__ float gelu1(float v) { pg8::f32x2 t = {v, v}; return pg8::gelu_pk(t).x; }
__device__ __forceinline__ float half32_max(float v) {
    v = dpp_maxc<0xB1>(v); v = dpp_maxc<0x4E>(v); v = dpp_maxc<0x141>(v); v = dpp_maxc<0x140>(v);
    auto r = __builtin_amdgcn_permlane16_swap(__float_as_uint(v), __float_as_uint(v), false, false); return __builtin_fmaxf(__uint_as_float(r[0]), __uint_as_float(r[1]));
}

__device__ __forceinline__ void peer_phase(Frame& F, int l) {
    using att::f32x16; using att::crow;
    const int lane = F.lane, r32 = lane & 31, hi = lane >> 5, w = F.wave;
    const auto kp_ = ka_fresh(F); unsigned char* const ws_ = KA_WS(kp_); float* const out_ = KA_OUT(kp_);
    const bf16* PQ = WSP(bf16, WS_PROJ);
    const bf16* keys = WSP(bf16, WS_PKEYS) + (size_t)l * 16 * 128 * 128;
    const unsigned char* U6 = WSP(unsigned char, WS_PU) + (size_t)l * NEXP * PROW;
    const unsigned char* V6 = WSP(unsigned char, WS_PV) + (size_t)l * NEXP * PROW;
    LAS unsigned* ids = (LAS unsigned*)(F.lds + RING_OFF);
    const unsigned kbuf = (unsigned)(uintptr_t)(F.lds + RING_OFF + 65536 + (w >> 2) * 32768);
    const att::lds_cptr KB = (att::lds_cptr)(F.lds + RING_OFF + 65536 + (w >> 2) * 32768);
    LAS unsigned char* scr = F.lds + PEER_SCR + w * 2048 + lane * 32;
    const float* gf = KA_IN(kp_, 10) + l * DM;
    for (int tile = F.bx; tile < TT / 128; tile += F.G) {
        {
            const int tokl = 32 * (w & 3) + r32; const size_t tok = (size_t)tile * 128 + tokl;
#define KEYS_ISSUE(gi) do { const bf16* kg_ = keys + (size_t)((4 * (w >> 2)) * 2 + (gi)) * 16384; int ln_ = lane; asm volatile("" : "+v"(ln_)); _Pragma("unroll") for (int i_ = 0; i_ < 8; ++i_) { const int q_ = 8 * (w & 3) + i_, row_ = 4 * q_ + (ln_ >> 4); \
                att::glds16(kg_ + row_ * 128 + (((ln_ & 15) ^ (row_ & 15)) << 3), (unsigned)__builtin_amdgcn_readfirstlane(kbuf + q_ * 1024)); } } while (0)
            for (int rep_ = 0; rep_ < NREP(256); ++rep_) {
            KEYS_ISSUE(0);
            bf16x8 bq[8];
            { const bf16* qp = PQ + tok * PQW + (4 * (w >> 2)) * 256 + hi * 8;
#pragma unroll
              for (int ks = 0; ks < 8; ++ks) bq[ks] = *(const bf16x8*)(qp + ks * 16); }
            for (int hh = 0; hh < 4; ++hh) {
                const int h = 4 * (w >> 2) + hh;
                float L0[16], L1[16];
#pragma unroll
                for (int p = 0; p < 2; ++p) {
                    asm volatile("" : "+v"(bq[0]), "+v"(bq[1]), "+v"(bq[2]), "+v"(bq[3]), "+v"(bq[4]), "+v"(bq[5]), "+v"(bq[6]), "+v"(bq[7]));
                    ATT_WAITV(0); ATT_BAR();
                    f32x16 acc[4];
#pragma unroll
                    for (int kb = 0; kb < 4; ++kb) acc[kb] = f32x16{};
                    const int kro = r32 * 256, ksw = r32 & 15;
#pragma unroll
                    for (int ks = 0; ks < 8; ++ks) {
#pragma unroll
                        for (int kb = 0; kb < 4; ++kb) { const bf16x8 ak = *(const __attribute__((address_space(3))) bf16x8*)(KB + kb * 8192 + kro + (((2 * ks + hi) ^ ksw) << 4)); acc[kb] = __builtin_amdgcn_mfma_f32_32x32x16_bf16(ak, bq[ks], acc[kb], 0, 0, 0); } }
                    asm volatile("" : "+v"(acc[0]), "+v"(acc[1]), "+v"(acc[2]), "+v"(acc[3]));
                    ATT_BAR();
                    if (hh * 2 + p + 1 < 8) { KEYS_ISSUE(hh * 2 + p + 1);
                        const bf16* qp = PQ + tok * PQW + (4 * (w >> 2)) * 256 + (hh * 2 + p + 1) * 128 + hi * 8;
#pragma unroll
                        for (int ks = 0; ks < 8; ++ks) bq[ks] = *(const bf16x8*)(qp + ks * 16); }
                    float t[16];
#pragma unroll
                    for (int kb = 0; kb < 4; ++kb) { float c[16];
#pragma unroll
                        for (int r = 0; r < 16; ++r) c[r] = __uint_as_float((__float_as_uint(acc[kb][r]) & ~127u) | (unsigned)(kb * 32 + (r & 3) + 8 * (r >> 2)));
                        sort16_desc(c);
                        if (kb == 0) {
#pragma unroll
                            for (int r = 0; r < 16; ++r) t[r] = c[r];
                        } else merge16(t, c); }
                    float a[16], b[16];
#pragma unroll
                    for (int i = 0; i < 16; ++i) { auto rr = __builtin_amdgcn_permlane32_swap(__float_as_uint(t[i]), __float_as_uint(t[i]), false, false); a[i] = __uint_as_float(rr[0]); b[i] = __uint_as_float(rr[1] | 4u); }
                    merge16(a, b);
#pragma unroll
                    for (int i = 0; i < 16; ++i) { if (p == 0) L0[i] = a[i]; else L1[i] = a[i]; }
                }
#pragma unroll
                for (int q = 0; q < 4; ++q) {
                    ((LAS unsigned*)scr)[q] = (__float_as_uint(L0[4 * q]) & 127u) | ((__float_as_uint(L0[4 * q + 1]) & 127u) << 8) | ((__float_as_uint(L0[4 * q + 2]) & 127u) << 16) | ((__float_as_uint(L0[4 * q + 3]) & 127u) << 24);
                    ((LAS unsigned*)scr)[4 + q] = (__float_as_uint(L1[4 * q]) & 127u) | ((__float_as_uint(L1[4 * q + 1]) & 127u) << 8) | ((__float_as_uint(L1[4 * q + 2]) & 127u) << 16) | ((__float_as_uint(L1[4 * q + 3]) & 127u) << 24);
                }
                float sel[16];
#pragma unroll
                for (int ch = 0; ch < 4; ++ch) { float c[16];
#pragma unroll
                    for (int q = 0; q < 16; ++q) { constexpr int dummy = 0; const int code = kCand.inv[ch * 16 + q];
                        c[q] = code >= 0 ? __uint_as_float((__float_as_uint(L0[code >= 0 ? (code >> 4) : 0] + L1[code >= 0 ? (code & 15) : 0]) & ~255u) | (unsigned)(code >= 0 ? code : 0)) : -INFINITY; }
                    sort16_desc(c);
                    if (ch == 0) {
#pragma unroll
                        for (int q = 0; q < 16; ++q) sel[q] = c[q];
                    } else merge16(sel, c); }
                asm volatile("s_waitcnt lgkmcnt(0)" ::: "memory");
                float ev[16]; unsigned eid[16]; float esum = 0.f;
                const float s0 = __uint_as_float(__float_as_uint(sel[0]) & ~255u);
#pragma unroll
                for (int k = 0; k < 16; ++k) { const unsigned bits = __float_as_uint(sel[k]); const unsigned code = bits & 255u;
                    const unsigned i1 = scr[code >> 4], i2 = scr[16 + (code & 15u)];
                    eid[k] = i1 * 128u + i2; ev[k] = __expf(__uint_as_float(bits & ~255u) - s0); esum += ev[k]; }
                const float rinv = 1.0f / esum;
                asm volatile("s_waitcnt lgkmcnt(0)" ::: "memory");
#pragma unroll
                for (int k = 0; k < 8; ++k) { const unsigned idv = hi ? eid[k + 8] : eid[k]; const float gv = (hi ? ev[k + 8] : ev[k]) * rinv;
                    ids[tokl * 128 + h * 16 + 8 * hi + k] = idv | (cvtpk(0.f, gv) & 0xffff0000u); }
            }
            }
#undef KEYS_ISSUE
        }
        __syncthreads();
        {
        const Frame F2 = make_frame(); const int lane = F2.lane, w = F2.wave, bl = lane & 31, hf = lane >> 5;
        typedef __bf16 bf2 __attribute__((ext_vector_type(2))); typedef float f32x2_t __attribute__((ext_vector_type(2)));
        {   LAS unsigned* lst = ids + w * 2048; unsigned ent[16][2];
#pragma unroll
            for (int t = 0; t < 16; ++t) { ent[t][0] = lst[t * 128 + lane]; ent[t][1] = lst[t * 128 + 64 + lane]; }
            asm volatile("s_waitcnt lgkmcnt(0)" ::: "memory");
#pragma unroll
            for (int t = 0; t < 16; ++t) {
                LAS unsigned* L = lst + t * 128; const unsigned q0 = ent[t][0], q1 = ent[t][1]; const int r0 = (int)((q0 >> 10) & 15u), r1 = (int)((q1 >> 10) & 15u);
                int base = 0;
                for (int r = 0; r < 16; ++r) {
                    const unsigned long long m0 = __ballot(r0 == r), m1 = __ballot(r1 == r); const int c0 = __popcll(m0);
                    if (r0 == r) L[base + __builtin_amdgcn_mbcnt_hi((unsigned)(m0 >> 32), __builtin_amdgcn_mbcnt_lo((unsigned)m0, 0))] = q0;
                    if (r1 == r) L[base + c0 + __builtin_amdgcn_mbcnt_hi((unsigned)(m1 >> 32), __builtin_amdgcn_mbcnt_lo((unsigned)m1, 0))] = q1;
                    base += c0 + __popcll(m1);
                }
            }
            asm volatile("s_waitcnt lgkmcnt(0)" ::: "memory");
        }
        const __amdgpu_buffer_rsrc_t rsu = __builtin_amdgcn_make_buffer_rsrc((void*)U6, 0, NEXP * PROW, 0x00020000), rsv = __builtin_amdgcn_make_buffer_rsrc((void*)V6, 0, NEXP * PROW, 0x00020000);
        {
            const int ci = lane & 15, cg = lane >> 4;
            const unsigned xq8 = (unsigned)(uintptr_t)(F2.lds + RING_OFF + 65536 + w * 8192);
            const bool wr = ((ci & 7) == 0) && ((cg >> 1) == (ci >> 3));
            typedef int v8i_t __attribute__((ext_vector_type(8))); typedef unsigned v2u_t __attribute__((ext_vector_type(2)));
            for (int h = 0; h < 2; ++h) {
                int eb_v = 127;
                for (int p = 0; p < 4; ++p) {
                    const int tokl = 16 * w + 8 * h + 2 * p + hf; const size_t tok = (size_t)tile * 128 + tokl;
                    const bf16* xrow = WSP(bf16, WS_XB) + tok * DM + 32 * bl;
            {   v4u xw[4]; float ssq = 0.f; f32x4 x[8];
#pragma unroll
                for (int j = 0; j < 4; ++j) xw[j] = ((const v4u*)xrow)[j];
#pragma unroll
                for (int j = 0; j < 4; ++j) { const unsigned a_ = xw[j].x, b_ = xw[j].y, c_ = xw[j].z, d_ = xw[j].w;
                    x[2 * j] = (f32x4){__uint_as_float(a_ << 16), __uint_as_float(a_ & 0xffff0000u), __uint_as_float(b_ << 16), __uint_as_float(b_ & 0xffff0000u)};
                    x[2 * j + 1] = (f32x4){__uint_as_float(c_ << 16), __uint_as_float(c_ & 0xffff0000u), __uint_as_float(d_ << 16), __uint_as_float(d_ & 0xffff0000u)}; }
#pragma unroll
                for (int j = 0; j < 8; ++j) ssq += (x[j][0] * x[j][0] + x[j][1] * x[j][1]) + (x[j][2] * x[j][2] + x[j][3] * x[j][3]);
                const float rstd = 1.0f / sqrtf(half32_sum(ssq) * (1.f / DM) + EPS);
                float am = 0.f;
#pragma unroll
                for (int j = 0; j < 8; ++j) { const f32x4 gg = ((const f32x4*)(gf + 32 * bl))[j]; x[j] = x[j] * rstd * gg;
                    am = __builtin_fmaxf(am, __builtin_fmaxf(__builtin_fmaxf(__builtin_fabsf(x[j][0]), __builtin_fabsf(x[j][1])), __builtin_fmaxf(__builtin_fabsf(x[j][2]), __builtin_fabsf(x[j][3])))); }
                am = __builtin_fmaxf(half32_max(am), 1e-30f);
                auto rr = __builtin_amdgcn_permlane32_swap(__float_as_uint(am), __float_as_uint(am), false, false);
                const int ebA = (int)(rr[0] >> 23), ebB = (int)(rr[1] >> 23), ebO = hf ? ebB : ebA;
                const float mult = __uint_as_float((unsigned)(261 - ebO) << 23);
                if (lane == 2 * p) eb_v = ebA; if (lane == 2 * p + 1) eb_v = ebB;
                unsigned q8[8];
#pragma unroll
                for (int j = 0; j < 8; ++j) { int p_ = __builtin_amdgcn_cvt_pk_fp8_f32(x[j][0] * mult, x[j][1] * mult, 0, false); p_ = __builtin_amdgcn_cvt_pk_fp8_f32(x[j][2] * mult, x[j][3] * mult, p_, true); q8[j] = (unsigned)p_; }
                { const unsigned xo_ = xq8 + (2 * p + hf) * 1024 + bl * 32; *(LAS v4u*)(uintptr_t)xo_ = (v4u){q8[0], q8[1], q8[2], q8[3]}; *(LAS v4u*)(uintptr_t)(xo_ + 16) = (v4u){q8[4], q8[5], q8[6], q8[7]}; }
                asm volatile("s_waitcnt lgkmcnt(0)" ::: "memory");
            }
                }
                asm volatile("s_waitcnt lgkmcnt(0)" ::: "memory");
                v4u a0, a1, a2, a3, a4, a5, a6, a7, b0, b1, b2, b3, b4, b5, b6, b7, c0, c1, c2, c3, c4, c5, c6, c7; v2u_t sa, sb, sc;
#define U_REQ(B0, B1, B2, B3, B4, B5, B6, B7, S, k_) do { const int G_ = (k_) >> 2, p_ = (k_) & 3; \
                    const unsigned e_ = ids[(16 * w + 8 * h + 2 * p_ + (ci >> 3)) * 128 + 8 * G_ + (ci & 7)] & 0x3fffu; const int uo_ = (int)(e_ * (unsigned)PROW) + 16 * cg; \
                    B0 = __builtin_bit_cast(v4u, __builtin_amdgcn_raw_buffer_load_b128(rsu, uo_, 0, 0)); B1 = __builtin_bit_cast(v4u, __builtin_amdgcn_raw_buffer_load_b128(rsu, uo_ + 64, 0, 0)); \
                    B2 = __builtin_bit_cast(v4u, __builtin_amdgcn_raw_buffer_load_b128(rsu, uo_ + 128, 0, 0)); B3 = __builtin_bit_cast(v4u, __builtin_amdgcn_raw_buffer_load_b128(rsu, uo_ + 192, 0, 0)); \
                    B4 = __builtin_bit_cast(v4u, __builtin_amdgcn_raw_buffer_load_b128(rsu, uo_ + 256, 0, 0)); B5 = __builtin_bit_cast(v4u, __builtin_amdgcn_raw_buffer_load_b128(rsu, uo_ + 320, 0, 0)); \
                    B6 = __builtin_bit_cast(v4u, __builtin_amdgcn_raw_buffer_load_b128(rsu, uo_ + 384, 0, 0)); B7 = __builtin_bit_cast(v4u, __builtin_amdgcn_raw_buffer_load_b128(rsu, uo_ + 448, 0, 0)); \
                    S = __builtin_bit_cast(v2u_t, __builtin_amdgcn_raw_buffer_load_b64(rsu, uo_ + 512 - 8 * cg, 0, 0)); } while (0)
#define MF1(UB, S, j_) do { const v4u x0_ = *(const LAS v4u*)(uintptr_t)(xrd_ + 128 * (j_)), x1_ = *(const LAS v4u*)(uintptr_t)(xrd_ + 128 * (j_) + 64);     \
                    const v8i_t a_ = {(int)UB.x, (int)UB.y, (int)UB.z, (int)UB.w, 0, 0, 0, 0}, b_ = {(int)x0_.x, (int)x0_.y, (int)x0_.z, (int)x0_.w, (int)x1_.x, (int)x1_.y, (int)x1_.z, (int)x1_.w}; \
                    D_ = __builtin_amdgcn_mfma_scale_f32_16x16x128_f8f6f4(a_, b_, D_, 4, 0, (j_) & 3, (int)S[(j_) >> 2], 0, sbx_); } while (0)
#define STEP(C0, C1, C2, C3, C4, C5, C6, C7, SC_, N0, N1, N2, N3, N4, N5, N6, N7, SN_, k_) do { \
                    { const int k2_ = (k_) + 2 < 64 ? (k_) + 2 : 63; U_REQ(N0, N1, N2, N3, N4, N5, N6, N7, SN_, k2_); } \
                    const int G_ = (k_) >> 2, p_ = (k_) & 3; const int ebA_ = __builtin_amdgcn_readlane(eb_v, 2 * p_), ebB_ = __builtin_amdgcn_readlane(eb_v, 2 * p_ + 1); \
                    const int sbx_ = ((ci >> 3) ? ebB_ : ebA_) - 7; const unsigned xrd_ = xq8 + (2 * p_ + (ci >> 3)) * 1024 + cg * 16; \
                    f32x4 D_ = {0.f, 0.f, 0.f, 0.f}; \
                    MF1(C0, SC_, 0); MF1(C1, SC_, 1); MF1(C2, SC_, 2); MF1(C3, SC_, 3); MF1(C4, SC_, 4); MF1(C5, SC_, 5); MF1(C6, SC_, 6); MF1(C7, SC_, 7); \
                    { float d0_ = D_[0], d1_ = D_[1], d2_ = D_[2], d3_ = D_[3]; asm volatile("" : "+v"(d0_), "+v"(d1_), "+v"(d2_), "+v"(d3_)); D_ = (f32x4){d0_, d1_, d2_, d3_}; }     \
                    LAS unsigned* idc_ = ids + (16 * w + 8 * h + 2 * p_ + hf) * 128 + 8 * G_ + 4 * (cg & 1);       \
                    const v4u q_ = *(const LAS v4u*)idc_; pg8::f32x2 t0_ = {D_[0], D_[1]}, t1_ = {D_[2], D_[3]}; t0_ = pg8::gelu_pk(t0_); t1_ = pg8::gelu_pk(t1_); \
                    const v4u n_ = {(q_.x & 0xffffu) | (cvtpk(0.f, __uint_as_float(q_.x & 0xffff0000u) * t0_.x) & 0xffff0000u), (q_.y & 0xffffu) | (cvtpk(0.f, __uint_as_float(q_.y & 0xffff0000u) * t0_.y) & 0xffff0000u), \
                                    (q_.z & 0xffffu) | (cvtpk(0.f, __uint_as_float(q_.z & 0xffff0000u) * t1_.x) & 0xffff0000u), (q_.w & 0xffffu) | (cvtpk(0.f, __uint_as_float(q_.w & 0xffff0000u) * t1_.y) & 0xffff0000u)}; \
                    if (wr) *(LAS v4u*)idc_ = n_; } while (0)
                U_REQ(a0, a1, a2, a3, a4, a5, a6, a7, sa, 0); U_REQ(b0, b1, b2, b3, b4, b5, b6, b7, sb, 1);
#pragma nounroll
                for (int k = 0; k < 64; k += 3) {
                    STEP(a0, a1, a2, a3, a4, a5, a6, a7, sa, c0, c1, c2, c3, c4, c5, c6, c7, sc, k);
                    if (k + 1 >= 64) break;
                    STEP(b0, b1, b2, b3, b4, b5, b6, b7, sb, a0, a1, a2, a3, a4, a5, a6, a7, sa, k + 1);
                    STEP(c0, c1, c2, c3, c4, c5, c6, c7, sc, b0, b1, b2, b3, b4, b5, b6, b7, sb, k + 2);
                }
#undef STEP
#undef MF1
#undef U_REQ
                asm volatile("s_waitcnt lgkmcnt(0)" ::: "memory");
            }
        }

        v4u vb0, vb1, vb2, vb3, vb4, vb5, vb6, vb7; unsigned vs0, vs1, vs2, vs3, vs4, vs5, vs6, vs7;
#define V_LD(VB, VS, ent) do { const unsigned e_ = (ent) & 0x3fffu; const int ro_ = (int)(e_ * (unsigned)PROW) + 16 * bl; \
                VB = __builtin_bit_cast(v4u, __builtin_amdgcn_raw_buffer_load_b128(rsv, ro_, 0, 0)); VS = (unsigned)__builtin_amdgcn_raw_buffer_load_b8(rsv, ro_ + 512 - 15 * bl, 0, 0); } while (0)
#define V_FMA(VB, VS, ent) do { const float c_ = __uint_as_float((ent) & 0xffff0000u), sv_ = __uint_as_float(VS << 23); \
                _Pragma("unroll") for (int k_ = 0; k_ < 4; ++k_) { const unsigned vw_ = VB[k_]; \
                    { const f32x2_t f_ = __builtin_amdgcn_cvt_scalef32_pk_f32_fp4(vw_, sv_, 0); acc[8 * k_] += c_ * f_.x; acc[8 * k_ + 1] += c_ * f_.y; } \
                    { const f32x2_t f_ = __builtin_amdgcn_cvt_scalef32_pk_f32_fp4(vw_, sv_, 1); acc[8 * k_ + 2] += c_ * f_.x; acc[8 * k_ + 3] += c_ * f_.y; } \
                    { const f32x2_t f_ = __builtin_amdgcn_cvt_scalef32_pk_f32_fp4(vw_, sv_, 2); acc[8 * k_ + 4] += c_ * f_.x; acc[8 * k_ + 5] += c_ * f_.y; } \
                    { const f32x2_t f_ = __builtin_amdgcn_cvt_scalef32_pk_f32_fp4(vw_, sv_, 3); acc[8 * k_ + 6] += c_ * f_.x; acc[8 * k_ + 7] += c_ * f_.y; } } } while (0)
        { const LAS unsigned* id0 = ids + (16 * w + hf) * 128; const v4u e4_ = *(const LAS v4u*)id0, e5_ = *(const LAS v4u*)(id0 + 4);
          V_LD(vb0, vs0, e4_.x); V_LD(vb1, vs1, e4_.y); V_LD(vb2, vs2, e4_.z); V_LD(vb3, vs3, e4_.w); V_LD(vb4, vs4, e5_.x); V_LD(vb5, vs5, e5_.y); V_LD(vb6, vs6, e5_.z); V_LD(vb7, vs7, e5_.w); }
        for (int pp = 0; pp < 8; ++pp) {
            const int tokl = 16 * w + 2 * pp + hf; const size_t tok = (size_t)tile * 128 + tokl;
            bf16* xrow = WSP(bf16, WS_XB) + tok * DM + 32 * bl;
            v4u xo[4];
#pragma unroll
            for (int j = 0; j < 4; ++j) xo[j] = ((const v4u*)xrow)[j];
            float acc[32];
#pragma unroll
            for (int i = 0; i < 32; ++i) acc[i] = 0.f;
            const LAS unsigned* idp = ids + tokl * 128;
            const LAS unsigned* idx = ids + (tokl + (pp < 7 ? 2 : 0)) * 128;
#pragma nounroll
            for (int G = 0; G < 16; ++G) {
                const LAS unsigned* idn = G < 15 ? idp + 8 * (G + 1) : idx;
                const v4u ca = *(const LAS v4u*)(idp + 8 * G), cb = *(const LAS v4u*)(idp + 8 * G + 4), na = *(const LAS v4u*)idn, nb = *(const LAS v4u*)(idn + 4);
#define OPAQUE_ONE(x) int x; asm volatile("s_mov_b32 %0, 1" : "=s"(x))
                { OPAQUE_ONE(t_); if (t_) { V_FMA(vb0, vs0, ca.x); } V_LD(vb0, vs0, na.x); }
                { OPAQUE_ONE(t_); if (t_) { V_FMA(vb1, vs1, ca.y); } V_LD(vb1, vs1, na.y); }
                { OPAQUE_ONE(t_); if (t_) { V_FMA(vb2, vs2, ca.z); } V_LD(vb2, vs2, na.z); }
                { OPAQUE_ONE(t_); if (t_) { V_FMA(vb3, vs3, ca.w); } V_LD(vb3, vs3, na.w); }
                { OPAQUE_ONE(t_); if (t_) { V_FMA(vb4, vs4, cb.x); } V_LD(vb4, vs4, nb.x); }
                { OPAQUE_ONE(t_); if (t_) { V_FMA(vb5, vs5, cb.y); } V_LD(vb5, vs5, nb.y); }
                { OPAQUE_ONE(t_); if (t_) { V_FMA(vb6, vs6, cb.z); } V_LD(vb6, vs6, nb.z); }
                { OPAQUE_ONE(t_); if (t_) { V_FMA(vb7, vs7, cb.w); } V_LD(vb7, vs7, nb.w); }
#undef OPAQUE_ONE
            }
            f32x4 y[8]; float s2_ = 0.f;
            {
#pragma unroll
              for (int j = 0; j < 4; ++j) { const unsigned a_ = xo[j].x, b_ = xo[j].y, c_ = xo[j].z, d_ = xo[j].w;
                y[2 * j] = (f32x4){__uint_as_float(a_ << 16) + acc[8 * j], __uint_as_float(a_ & 0xffff0000u) + acc[8 * j + 1], __uint_as_float(b_ << 16) + acc[8 * j + 2], __uint_as_float(b_ & 0xffff0000u) + acc[8 * j + 3]};
                y[2 * j + 1] = (f32x4){__uint_as_float(c_ << 16) + acc[8 * j + 4], __uint_as_float(c_ & 0xffff0000u) + acc[8 * j + 5], __uint_as_float(d_ << 16) + acc[8 * j + 6], __uint_as_float(d_ & 0xffff0000u) + acc[8 * j + 7]}; }
#pragma unroll
              for (int j = 0; j < 8; ++j) s2_ += (y[j][0] * y[j][0] + y[j][1] * y[j][1]) + (y[j][2] * y[j][2] + y[j][3] * y[j][3]); }
            const float r2 = 1.0f / sqrtf(half32_sum(s2_) * (1.f / DM) + EPS);
            const int eo = 32 * bl;
            if (l < 3) {
#pragma unroll
                for (int j = 0; j < 4; ++j) ((v4u*)xrow)[j] = (v4u){cvtpk(y[2 * j][0], y[2 * j][1]), cvtpk(y[2 * j][2], y[2 * j][3]), cvtpk(y[2 * j + 1][0], y[2 * j + 1][1]), cvtpk(y[2 * j + 1][2], y[2 * j + 1][3])};
                { const float* gn = KA_IN(kp_, 2) + (l + 1) * DM + eo; bf16* xn = WSP(bf16, WS_XN) + tok * DM + eo;
#pragma unroll
                  for (int j = 0; j < 4; ++j) { const f32x4 n0 = y[2 * j] * r2 * ((const f32x4*)gn)[2 * j], n1 = y[2 * j + 1] * r2 * ((const f32x4*)gn)[2 * j + 1]; ((v4u*)xn)[j] = (v4u){cvtpk(n0[0], n0[1]), cvtpk(n0[2], n0[3]), cvtpk(n1[0], n1[1]), cvtpk(n1[2], n1[3])}; } }
                if (l == 1) { const float* gs = KA_IN(kp_, 15) + eo; bf16* xs = WSP(bf16, WS_MIX) + tok * DM + eo;
#pragma unroll
                  for (int j = 0; j < 4; ++j) { const f32x4 n0 = y[2 * j] * r2 * ((const f32x4*)gs)[2 * j], n1 = y[2 * j + 1] * r2 * ((const f32x4*)gs)[2 * j + 1]; ((v4u*)xs)[j] = (v4u){cvtpk(n0[0], n0[1]), cvtpk(n0[2], n0[3]), cvtpk(n1[0], n1[1]), cvtpk(n1[2], n1[3])}; } }
            } else {
                const float* gn = KA_IN(kp_, 17) + eo; float* oh = out_ + tok * DM + eo;
#pragma unroll
                for (int j = 0; j < 8; ++j) ((f32x4*)oh)[j] = y[j] * r2 * ((const f32x4*)gn)[j];
            }
        }
#undef V_LD
#undef V_FMA
        }
        __syncthreads();
    }
}

struct Args { const float* in[18]; float* out; unsigned char* ws; int ph_lo, ph_hi; };
__global__ void __launch_bounds__(NWAVES * 64, 2) hyb_fwd(Args args) {
    { Frame F = make_frame();
      for (int u = F.tid; u < 1024 / 4; u += NWAVES * 64) ((LAS unsigned*)(F.lds + LDSCTL_OFF))[u] = 0u; }
    __syncthreads();
    const int lo = args.ph_lo, hi = args.ph_hi;
    if (hi - lo > 1) { Frame F = make_frame(); const auto kp_ = ka_fresh(F); (void)xcd_barrier_post((unsigned*)(KA_WS(kp_) + WS_CTL) + CW_BAR, F.MISC + 8); }
#ifndef PHMASK
#define PHMASK 0xff
#endif

#define PHM(b) ((PHMASK & (b)) != 0)
#define IN(k) (lo <= (k) && (k) < hi)
#define SEAM(k) do { if (IN(k) && IN((k) + 1)) { Frame F = make_frame(); const auto kq_ = ka_fresh(F); XcdBarrier b_; b_.bar = (unsigned*)(KA_WS(kq_) + WS_CTL) + CW_BAR; b_.x = xb_xcc_id(); b_.st = F.MISC + 8; xcd_barrier(b_); if (NREP(512) == 2) xcd_barrier(b_); } } while (0)

    if (PHM(1) && IN(0)) { for (int rep_ = 0; rep_ < NREP(1); ++rep_) { Frame F = make_frame(); p0_prologue(F); } }
    SEAM(0);
    for (int l = 0; l < 4; ++l) {
        const int pb = 1 + 6 * l;
        if (PHM(2) && IN(pb)) {
            const int njobs = (l == 0) ? 5 : (l == 2 ? 2 : 1);
            for (int rep_ = 0; rep_ < NREP(2); ++rep_)
            for (int jb = 0; jb < njobs; ++jb) {
                Frame F = make_frame(); const auto kp_ = ka_fresh(F); unsigned char* const ws_ = KA_WS(kp_);
                pg8::Gemm g; pg8::EpiProj E; int cid = F.bx;
                E.rope = WSP(float, WS_ROPE); E.sc = att::C2; E.hm = 0; E.hs = 0;
                const bool is_skv = (l == 2 && jb == 0), is_proj = (l == 2) ? (jb == 1) : (jb == 0);
                if (is_skv) { g = pg8::Gemm{WSP(pg8::bf16_t, WS_MIX), WSP(pg8::bf16_t, WS_WSKV), TT, SKVW, DM}; E.O = WSP(pg8::bf16_t, WS_SKV); E.ldc = SKVW; E.rope_lim = 9; E.scale_lim = 0; E.scale_tile = -1; }
                else if (is_proj) { g = pg8::Gemm{WSP(pg8::bf16_t, WS_XN), (l < 2 ? WSP(pg8::bf16_t, WS_WA) + (size_t)l * INW * DM : WSP(pg8::bf16_t, WS_WB) + (size_t)(l - 2) * INW * DM), TT, INW, DM};
                    E.O = WSP(pg8::bf16_t, WS_PROJ); E.ldc = INW; E.rope_lim = (l < 2) ? 6 : 9; E.scale_lim = (l < 2) ? 3 : 9; E.scale_tile = 9; }
                else { const int lm = jb - 1; g = pg8::Gemm{WSP(pg8::bf16_t, WS_MEMN) + (size_t)lm * MEMROWS * DM, WSP(pg8::bf16_t, WS_WMKV) + (size_t)lm * MKVW * DM, MEMROWS, MKVW, DM};
                    E.O = WSP(pg8::bf16_t, WS_MEMKV) + (size_t)lm * MEMROWS * MKVW; E.ldc = MKVW; E.rope_lim = 0; E.scale_lim = 0; E.scale_tile = -1; cid = (int)((F.bx + F.G - 16 * lm) % F.G); }
                pg8::StaticOrder S; S.init(g.M, g.N, F.G, cid);
                pg8::gemm_phase<pg8::EpiProj, pg8::StaticOrder, true, true>(F.lds + RING_OFF, g, S, E);
                __syncthreads();
            }
        }
        SEAM(pb);
        if (IN(pb + 1)) {
            Frame F = make_frame(); const auto kp_ = ka_fresh(F); unsigned char* const ws_ = KA_WS(kp_);
            const bf16* PROJ = WSP(bf16, WS_PROJ); bf16* MIX = WSP(bf16, WS_MIX);
            if (PHM(4) && l < 2) {
                for (int rep_ = 0; rep_ < NREP(4); ++rep_) {
                const float li = 0.8f - 0.6f * expf(-0.3f * (float)l);
                const float* lp = KA_IN(kp_, 4) + l * 256;
                const float d01 = wave_sum(lp[F.lane] * lp[64 + F.lane]), d23 = wave_sum(lp[128 + F.lane] * lp[192 + F.lane]);
                const float lam = expf(d01) - expf(d23) + li;
                const float* subg = KA_IN(kp_, 5) + l * 128;
                const int nper = (768 + F.G - 1) / F.G;
                for (int k = 0; k < nper; ++k) {
                    const int P = F.vcu * nper + k; if (P >= 768) break;
                    const int bh = P >> 4, s = P & 15;
                    diff_unit(F, bh / 6, bh % 6, s, PROJ, MIX, lam, 1.0f - li, subg);
                    diff_unit(F, bh / 6, bh % 6, 31 - s, PROJ, MIX, lam, 1.0f - li, subg);
                }
                }
            } else if (PHM(8)) {
                for (int rep2_ = 0; rep2_ < NREP(8); ++rep2_) {
                const bf16* SKV = WSP(bf16, WS_SKV);
                const int nper = (4608 + F.G - 1) / F.G;
                for (int k = 0; k < nper; ++k) {
                    const int U = F.vcu * nper + k; if (U >= 4608) break;
                    const int w16 = U & 15, bh = U >> 4, head = bh % 36, b = bh / 36, g = head / 12;
                    const int d = g == 0 ? 1 : (g == 1 ? 4 : 16), res = g == 0 ? 0 : (g == 1 ? (w16 >> 2) : w16), s = g == 0 ? w16 : (g == 1 ? (w16 & 3) : 0);
                    dil_strip(F, b, head, res, s, d, PROJ, SKV, WSP(bf16, WS_OG), WSP(float, WS_LSEG));
                }
                }
            }
            if (l < 2) { for (int rep3_ = 0; rep3_ < NREP(16); ++rep3_) if (PHM(16)) mem_attn_all(F, PROJ, WSP(bf16, WS_MEMKV) + (size_t)l * MEMROWS * MKVW, MIX); }
            asm volatile("s_waitcnt vmcnt(0) lgkmcnt(0)" ::: "memory"); __syncthreads();
        }
        SEAM(pb + 1);
        if (IN(pb + 2) && l >= 2) {
            Frame F = make_frame(); const auto kp_ = ka_fresh(F); unsigned char* const ws_ = KA_WS(kp_);
            if (PHM(8)) dil_combine_all(F, WSP(bf16, WS_OG), WSP(float, WS_LSEG), WSP(bf16, WS_MIX));
            for (int rep3_ = 0; rep3_ < NREP(16); ++rep3_) if (PHM(16)) mem_attn_all(F, WSP(bf16, WS_PROJ), WSP(bf16, WS_MEMKV) + (size_t)l * MEMROWS * MKVW, WSP(bf16, WS_MIX));
            asm volatile("s_waitcnt vmcnt(0) lgkmcnt(0)" ::: "memory"); __syncthreads();
        }
        if (l >= 2) SEAM(pb + 2);
        if (PHM(32) && IN(pb + 3)) {
            Frame F = make_frame(); const auto kp_ = ka_fresh(F); unsigned char* const ws_ = KA_WS(kp_);
            pg8::Gemm g{WSP(pg8::bf16_t, WS_MIX), WSP(pg8::bf16_t, WS_WOUT) + (size_t)l * DM * DM, TT, DM, DM};
            pg8::EpiRes E{WSP(pg8::bf16_t, WS_XB), WSP(float, WS_SS), DM};
            pg8::StaticOrder S; S.init(TT, DM, F.G, F.bx);
            pg8::gemm_phase<pg8::EpiRes, pg8::StaticOrder, true, true>(F.lds + RING_OFF, g, S, E);
            __syncthreads();
        }
        SEAM(pb + 3);
        if (PHM(64) && IN(pb + 4)) {
            Frame F = make_frame(); const auto kp_ = ka_fresh(F); unsigned char* const ws_ = KA_WS(kp_);
            pg8::Gemm g{WSP(pg8::bf16_t, WS_XB), WSP(pg8::bf16_t, WS_WPQ) + (size_t)l * PQW * DM, TT, PQW, DM};
            pg8::EpiScaleRow E{WSP(pg8::bf16_t, WS_PROJ), PQW, WSP(float, WS_SS), EPS};
            pg8::StaticOrder S; S.init(TT, PQW, F.G, F.bx);
            for (int rep_ = 0; rep_ < NREP(64); ++rep_) {
            pg8::gemm_phase<pg8::EpiScaleRow, pg8::StaticOrder, true, true>(F.lds + RING_OFF, g, S, E);
            __syncthreads(); }
        }
        SEAM(pb + 4);
        if (PHM(128) && IN(pb + 5)) { Frame F = make_frame(); peer_phase(F, l); }
        SEAM(pb + 5);
    }
#undef IN
#undef SEAM
}

#ifndef HYB_N_LAUNCHES
#define HYB_N_LAUNCHES 1
#endif
extern "C" void kernel_launch(void* const* d_in, const int* in_sizes, int n_in, void* d_out, int out_size, void* d_ws, size_t ws_size, hipStream_t stream) {
    static int grid = 0;
    if (grid == 0) {
        if (n_in != 18 || out_size != TT * DM || ws_size < WS_END) { fprintf(stderr, "kernel_launch: unexpected shapes (n_in %d, out %d, ws %zu)\n", n_in, out_size, ws_size); grid = -1; return; }
        int dev = 0, cus = 0, per_cu = 0;
        if (hipGetDevice(&dev) != hipSuccess || hipDeviceGetAttribute(&cus, hipDeviceAttributeMultiprocessorCount, dev) != hipSuccess) { grid = -1; return; }
        if (hipFuncSetAttribute((const void*)hyb_fwd, hipFuncAttributeMaxDynamicSharedMemorySize, LDS_BYTES) != hipSuccess) { fprintf(stderr, "kernel_launch: hipFuncSetAttribute failed\n"); grid = -1; return; }
        if (hipOccupancyMaxActiveBlocksPerMultiprocessor(&per_cu, (const void*)hyb_fwd, NWAVES * 64, LDS_BYTES) != hipSuccess || per_cu < 1) { fprintf(stderr, "kernel_launch: occupancy query says %d\n", per_cu); }
        (void)hipGetLastError();
        grid = cus;
    }
    if (grid < 0) return;
    (void)hipMemsetAsync((char*)d_ws + WS_CTL, 0, CTL_ZERO_BYTES, stream);
    Args a{};
    for (int i = 0; i < 18; ++i) a.in[i] = (const float*)d_in[i];
    a.out = (float*)d_out; a.ws = (unsigned char*)d_ws;
    if (HYB_N_LAUNCHES == 1) { a.ph_lo = 0; a.ph_hi = NPHASE; hipLaunchKernelGGL(hyb_fwd, dim3(grid), dim3(NWAVES * 64), LDS_BYTES, stream, a); }
    else { for (int p = 0; p < NPHASE; ++p) { a.ph_lo = p; a.ph_hi = p + 1; hipLaunchKernelGGL(hyb_fwd, dim3(grid), dim3(NWAVES * 64), LDS_BYTES, stream, a); } }
}
```

```cpp
#include <hip/hip_runtime.h>
#include <cstdio>
#include <cstdint>
#include <cmath>
template <int CTRL> __device__ __forceinline__ float dpp_addc(float v) { return v + __uint_as_float((unsigned)__builtin_amdgcn_update_dpp(0, (int)__float_as_uint(v), CTRL, 0xf, 0xf, true)); }
template <int CTRL> __device__ __forceinline__ float dpp_maxc(float v) { return __builtin_fmaxf(v, __uint_as_float((unsigned)__builtin_amdgcn_update_dpp(0, (int)__float_as_uint(v), CTRL, 0xf, 0xf, true))); }
__device__ __forceinline__ float xor16_sum(float v) { auto r = __builtin_amdgcn_permlane16_swap(__float_as_uint(v), __float_as_uint(v), false, false); return __uint_as_float(r[0]) + __uint_as_float(r[1]); }
__device__ __forceinline__ float xor32_sum(float v) { auto r = __builtin_amdgcn_permlane32_swap(__float_as_uint(v), __float_as_uint(v), false, false); return __uint_as_float(r[0]) + __uint_as_float(r[1]); }
__device__ __forceinline__ float xor16_get(float v, bool odd_row) { auto r = __builtin_amdgcn_permlane16_swap(__float_as_uint(v), __float_as_uint(v), false, false); return __uint_as_float(odd_row ? r[0] : r[1]); }
__device__ __forceinline__ float row16_sum(float v) { v = dpp_addc<0xB1>(v); v = dpp_addc<0x4E>(v); v = dpp_addc<0x141>(v); return dpp_addc<0x140>(v); }
__device__ __forceinline__ float half32_sum(float v) { return xor16_sum(row16_sum(v)); }
__device__ __forceinline__ float wave_sum_valu(float v) { return xor32_sum(half32_sum(v)); }
__device__ __forceinline__ float wave_max_valu(float v) {
    v = dpp_maxc<0xB1>(v); v = dpp_maxc<0x4E>(v); v = dpp_maxc<0x141>(v); v = dpp_maxc<0x140>(v);
    { auto r = __builtin_amdgcn_permlane16_swap(__float_as_uint(v), __float_as_uint(v), false, false); v = __builtin_fmaxf(__uint_as_float(r[0]), __uint_as_float(r[1])); }
    { auto r = __builtin_amdgcn_permlane32_swap(__float_as_uint(v), __float_as_uint(v), false, false); v = __builtin_fmaxf(__uint_as_float(r[0]), __uint_as_float(r[1])); }
    return v;
}
namespace pg8 {
#define PG8_LAS __attribute__((address_space(3)))
typedef unsigned short bf16_t;
typedef short bf16x8 __attribute__((ext_vector_type(8)));
typedef float f32x4 __attribute__((ext_vector_type(4)));
typedef unsigned u32x4 __attribute__((ext_vector_type(4)));
constexpr int BM = 256, BK = 64, HALF = 128, HTB = HALF * BK * 2  , STAGE_BYTES = 8 * HTB, NXCD = 8, WGM = 8;

__host__ __device__ __forceinline__ int lds_byte(int r, int c) { const int st = (r >> 4) * 2 + (c >> 5), rr = r & 15, cc = c & 31, ob = rr * 64 + cc * 2; return st * 1024 + (ob ^ (((ob >> 9) & 1) << 5)); }
__host__ __device__ __forceinline__ void stage_rc(int b, int& R, int& C) { const int st = b / 1024, sb = b % 1024, swz = sb ^ (((sb >> 9) & 1) << 5); R = (st >> 1) * 16 + swz / 64; C = (st & 1) * 32 + (swz % 64) / 2; }
__host__ __device__ __forceinline__ int perm32(int rho) { const int n = rho >> 4, i = rho & 15; return 8 * (i >> 2) + 4 * n + (i & 3); }

struct Unit { int pm, pn; };
struct Gemm { const bf16_t* A; const bf16_t* Bt; int M, N, K; };

struct StaticOrder {
    int nM, nN, nwg, G, c;
    __host__ __device__ void init(int M, int N, int G_, int c_) { nM = M / BM; nN = N / BM; nwg = nM * nN; G = G_; c = c_; }
    __host__ __device__ bool next(int i, Unit& u) const {
        const long L = (long)i * G + c; if (L >= nwg) return false;
        int wgid = (int)L; { const int q = nwg / NXCD, r = nwg % NXCD, xcd = wgid % NXCD, off = wgid / NXCD; wgid = (xcd < r ? xcd * (q + 1) : r * (q + 1) + (xcd - r) * q) + off; }
        const int nig = WGM * nN, gid = wgid / nig, fm = gid * WGM, gsz = (nM - fm) < WGM ? (nM - fm) : WGM;
        u.pm = fm + ((wgid % nig) % gsz); u.pn = (wgid % nig) / gsz; return true;
    }
    __device__ __forceinline__ void a_ready(const Unit&) const {}
    __device__ __forceinline__ void done(const Unit&) const {}
};

__device__ __forceinline__ unsigned cvt_pk_bf16(float lo, float hi) { unsigned r; asm volatile("v_cvt_pk_bf16_f32 %0, %1, %2" : "=v"(r) : "v"(lo), "v"(hi)); return r; }
typedef float f32x2 __attribute__((ext_vector_type(2)));
__device__ __forceinline__ f32x2 gelu_pk(f32x2 v) {
    const f32x2 av = __builtin_elementwise_abs(v), d = av * 0.2316418882f + 1.0f;
    f32x2 t; t.x = __builtin_amdgcn_rcpf(d.x); t.y = __builtin_amdgcn_rcpf(d.y);
    f32x2 q = t * 0.5307027145f + (-0.7265760135f); q = q * t + 0.7107068705f; q = q * t + (-0.142248368f); q = q * t + 0.127414796f; q = q * t;
    const f32x2 s = (v * v) * (-0.72134752044f);
    f32x2 e; e.x = __builtin_amdgcn_exp2f(s.x); e.y = __builtin_amdgcn_exp2f(s.y);
    const f32x2 m = v * (q * e), r = v - m;
    f32x2 o; o.x = v.x < 0.f ? m.x : r.x; o.y = v.y < 0.f ? m.y : r.y; return o;
}


struct EpiProj {
    static constexpr bool PERM = true, AFTER_DRAIN = false;
    bf16_t* O; int ldc; const float* rope; int rope_lim, scale_lim, scale_tile; float sc; int hm; size_t hs;
    __device__ __forceinline__ void operator()(const f32x4 (&acc)[2][2][4][2], const Unit& u, int wr, int wc, int fr, int fq) const {
        const int row0 = u.pm * BM + wr * 64 + fr, col0 = u.pn * BM + wc * 32 + 8 * fq;
        const bool do_rope = (u.pn < rope_lim) && ((wc & 1) == 0);
        const float s = (u.pn < scale_lim || u.pn == scale_tile) ? sc : 1.f;
        const float sg = (fq == 0) ? -1.f : 1.f;
#pragma unroll
        for (int ai = 0; ai < 2; ++ai)
#pragma unroll
            for (int m = 0; m < 4; ++m) {
                const int row = row0 + ai * HALF + m * 16;
                f32x4 c0 = {1.f, 1.f, 1.f, 1.f}, c1 = c0, s0 = {0.f, 0.f, 0.f, 0.f}, s1 = s0;
                if (do_rope) { const f32x4* rp = (const f32x4*)(rope + (size_t)(row & 4095) * 16); c0 = rp[0]; c1 = rp[1]; s0 = rp[2]; s1 = rp[3]; }
                bf16_t* rowp = hm ? O + ((size_t)(row >> 12) * hm + (col0 >> 6)) * hs + (size_t)(row & 4095) * 64 + (col0 & 63) : O + (size_t)row * ldc + col0;
                const size_t bjstep = hm ? 2 * hs : (size_t)HALF;
#pragma unroll
                for (int bj = 0; bj < 2; ++bj) {
                    f32x4 v0 = acc[ai][bj][m][0], v1 = acc[ai][bj][m][1];
                    if (do_rope) {
                        f32x4 p0, p1;
#pragma unroll
                        for (int j = 0; j < 4; ++j) { p0[j] = xor16_get(v0[j], (fq & 1) != 0); p1[j] = xor16_get(v1[j], (fq & 1) != 0); }
                        if (fq < 2) { v0 = v0 * c0 + (p0 * s0) * sg; v1 = v1 * c1 + (p1 * s1) * sg; }
                    }
                    v0 = v0 * s; v1 = v1 * s;
                    u32x4 w; w.x = cvt_pk_bf16(v0[0], v0[1]); w.y = cvt_pk_bf16(v0[2], v0[3]); w.z = cvt_pk_bf16(v1[0], v1[1]); w.w = cvt_pk_bf16(v1[2], v1[3]);
                    *(u32x4*)(rowp + bj * bjstep) = w;
                }
            }
    }
};
struct EpiRes {
    static constexpr bool PERM = true, AFTER_DRAIN = false;
    bf16_t* XR; float* SS; int ldc;
    __device__ __forceinline__ void operator()(const f32x4 (&acc)[2][2][4][2], const Unit& u, int wr, int wc, int fr, int fq) const {
        const int row0 = u.pm * BM + wr * 64 + fr, col0 = u.pn * BM + wc * 32 + 8 * fq;
#pragma unroll
        for (int ai = 0; ai < 2; ++ai)
#pragma unroll
            for (int m = 0; m < 4; ++m) {
                const int row = row0 + ai * HALF + m * 16;
                float q = 0.f;
#pragma unroll
                for (int bj = 0; bj < 2; ++bj) {
                    bf16_t* xp = XR + (size_t)row * ldc + col0 + bj * HALF;
                    const u32x4 xw = *(const u32x4*)xp;
                    f32x4 x0 = {__uint_as_float(xw.x << 16), __uint_as_float(xw.x & 0xffff0000u), __uint_as_float(xw.y << 16), __uint_as_float(xw.y & 0xffff0000u)};
                    f32x4 x1 = {__uint_as_float(xw.z << 16), __uint_as_float(xw.z & 0xffff0000u), __uint_as_float(xw.w << 16), __uint_as_float(xw.w & 0xffff0000u)};
                    x0 = x0 + acc[ai][bj][m][0]; x1 = x1 + acc[ai][bj][m][1];
                    u32x4 w; w.x = cvt_pk_bf16(x0[0], x0[1]); w.y = cvt_pk_bf16(x0[2], x0[3]); w.z = cvt_pk_bf16(x1[0], x1[1]); w.w = cvt_pk_bf16(x1[2], x1[3]);
                    *(u32x4*)xp = w;
                    q += (x0[0] * x0[0] + x0[1] * x0[1]) + (x0[2] * x0[2] + x0[3] * x0[3]) + (x1[0] * x1[0] + x1[1] * x1[1]) + (x1[2] * x1[2] + x1[3] * x1[3]);
                }
                q = xor32_sum(xor16_sum(q));
                if (fq == 0) SS[(size_t)row * 16 + u.pn * 4 + wc] = q;
            }
    }
};
struct EpiScaleRow {
    static constexpr bool PERM = true, AFTER_DRAIN = false;
    bf16_t* O; int ldc; const float* SS; float eps;
    __device__ __forceinline__ void operator()(const f32x4 (&acc)[2][2][4][2], const Unit& u, int wr, int wc, int fr, int fq) const {
        const int row0 = u.pm * BM + wr * 64 + fr, col0 = u.pn * BM + wc * 32 + 8 * fq;
#pragma unroll
        for (int ai = 0; ai < 2; ++ai)
#pragma unroll
            for (int m = 0; m < 4; ++m) {
                const int row = row0 + ai * HALF + m * 16;
                const f32x4* sp = (const f32x4*)(SS + (size_t)row * 16);
                const f32x4 a = sp[0], b = sp[1], c = sp[2], d = sp[3];
                const float tot = (((a[0] + a[1]) + (a[2] + a[3])) + ((b[0] + b[1]) + (b[2] + b[3]))) + (((c[0] + c[1]) + (c[2] + c[3])) + ((d[0] + d[1]) + (d[2] + d[3])));
                const float rs = 1.0f / sqrtf(tot * (1.0f / 1024.0f) + eps);
                bf16_t* rowp = O + (size_t)row * ldc + col0;
#pragma unroll
                for (int bj = 0; bj < 2; ++bj) {
                    const f32x4 v0 = acc[ai][bj][m][0] * rs, v1 = acc[ai][bj][m][1] * rs;
                    u32x4 w; w.x = cvt_pk_bf16(v0[0], v0[1]); w.y = cvt_pk_bf16(v0[2], v0[3]); w.z = cvt_pk_bf16(v1[0], v1[1]); w.w = cvt_pk_bf16(v1[2], v1[3]);
                    *(u32x4*)(rowp + bj * HALF) = w;
                }
            }
    }
};

template <class Epi, class Sched, bool ALIGN_EPI = false, bool SP2 = false>
__device__ __forceinline__ void gemm_phase(PG8_LAS unsigned char* lds, const Gemm g, const Sched& S, const Epi& E) {
    int tid_ = threadIdx.x; asm volatile("" : "+v"(tid_));
    const int tid = tid_, wid = __builtin_amdgcn_readfirstlane(tid >> 6), lane = tid & 63, wr = wid >> 2, wc = wid & 3, fr = lane & 15, fq = lane >> 4;
    const int K = g.K, nt = K / BK;
    unsigned voffA[2], voffB[2];
#pragma unroll
    for (int i = 0; i < 2; ++i) { int R, C; stage_rc(tid * 16 + i * 8192, R, C); const int Rb = Epi::PERM ? ((R & ~31) + perm32(R & 31)) : R;
        voffA[i] = (unsigned)(R * K + C) * 2u; voffB[i] = (unsigned)(Rb * K + C) * 2u; }
    const size_t kstep = (size_t)(BK * 2);
    const size_t hstep = (size_t)HALF * K * 2;
    const size_t tstep = 2 * hstep;
    const unsigned ldsw = (unsigned)wid * 1024u;
    const int aoff = lds_byte(wr * 64 + fr, fq * 8), boff = lds_byte(wc * 32 + fr, fq * 8);
#define PG8_SA(b, h) (((b) * 2 + (h)) * HTB)
#define PG8_SB(b, h) ((4 + (b) * 2 + (h)) * HTB)
#define PG8_STAGE(bufoff, gbase, voff) do { _Pragma("unroll") for (int _i = 0; _i < 2; ++_i) \
        __builtin_amdgcn_global_load_lds((const unsigned*)((const char*)(gbase) + (voff)[_i]), (PG8_LAS unsigned*)(lds + (bufoff) + ldsw + _i * 8192), 16, 0, 0); } while (0)
#define PG8_LDA(dst, b, h) do { _Pragma("unroll") for (int m = 0; m < 4; ++m) _Pragma("unroll") for (int k = 0; k < 2; ++k) dst[m][k] = *(const PG8_LAS bf16x8*)(lds + PG8_SA(b, h) + aoff + m * 2048 + k * 1024); } while (0)
#define PG8_LDB(dst, b, h) do { _Pragma("unroll") for (int n = 0; n < 2; ++n) _Pragma("unroll") for (int k = 0; k < 2; ++k) dst[n][k] = *(const PG8_LAS bf16x8*)(lds + PG8_SB(b, h) + boff + n * 2048 + k * 1024); } while (0)
#define PG8_MMA(ai, bj, At, Bt) do { __builtin_amdgcn_s_setprio(1); _Pragma("unroll") for (int m = 0; m < 4; ++m) _Pragma("unroll") for (int n = 0; n < 2; ++n) _Pragma("unroll") for (int k = 0; k < 2; ++k) \
        acc[ai][bj][m][n] = __builtin_amdgcn_mfma_f32_16x16x32_bf16(Bt[n][k], At[m][k], acc[ai][bj][m][n], 0, 0, 0); __builtin_amdgcn_s_setprio(0); } while (0)
#define PG8_WAIT_V(n) asm volatile("s_waitcnt vmcnt(" #n ")" ::: "memory")
#define PG8_WAIT_L(n) asm volatile("s_waitcnt lgkmcnt(" #n ")" ::: "memory")
#define PG8_BAR __builtin_amdgcn_s_barrier()
#define PG8_SCHED __builtin_amdgcn_sched_barrier(0)
    Unit cur, nxt; int ui = 0;
    if (!S.next(0, cur)) return;
    f32x4 acc[2][2][4][2];
#pragma unroll
    for (int a = 0; a < 2; ++a)
#pragma unroll
        for (int b = 0; b < 2; ++b)
#pragma unroll
            for (int m = 0; m < 4; ++m)
#pragma unroll
                for (int n = 0; n < 2; ++n) acc[a][b][m][n] = (f32x4){0.f, 0.f, 0.f, 0.f};
    bf16x8 At[4][2], B0[2][2], B1[2][2];
    const char* cA = (const char*)g.A + (size_t)cur.pm * tstep; const char* cB = (const char*)g.Bt + (size_t)cur.pn * tstep;
    S.a_ready(cur);
    if constexpr (SP2) {
        PG8_STAGE(PG8_SB(0, 0), cB, voffB); PG8_STAGE(PG8_SB(0, 1), cB + hstep, voffB); PG8_STAGE(PG8_SA(0, 0), cA, voffA); PG8_STAGE(PG8_SA(0, 1), cA + hstep, voffA);
        if (wr == 1) PG8_BAR;
        PG8_WAIT_V(2); PG8_BAR;
        PG8_STAGE(PG8_SB(1, 0), cB + kstep, voffB); PG8_STAGE(PG8_SA(1, 0), cA + kstep, voffA); PG8_STAGE(PG8_SB(1, 1), cB + hstep + kstep, voffB);
        PG8_WAIT_V(6); PG8_BAR;
    } else {
        PG8_STAGE(PG8_SB(0, 0), cB, voffB); PG8_STAGE(PG8_SA(0, 0), cA, voffA); PG8_STAGE(PG8_SB(0, 1), cB + hstep, voffB); PG8_STAGE(PG8_SA(0, 1), cA + hstep, voffA);
        if (wr == 1) PG8_BAR;
        PG8_WAIT_V(4); PG8_BAR;
        PG8_STAGE(PG8_SB(1, 0), cB + kstep, voffB); PG8_STAGE(PG8_SA(1, 0), cA + kstep, voffA); PG8_STAGE(PG8_SB(1, 1), cB + hstep + kstep, voffB);
        PG8_WAIT_V(6); PG8_BAR;
    }
    for (;;) {
        const bool has_next = S.next(ui + 1, nxt);
        const char* nA = has_next ? (const char*)g.A + (size_t)nxt.pm * tstep : cA; const char* nB = has_next ? (const char*)g.Bt + (size_t)nxt.pn * tstep : cB;
        for (int t = 0; t < nt; t += 2) {
            const bool last = (t == nt - 2);
            const char* a1 = cA + (size_t)(t + 1) * kstep;
            const char* a2 = last ? nA : cA + (size_t)(t + 2) * kstep; const char* b2 = last ? nB : cB + (size_t)(t + 2) * kstep;
            const char* a3 = a2 + kstep; const char* b3 = b2 + kstep;
            if (last && has_next) S.a_ready(nxt);
            if constexpr (SP2) {
            PG8_LDB(B0, 0, 0); PG8_LDB(B1, 0, 1); PG8_SCHED; PG8_LDA(At, 0, 0); PG8_STAGE(PG8_SA(1, 1), a1 + hstep, voffA);
            PG8_WAIT_V(8); PG8_WAIT_L(0); PG8_BAR; PG8_MMA(0, 0, At, B0); PG8_MMA(0, 1, At, B1); PG8_BAR; PG8_SCHED;
            PG8_LDA(At, 0, 1); PG8_STAGE(PG8_SB(0, 0), b2, voffB); PG8_STAGE(PG8_SB(0, 1), b2 + hstep, voffB); PG8_STAGE(PG8_SA(0, 0), a2, voffA);
            PG8_WAIT_V(8); PG8_WAIT_L(0); PG8_BAR; PG8_MMA(1, 0, At, B0); PG8_MMA(1, 1, At, B1); PG8_BAR; PG8_SCHED;
            PG8_LDB(B0, 1, 0); PG8_LDB(B1, 1, 1); PG8_SCHED; PG8_LDA(At, 1, 0); PG8_STAGE(PG8_SA(0, 1), a2 + hstep, voffA);
            PG8_WAIT_V(8); PG8_WAIT_L(0); PG8_BAR; PG8_MMA(0, 0, At, B0); PG8_MMA(0, 1, At, B1); PG8_BAR; PG8_SCHED;
            PG8_LDA(At, 1, 1); PG8_STAGE(PG8_SB(1, 0), b3, voffB); PG8_STAGE(PG8_SB(1, 1), b3 + hstep, voffB); PG8_STAGE(PG8_SA(1, 0), a3, voffA);
            PG8_WAIT_V(8); PG8_WAIT_L(0); PG8_BAR; PG8_MMA(1, 0, At, B0); PG8_MMA(1, 1, At, B1); PG8_BAR; PG8_SCHED;
            } else {
            PG8_LDB(B0, 0, 0); PG8_SCHED; PG8_LDA(At, 0, 0); PG8_STAGE(PG8_SA(1, 1), a1 + hstep, voffA);
            PG8_WAIT_L(8); PG8_BAR; PG8_WAIT_L(0); PG8_MMA(0, 0, At, B0); PG8_BAR; PG8_SCHED;
            PG8_LDB(B1, 0, 1); PG8_STAGE(PG8_SB(0, 0), b2, voffB);
            PG8_BAR; PG8_WAIT_L(0); PG8_MMA(0, 1, At, B1); PG8_BAR;
            PG8_LDA(At, 0, 1); PG8_STAGE(PG8_SA(0, 0), a2, voffA);
            PG8_BAR; PG8_WAIT_L(0); PG8_MMA(1, 0, At, B0); PG8_BAR; PG8_SCHED;
            PG8_STAGE(PG8_SB(0, 1), b2 + hstep, voffB);
            PG8_WAIT_V(6); PG8_BAR; PG8_MMA(1, 1, At, B1); PG8_BAR;
            PG8_LDB(B0, 1, 0); PG8_SCHED; PG8_LDA(At, 1, 0); PG8_STAGE(PG8_SA(0, 1), a2 + hstep, voffA);
            PG8_WAIT_L(8); PG8_BAR; PG8_WAIT_L(0); PG8_MMA(0, 0, At, B0); PG8_BAR; PG8_SCHED;
            PG8_LDB(B1, 1, 1); PG8_STAGE(PG8_SB(1, 0), b3, voffB);
            PG8_BAR; PG8_WAIT_L(0); PG8_MMA(0, 1, At, B1); PG8_BAR;
            PG8_LDA(At, 1, 1); PG8_STAGE(PG8_SA(1, 0), a3, voffA);
            PG8_BAR; PG8_WAIT_L(0); PG8_MMA(1, 0, At, B0); PG8_BAR; PG8_SCHED;
            PG8_STAGE(PG8_SB(1, 1), b3 + hstep, voffB);
            PG8_WAIT_V(6); PG8_BAR; PG8_MMA(1, 1, At, B1); PG8_BAR;
            }
        }
        if constexpr (ALIGN_EPI) { if (wr == 0) PG8_BAR; }
        if constexpr (!Epi::AFTER_DRAIN) { E(acc, cur, wr, wc, fr, fq); S.done(cur); }
        if (!has_next) break;
#pragma unroll
        for (int a = 0; a < 2; ++a)
#pragma unroll
            for (int b = 0; b < 2; ++b)
#pragma unroll
                for (int m = 0; m < 4; ++m)
#pragma unroll
                    for (int n = 0; n < 2; ++n) acc[a][b][m][n] = (f32x4){0.f, 0.f, 0.f, 0.f};
        cur = nxt; cA = nA; cB = nB; ++ui;
        if constexpr (ALIGN_EPI) { if (wr == 1) PG8_BAR; }
    }
    PG8_WAIT_V(0);
    if constexpr (!ALIGN_EPI) { if (wr == 0) PG8_BAR; }
    PG8_BAR;
    if constexpr (Epi::AFTER_DRAIN) { E.fused(acc, cur, wr, wc, fr, fq, lds, wid, lane); S.done(cur); }
#undef PG8_SA
#undef PG8_SB
#undef PG8_STAGE
#undef PG8_LDA
#undef PG8_LDB
#undef PG8_MMA
#undef PG8_WAIT_V
#undef PG8_WAIT_L
#undef PG8_BAR
#undef PG8_SCHED
}
}
#define GAS __attribute__((address_space(1)))
#define LAS __attribute__((address_space(3)))
typedef unsigned short bf16;
typedef unsigned v4u __attribute__((ext_vector_type(4)));
typedef float f32x4 __attribute__((ext_vector_type(4)));
typedef short bf16x8 __attribute__((ext_vector_type(8)));
typedef GAS unsigned gu32;
typedef GAS unsigned long long gu64;
#define RLX_AGENT __ATOMIC_RELAXED, __HIP_MEMORY_SCOPE_AGENT
#define LDS_WAIT() asm volatile("s_waitcnt lgkmcnt(0)" ::: "memory")
#define VM_WAIT() asm volatile("s_waitcnt vmcnt(0)" ::: "memory")
__device__ __forceinline__ unsigned long long rt() { return __builtin_amdgcn_s_memrealtime(); }
__device__ __forceinline__ unsigned f2bf(float f) { unsigned u = __builtin_bit_cast(unsigned, f); return (u + 0x7fffu + ((u >> 16) & 1u)) >> 16; }
__device__ __forceinline__ unsigned pk2(float lo, float hi) { return f2bf(lo) | (f2bf(hi) << 16); }

namespace att {
typedef __attribute__((address_space(3))) const char* lds_cptr;
typedef __attribute__((address_space(3))) char* lds_ptr;
typedef __attribute__((address_space(3))) float* lds_fptr;
using s16x4 = __attribute__((ext_vector_type(4))) short;
using f32x16 = __attribute__((ext_vector_type(16))) float;
using u32x4 = __attribute__((ext_vector_type(4))) unsigned;
typedef short v4i16_t __attribute__((ext_vector_type(4)));
typedef float f32x2_t __attribute__((ext_vector_type(2))); typedef __bf16 bf16x2_t __attribute__((ext_vector_type(2)));
constexpr float C2 = 0.125f * 1.4426950408889634f;
__device__ __forceinline__ int crow(int r, int hi) { return (r & 3) + 8 * (r >> 2) + 4 * hi; }
__device__ __forceinline__ unsigned cvtpk_s(float lo, float hi) { f32x2_t v = {lo, hi}; bf16x2_t b = __builtin_convertvector(v, bf16x2_t); return __builtin_bit_cast(unsigned, b); }
__device__ __forceinline__ void glds16(const void* gsrc, unsigned lds_dst) { unsigned keep;
    asm volatile("s_mov_b32 %0, m0\n\ts_mov_b32 m0, %2\n\ts_nop 0\n\tglobal_load_lds_dwordx4 %1, off\n\ts_mov_b32 m0, %0" : "=&s"(keep) : "v"(gsrc), "s"(lds_dst) : "memory"); }
#define ATT_WAITV(N) asm volatile("s_waitcnt vmcnt(" #N ")" ::: "memory")
#define ATT_WAITL() asm volatile("s_waitcnt lgkmcnt(0)" ::: "memory")
#define ATT_BAR() asm volatile("s_waitcnt lgkmcnt(0)\n\ts_barrier" ::: "memory")
__device__ __forceinline__ s16x4 vtr(lds_cptr p) { return __builtin_bit_cast(s16x4, __builtin_amdgcn_ds_read_tr16_b64_v4i16((__attribute__((address_space(3))) v4i16_t*)p)); }

__device__ __forceinline__ int kswz(int row) { return (((row >> 1) & 1) << 2) | ((row >> 2) & 3); }
__device__ __forceinline__ void kread_offs(int (&ko)[4], int r32, int hi) {
#pragma unroll
    for (int d0 = 0; d0 < 4; ++d0) ko[d0] = r32 * 128 + (((2 * d0 + hi) ^ kswz(r32)) << 4);
}
__device__ __forceinline__ void qkt(f32x16& p0, f32x16& p1, lds_cptr kslot, const bf16x8* qr, const int (&ko)[4], float cinit) {
    f32x16 z;
#pragma unroll
    for (int r = 0; r < 16; ++r) z[r] = cinit;
    bf16x8 kf[8];
#pragma unroll
    for (int d0 = 0; d0 < 4; ++d0) { kf[2 * d0] = *(const __attribute__((address_space(3))) bf16x8*)(kslot + ko[d0]); kf[2 * d0 + 1] = *(const __attribute__((address_space(3))) bf16x8*)(kslot + ko[d0] + 4096); }
    __builtin_amdgcn_sched_barrier(0);
#pragma unroll
    for (int d0 = 0; d0 < 4; ++d0) {
        if (d0 == 0) { p0 = __builtin_amdgcn_mfma_f32_32x32x16_bf16(kf[0], qr[0], z, 0, 0, 0); p1 = __builtin_amdgcn_mfma_f32_32x32x16_bf16(kf[1], qr[0], z, 0, 0, 0); }
        else { p0 = __builtin_amdgcn_mfma_f32_32x32x16_bf16(kf[2 * d0], qr[d0], p0, 0, 0, 0); p1 = __builtin_amdgcn_mfma_f32_32x32x16_bf16(kf[2 * d0 + 1], qr[d0], p1, 0, 0, 0); }
    }
}
__device__ __forceinline__ int rowmax_bits(const f32x16& p0, const f32x16& p1) {
    int a, b;
    { const float f0 = p0[0], f1 = p1[0]; a = __float_as_int(f0); b = __float_as_int(f1); }
#pragma unroll
    for (int r = 1; r < 16; ++r) { const float f0 = p0[r], f1 = p1[r]; const int x = __float_as_int(f0), y = __float_as_int(f1); a = a > x ? a : x; b = b > y ? b : y; }
    const int m = a > b ? a : b;
    auto rr = __builtin_amdgcn_permlane32_swap((unsigned)m, (unsigned)m, false, false);
    return (int)rr[0] > (int)rr[1] ? (int)rr[0] : (int)rr[1];
}
__device__ __forceinline__ float rowmax(const f32x16& p0, const f32x16& p1) {
    float a = __builtin_fmaxf(p0[0], p1[0]), b = __builtin_fmaxf(p0[1], p1[1]);
#pragma unroll
    for (int r = 2; r < 16; r += 2) { a = __builtin_fmaxf(a, __builtin_fmaxf(p0[r], p1[r])); b = __builtin_fmaxf(b, __builtin_fmaxf(p0[r + 1], p1[r + 1])); }
    const float m = __builtin_fmaxf(a, b);
    auto rr = __builtin_amdgcn_permlane32_swap(__float_as_uint(m), __float_as_uint(m), false, false);
    return __builtin_fmaxf(__uint_as_float(rr[0]), __uint_as_float(rr[1]));
}
__device__ __forceinline__ float halfsum(float v) {
    auto rr = __builtin_amdgcn_permlane32_swap(__float_as_uint(v), __float_as_uint(v), false, false);
    return __uint_as_float(rr[0]) + __uint_as_float(rr[1]);
}
template <int NDB> __device__ __forceinline__ void vread_offs(int (&vo)[NDB][2], int lane) {
    const int hi = lane >> 5, g1 = (lane >> 4) & 1, q = (lane & 15) >> 2, p = lane & 3, cl = 2 * g1 + (p >> 1);
#pragma unroll
    for (int d0 = 0; d0 < NDB; ++d0)
#pragma unroll
        for (int h8 = 0; h8 < 2; ++h8) {
            const int row = 8 * h8 + 4 * hi + q, c = 4 * d0 + cl;
            if (NDB == 2) vo[d0][h8] = row * 128 + ((c ^ kswz(row)) << 4) + 8 * (p & 1);
            else vo[d0][h8] = row * 256 + ((c ^ ((row & 3) << 2)) << 4) + 8 * (p & 1);
        }
}
constexpr float SM_THR = 4.0f;
template <int NDB>
__device__ __forceinline__ void softmax_pv(f32x16& p0, f32x16& p1, float& m_run, float& l_run, bool first, f32x16 (&o)[NDB], lds_cptr vslot, const int (&vo)[NDB][2], lds_fptr wsf, int r32, int hi) {
    const int mb = rowmax_bits(p0, p1);
    if (__any(first || mb > __builtin_bit_cast(int, SM_THR))) {
        const float rm = rowmax(p0, p1);
        const float dl = first ? rm : __builtin_fmaxf(rm, 0.f);
        m_run += dl;
#pragma unroll
        for (int r = 0; r < 16; ++r) { p0[r] -= dl; p1[r] -= dl; }
        if (!first) {
            const float alpha = __builtin_amdgcn_exp2f(-dl);
            l_run *= alpha;
            if (hi == 0) wsf[r32] = alpha;
            ATT_WAITL();
#pragma unroll
            for (int g = 0; g < 4; ++g) {
                const f32x4 a4 = *(const __attribute__((address_space(3))) f32x4*)(wsf + 8 * g + 4 * hi);
#pragma unroll
                for (int d = 0; d < NDB; ++d) { o[d][4 * g + 0] *= a4[0]; o[d][4 * g + 1] *= a4[1]; o[d][4 * g + 2] *= a4[2]; o[d][4 * g + 3] *= a4[3]; }
            }
        }
    }
    float s = 0.f;
#pragma unroll
    for (int r = 0; r < 16; ++r) { p0[r] = __builtin_amdgcn_exp2f(p0[r]); p1[r] = __builtin_amdgcn_exp2f(p1[r]); s += p0[r] + p1[r]; }
    l_run += s;
    u32x4 pw[4];
#pragma unroll
    for (int k = 0; k < 2; ++k) { pw[k] = (u32x4){cvtpk_s(p0[8 * k], p0[8 * k + 1]), cvtpk_s(p0[8 * k + 2], p0[8 * k + 3]), cvtpk_s(p0[8 * k + 4], p0[8 * k + 5]), cvtpk_s(p0[8 * k + 6], p0[8 * k + 7])};
        pw[2 + k] = (u32x4){cvtpk_s(p1[8 * k], p1[8 * k + 1]), cvtpk_s(p1[8 * k + 2], p1[8 * k + 3]), cvtpk_s(p1[8 * k + 4], p1[8 * k + 5]), cvtpk_s(p1[8 * k + 6], p1[8 * k + 7])}; }
    s16x4 fa[8], fb[8];
#pragma unroll
    for (int ks = 0; ks < 4; ++ks) { fa[2 * ks] = vtr(vslot + vo[0][0] + ks * (1024 * NDB)); fa[2 * ks + 1] = vtr(vslot + vo[0][1] + ks * (1024 * NDB)); }
#pragma unroll
    for (int d0 = 0; d0 < NDB; ++d0) {
        __builtin_amdgcn_sched_barrier(0);
        if (d0 + 1 < NDB) {
#pragma unroll
            for (int ks = 0; ks < 4; ++ks) { if (d0 & 1) { fa[2 * ks] = vtr(vslot + vo[d0 + 1 < NDB ? d0 + 1 : 0][0] + ks * (1024 * NDB)); fa[2 * ks + 1] = vtr(vslot + vo[d0 + 1 < NDB ? d0 + 1 : 0][1] + ks * (1024 * NDB)); }
                else { fb[2 * ks] = vtr(vslot + vo[d0 + 1 < NDB ? d0 + 1 : 0][0] + ks * (1024 * NDB)); fb[2 * ks + 1] = vtr(vslot + vo[d0 + 1 < NDB ? d0 + 1 : 0][1] + ks * (1024 * NDB)); } }
        }
        __builtin_amdgcn_sched_barrier(0);
#pragma unroll
        for (int ks = 0; ks < 4; ++ks) {
            const s16x4 lo = (d0 & 1) ? fb[2 * ks] : fa[2 * ks], hh = (d0 & 1) ? fb[2 * ks + 1] : fa[2 * ks + 1];
            const bf16x8 vb = (bf16x8){lo[0], lo[1], lo[2], lo[3], hh[0], hh[1], hh[2], hh[3]};
            o[d0] = __builtin_amdgcn_mfma_f32_32x32x16_bf16(__builtin_bit_cast(bf16x8, pw[ks]), vb, o[d0], 0, 0, 0);
        }
    }
}
template <int NDB>
__device__ __forceinline__ void pv_only(f32x16 (&o)[NDB], const u32x4 (&pw)[4], lds_cptr vslot, const int (&vo)[NDB][2]) {
#pragma unroll
    for (int d0 = 0; d0 < NDB; ++d0)
#pragma unroll
        for (int ks = 0; ks < 4; ++ks) {
            const s16x4 lo = vtr(vslot + vo[d0][0] + ks * (1024 * NDB)), hh = vtr(vslot + vo[d0][1] + ks * (1024 * NDB));
            const bf16x8 vb = (bf16x8){lo[0], lo[1], lo[2], lo[3], hh[0], hh[1], hh[2], hh[3]};
            o[d0] = __builtin_amdgcn_mfma_f32_32x32x16_bf16(__builtin_bit_cast(bf16x8, pw[ks]), vb, o[d0], 0, 0, 0);
        }
}
template <int NDB>
__device__ __forceinline__ float finish_o(float l_run, f32x16 (&o)[NDB], lds_fptr wsf, int r32, int hi) {
    const float l = halfsum(l_run);
    if (hi == 0) wsf[32 + r32] = 1.0f / l;
    ATT_WAITL();
#pragma unroll
    for (int g = 0; g < 4; ++g) {
        const f32x4 a4 = *(const __attribute__((address_space(3))) f32x4*)(wsf + 32 + 8 * g + 4 * hi);
#pragma unroll
        for (int d = 0; d < NDB; ++d) { o[d][4 * g + 0] *= a4[0]; o[d][4 * g + 1] *= a4[1]; o[d][4 * g + 2] *= a4[2]; o[d][4 * g + 3] *= a4[3]; }
    }
    return l;
}
}

constexpr int NWAVES = 8;
constexpr int NB = 8, SEQ = 4096, DM = 1024, TT = NB * SEQ;
constexpr int MEMT = 256, MEMROWS = NB * MEMT;
constexpr int INW = 2560, SKVW = 4608, PQW = 2048, MKVW = 512;
constexpr int NEXP = 16384;
constexpr float EPS = 1e-5f;
constexpr int NPHASE = 25;

constexpr size_t MiB = 1u << 20;
constexpr size_t WS_CTL = 0, CTL_ZERO_BYTES = 1 * MiB;
constexpr size_t WS_WA = 1 * MiB, WS_WB = 11 * MiB, WS_WMKV = 21 * MiB, WS_WOUT = 25 * MiB, WS_WPQ = 33 * MiB, WS_WSKV = 49 * MiB, WS_PKEYS = 58 * MiB, WS_ROPE = 60 * MiB, WS_SS = 61 * MiB, WS_MEMKV = 63 * MiB;
constexpr size_t WS_PU = 96 * MiB, WS_PV = 160 * MiB;
constexpr int PROW = 544;
constexpr size_t WS_XN = 352 * MiB, WS_XB = 416 * MiB, WS_PROJ = 480 * MiB, WS_MIX = 640 * MiB, WS_SKV = 704 * MiB, WS_END = 992 * MiB;
constexpr size_t WS_MEMN = WS_SKV;
constexpr size_t WS_OG = 224 * MiB;
constexpr size_t WS_LSEG = 368 * MiB;
static_assert(WS_OG + (size_t)TT * 2304 * 2 <= WS_LSEG && WS_LSEG + (size_t)TT * 36 * 4 <= WS_XB + 64 * MiB && WS_OG >= WS_PV + 50 * MiB, "OG scratch");
constexpr int CW_BAR = 4096;

constexpr int RING_OFF = 0, RING_BYTES = 131072;
constexpr int LDSCTL_OFF = RING_BYTES, MISC_OFF = LDSCTL_OFF + 320;
constexpr int PEER_SCR = LDSCTL_OFF + 1024;
constexpr int LDS_BYTES = 163840;
static_assert(PEER_SCR + 8 * 2048 <= LDS_BYTES, "LDS map");

#define XB_TMO      128
#define XB_XCNT(j)  (256  + 64 * (j))
#define XB_XSUB(j)  (1280 + 64 * (j))
#define XB_XGEN(j)  (2304 + 64 * (j))
#define XB_TOP      3328
#define XB_TOPGEN   3392
#define XCD_BAR_WORDS 3456
#define XB_SPIN_CAP (1u << 18)

__device__ __forceinline__ unsigned xb_ld(unsigned* p)              { return __hip_atomic_load(p, __ATOMIC_RELAXED, __HIP_MEMORY_SCOPE_AGENT); }
__device__ __forceinline__ unsigned xb_add(unsigned* p, unsigned v) { return __hip_atomic_fetch_add(p, v, __ATOMIC_RELAXED, __HIP_MEMORY_SCOPE_AGENT); }
__device__ __forceinline__ unsigned xb_xcc_id() { return (unsigned)__builtin_amdgcn_s_getreg((3 << 11) | 20) & 0xFu; }
#define XB_SPIN(cond, bar) do { unsigned _sp = 0; while (cond) { __builtin_amdgcn_s_sleep(1); \
    if ((++_sp & 255u) == 0u) { if (xb_ld(&(bar)[XB_TMO])) break; if (_sp > XB_SPIN_CAP) { atomicAdd(&(bar)[XB_TMO], 1u); break; } } } } while (0)

struct XcdBarrier {
    unsigned* bar; unsigned x;
    volatile LAS unsigned* st;
};

__device__ __forceinline__ XcdBarrier xcd_barrier_post(unsigned* bar, volatile LAS unsigned* st) {
    XcdBarrier b; b.bar = bar; b.x = xb_xcc_id(); b.st = st;
    if (threadIdx.x == 0) (void)xb_add(&bar[XB_XCNT(b.x)], 1u);
    return b;
}
__device__ __forceinline__ void xcd_barrier_complete(unsigned* bar, unsigned x, unsigned& nloc, unsigned& nx) {
    const unsigned G = gridDim.x * gridDim.y * gridDim.z;
    unsigned sum, cnt, mine, sp = 0u;
    for (;;) {
        sum = 0u; cnt = 0u; mine = 0u;
#pragma unroll
        for (unsigned j = 0; j < 16; ++j) { const unsigned c = xb_ld(&bar[XB_XCNT(j)]); sum += c; cnt += (c > 0u) ? 1u : 0u; mine = (j == x) ? c : mine; }
        if (sum == G) break;
        __builtin_amdgcn_s_sleep(1);
        if ((++sp & 255u) == 0u) { if (xb_ld(&bar[XB_TMO])) break; if (sp > XB_SPIN_CAP) { atomicAdd(&bar[XB_TMO], 1u); break; } }
    }
    nloc = mine > 0u ? mine : 1u; nx = cnt > 0u ? cnt : 1u;
}

__device__ __forceinline__ void xcd_barrier(const XcdBarrier& b) {
    asm volatile("s_waitcnt vmcnt(0)" ::: "memory");
    __syncthreads();
    if (threadIdx.x == 0) {
        unsigned* bar = b.bar;
        __builtin_amdgcn_s_waitcnt(0);
        unsigned nloc = b.st[0], nx = b.st[1];
        if (nloc == 0u) { xcd_barrier_complete(bar, b.x, nloc, nx); b.st[0] = nloc; b.st[1] = nx; }
        const unsigned old = xb_add(&bar[XB_XSUB(b.x)], 1u);
        const unsigned gen = old / nloc;
        if (old + 1u == (gen + 1u) * nloc) {
            __builtin_amdgcn_fence(__ATOMIC_RELEASE, "agent");
            asm volatile("s_waitcnt vmcnt(0)" ::: "memory");
            const unsigned og = xb_add(&bar[XB_TOP], 1u);
            const unsigned tg = og / nx;
            if (og + 1u == (tg + 1u) * nx) xb_add(&bar[XB_TOPGEN], 1u);
            else XB_SPIN(xb_ld(&bar[XB_TOPGEN]) == tg, bar);
            __builtin_amdgcn_fence(__ATOMIC_ACQUIRE, "agent");
            xb_add(&bar[XB_XGEN(b.x)], 1u);
            asm volatile("s_waitcnt vmcnt(0)" ::: "memory");
        } else {
            XB_SPIN(xb_ld(&bar[XB_XGEN(b.x)]) == gen, bar);
            __builtin_amdgcn_fence(__ATOMIC_ACQUIRE, "agent");
            asm volatile("s_waitcnt vmcnt(0)" ::: "memory");
        }
    }
    __syncthreads();
}

struct Frame {
    LAS unsigned char* lds;
    volatile LAS unsigned* MISC;
    int tid, lane, wave, vcu, G, bx;
    const unsigned char __attribute__((address_space(4)))* ka;
};
__device__ __forceinline__ Frame make_frame() {
    extern __shared__ __attribute__((aligned(16))) unsigned char lds_dyn_[];
    Frame F; int tid = threadIdx.x, bx = blockIdx.x, G = gridDim.x;
    asm volatile("" : "+v"(tid)); asm volatile("" : "+s"(bx), "+s"(G));
    F.lds = (LAS unsigned char*)lds_dyn_; F.MISC = (volatile LAS unsigned*)(F.lds + MISC_OFF);
    F.tid = tid; F.lane = tid & 63; F.wave = __builtin_amdgcn_readfirstlane(tid >> 6);
    F.G = G; F.vcu = (G % 8 == 0) ? (bx % 8) * (G / 8) + bx / 8 : bx; F.bx = bx;
    F.ka = (const unsigned char __attribute__((address_space(4)))*)__builtin_amdgcn_kernarg_segment_ptr();
    return F;
}
__device__ __forceinline__ const unsigned char __attribute__((address_space(4)))* ka_fresh(const Frame& F) { const unsigned char __attribute__((address_space(4)))* p = F.ka; asm volatile("" : "+s"(p)); return p; }
#define KA_IN(kp, i) (*(const float* const __attribute__((address_space(4)))*)((kp) + 8 * (i)))
#define KA_OUT(kp) (*(float* const __attribute__((address_space(4)))*)((kp) + 144))
#define KA_WS(kp) (*(unsigned char* const __attribute__((address_space(4)))*)((kp) + 152))
#define WSP(T, off) ((T*)(ws_ + (off)))
__device__ __forceinline__ float wave_sum(float v) { return wave_sum_valu(v); }
__device__ __forceinline__ unsigned cvtpk(float lo, float hi) { return att::cvtpk_s(lo, hi); }

__device__ __forceinline__ void p0_transpose_item(const float* W, int K, int N, bf16* WT, const float* gain, LAS float* scr, int item, int lane) {
    const int nblk = N / 32, kb = item / nblk, nb = item % nblk, k0 = 64 * kb, n0 = 32 * nb;
#pragma unroll 8
    for (int i = 0; i < 32; ++i) { const int kk = 2 * i + (lane >> 5); float w = W[(size_t)(k0 + kk) * N + n0 + (lane & 31)]; if (gain) w *= gain[k0 + kk]; scr[kk * 33 + (lane & 31)] = w; }
    LDS_WAIT(); asm volatile("" ::: "memory");
    const int c = lane & 7;
#pragma unroll
    for (int j = 0; j < 4; ++j) { const int n = (lane >> 3) + 8 * j; const LAS float* s = scr + (8 * c) * 33 + n;
        v4u o; o.x = cvtpk(s[0 * 33], s[1 * 33]); o.y = cvtpk(s[2 * 33], s[3 * 33]); o.z = cvtpk(s[4 * 33], s[5 * 33]); o.w = cvtpk(s[6 * 33], s[7 * 33]);
        *(GAS v4u*)(WT + (size_t)(n0 + n) * K + k0 + 8 * c) = o; }
    LDS_WAIT(); asm volatile("" ::: "memory");
}
__device__ __forceinline__ void cvt_row(const float* src, bf16* dst, int lane) {
    const GAS f32x4* s = (const GAS f32x4*)src + lane; GAS unsigned long long* d = (GAS unsigned long long*)dst + lane;
    f32x4 v[4];
#pragma unroll
    for (int j = 0; j < 4; ++j) v[j] = s[64 * j];
#pragma unroll
    for (int j = 0; j < 4; ++j) d[64 * j] = (unsigned long long)cvtpk(v[j].x, v[j].y) | ((unsigned long long)cvtpk(v[j].z, v[j].w) << 32);
}
template <bool PERM> __device__ __forceinline__ void cvt_2rows_fp4(const float* src, unsigned char* dst, int lane) {
    const int l = lane & 31, h = lane >> 5;
    const GAS f32x4* s = (const GAS f32x4*)(src + (size_t)h * DM + 32 * l);
    f32x4 v[8]; float am = 0.f;
#pragma unroll
    for (int j = 0; j < 8; ++j) { v[j] = s[j]; am = __builtin_fmaxf(am, __builtin_fmaxf(__builtin_fmaxf(__builtin_fabsf(v[j].x), __builtin_fabsf(v[j].y)), __builtin_fmaxf(__builtin_fabsf(v[j].z), __builtin_fabsf(v[j].w)))); }
    const unsigned tb = __float_as_uint(am * (1.0f / 6.0f));
    int eb = (int)(tb >> 23) + ((tb & 0x7fffffu) ? 1 : 0); eb = eb < 1 ? 1 : (eb > 254 ? 254 : eb);
    const float sc = __uint_as_float((unsigned)eb << 23);
    unsigned p[4];
#pragma unroll
    for (int k = 0; k < 4; ++k) { unsigned w = 0u;
        w = __builtin_amdgcn_cvt_scalef32_pk_fp4_f32(w, v[2 * k].x, v[2 * k].y, sc, 0); w = __builtin_amdgcn_cvt_scalef32_pk_fp4_f32(w, v[2 * k].z, v[2 * k].w, sc, 1);
        w = __builtin_amdgcn_cvt_scalef32_pk_fp4_f32(w, v[2 * k + 1].x, v[2 * k + 1].y, sc, 2); w = __builtin_amdgcn_cvt_scalef32_pk_fp4_f32(w, v[2 * k + 1].z, v[2 * k + 1].w, sc, 3); p[k] = w; }
    unsigned char* d = dst + (size_t)h * PROW;
    *(GAS v4u*)(d + 16 * l) = (v4u){p[0], p[1], p[2], p[3]};
    d[512 + (PERM ? 8 * (l & 3) + (l >> 2) : l)] = (unsigned char)eb;
}
__device__ __forceinline__ void rms_row(const float* xrow, const float* g, bf16* orow, bf16* cp, int lane) {
    const GAS f32x4* xr = (const GAS f32x4*)xrow + lane; const GAS f32x4* gr = (const GAS f32x4*)g + lane;
    f32x4 v[4]; float s = 0.f;
#pragma unroll
    for (int j = 0; j < 4; ++j) { v[j] = xr[64 * j]; s += (v[j].x * v[j].x + v[j].y * v[j].y) + (v[j].z * v[j].z + v[j].w * v[j].w); }
    if (cp) { GAS unsigned long long* c = (GAS unsigned long long*)cp + lane;
#pragma unroll
        for (int j = 0; j < 4; ++j) c[64 * j] = (unsigned long long)cvtpk(v[j].x, v[j].y) | ((unsigned long long)cvtpk(v[j].z, v[j].w) << 32); }
    const float rstd = 1.0f / sqrtf(wave_sum(s) * (1.f / DM) + EPS);
    GAS unsigned long long* o8 = (GAS unsigned long long*)orow + lane;
#pragma unroll
    for (int j = 0; j < 4; ++j) { const f32x4 gg = gr[64 * j]; o8[64 * j] = (unsigned long long)cvtpk(v[j].x * rstd * gg.x, v[j].y * rstd * gg.y) | ((unsigned long long)cvtpk(v[j].z * rstd * gg.z, v[j].w * rstd * gg.w) << 32); }
}
__device__ __forceinline__ void p0_prologue(Frame& F) {
    const auto kp_ = ka_fresh(F); unsigned char* const ws_ = KA_WS(kp_); float* const out_ = KA_OUT(kp_);
#define FIN(i) KA_IN(kp_, i)
    LAS float* scr = (LAS float*)(F.lds + RING_OFF + F.wave * 16384);
    const int gw = F.vcu * NWAVES + F.wave, NGW = F.G * NWAVES, lane = F.lane;
    constexpr int I_IN = 16 * (INW / 32), I_MKV = 16 * (MKVW / 32), I_OUT = 16 * (DM / 32), I_PQ = 16 * (PQW / 32), I_SKV = 16 * (SKVW / 32);
    constexpr int E0 = 2 * I_IN, E1 = E0 + 2 * I_IN, E2 = E1 + 4 * I_MKV, E3 = E2 + 4 * I_OUT, E4 = E3 + 4 * I_PQ, E5 = E4 + I_SKV;
    for (int it = gw; it < E5; it += NGW) {
        if (it < E0) { const int l = it / I_IN, r = it % I_IN; p0_transpose_item(FIN(3) + (size_t)l * DM * INW, DM, INW, WSP(bf16, WS_WA) + (size_t)l * INW * DM, nullptr, scr, r, lane); }
        else if (it < E1) { const int q = it - E0, l = q / I_IN, r = q % I_IN; p0_transpose_item(FIN(6) + (size_t)l * DM * INW, DM, INW, WSP(bf16, WS_WB) + (size_t)l * INW * DM, nullptr, scr, r, lane); }
        else if (it < E2) { const int q = it - E1, l = q / I_MKV, r = q % I_MKV; p0_transpose_item(FIN(8) + (size_t)l * DM * MKVW, DM, MKVW, WSP(bf16, WS_WMKV) + (size_t)l * MKVW * DM, nullptr, scr, r, lane); }
        else if (it < E3) { const int q = it - E2, l = q / I_OUT, r = q % I_OUT; p0_transpose_item(FIN(9) + (size_t)l * DM * DM, DM, DM, WSP(bf16, WS_WOUT) + (size_t)l * DM * DM, nullptr, scr, r, lane); }
        else if (it < E4) { const int q = it - E3, l = q / I_PQ, r = q % I_PQ; p0_transpose_item(FIN(11) + (size_t)l * DM * PQW, DM, PQW, WSP(bf16, WS_WPQ) + (size_t)l * PQW * DM, FIN(10) + l * DM, scr, r, lane); }
        else { const int r = it - E4; p0_transpose_item(FIN(16), DM, SKVW, WSP(bf16, WS_WSKV), nullptr, scr, r, lane); }
    }
    for (int r2 = gw; r2 < 2 * NEXP; r2 += NGW) { cvt_2rows_fp4<true>(FIN(13) + (size_t)r2 * 2 * DM, WSP(unsigned char, WS_PU) + (size_t)r2 * 2 * PROW, lane); cvt_2rows_fp4<false>(FIN(14) + (size_t)r2 * 2 * DM, WSP(unsigned char, WS_PV) + (size_t)r2 * 2 * PROW, lane); }
    for (int r = gw; r < 1024; r += NGW) cvt_row(FIN(12) + (size_t)r * 1024, WSP(bf16, WS_PKEYS) + (size_t)r * 1024, lane);
    for (int e = gw * 64 + lane; e < SEQ * 8; e += NGW * 64) { const int t = e >> 3, i = e & 7;
        const double ang = (double)t * pow(500000.0, -(double)i / 8.0);
        WSP(float, WS_ROPE)[t * 16 + i] = (float)cos(ang); WSP(float, WS_ROPE)[t * 16 + 8 + i] = (float)sin(ang); }
    for (int r = gw; r < 4 * MEMROWS; r += NGW) { const int l = r / MEMROWS, m = r % MEMROWS; rms_row(FIN(1) + (size_t)m * DM, FIN(7) + l * DM, WSP(bf16, WS_MEMN) + (size_t)r * DM, nullptr, lane); }
    for (int m = gw; m < TT; m += NGW) rms_row(FIN(0) + (size_t)m * DM, FIN(2), WSP(bf16, WS_XN) + (size_t)m * DM, WSP(bf16, WS_XB) + (size_t)m * DM, lane);
}
#undef FIN

__device__ __forceinline__ void diff_unit(Frame& F, int b, int h, int ib, const bf16* PROJ, bf16* MIX, float lam, float oml, const float* subg) {
    using namespace att;
    const int lane = F.lane, r32 = lane & 31, hi = lane >> 5, w = F.wave, p = w >> 2, wq = w & 3;
    const lds_cptr L = (lds_cptr)(F.lds + RING_OFF);
    const unsigned lds0 = (unsigned)(uintptr_t)(F.lds + RING_OFF);
    lds_fptr wsf = (lds_fptr)(F.lds + RING_OFF + 98304 + w * 256);
    const size_t rb = (size_t)b * SEQ;
    const bf16* Qw = PROJ + (rb + 128 * ib + 32 * wq + r32) * INW + (2 * h + p) * 64;
    const bf16* Kg = PROJ + rb * INW + 768 + (2 * h) * 64;
    const bf16* Vg = PROJ + rb * INW + 1536 + h * 128;
    const int NT = 2 * (ib + 1);
    const int krow_ = 8 * w + (lane >> 3), kch_ = (lane & 7) ^ kswz(krow_);
    const bf16* ksrc0 = Kg + (size_t)krow_ * INW + kch_ * 8;
    const bf16* ksrc1 = ksrc0 + 64;
    const int vrow_ = 8 * w + (lane >> 4), vch_ = (lane & 15) ^ ((vrow_ & 3) << 2);
    const bf16* vsrc0 = Vg + (size_t)vrow_ * INW + vch_ * 8;
    const bf16* vsrc1 = vsrc0 + (size_t)4 * INW;
#define DIFF_ISSUE(t, slot) do { const size_t go_ = (size_t)(t) * 64 * INW; const unsigned sb_ = lds0 + (slot) * 32768; \
        glds16(ksrc0 + go_, (unsigned)__builtin_amdgcn_readfirstlane(sb_ + w * 1024)); glds16(ksrc1 + go_, (unsigned)__builtin_amdgcn_readfirstlane(sb_ + 8192 + w * 1024)); \
        glds16(vsrc0 + go_, (unsigned)__builtin_amdgcn_readfirstlane(sb_ + 16384 + w * 2048)); glds16(vsrc1 + go_, (unsigned)__builtin_amdgcn_readfirstlane(sb_ + 16384 + w * 2048 + 1024)); } while (0)
    DIFF_ISSUE(0, 0); DIFF_ISSUE(1, 1);
    bf16x8 qr[4];
#pragma unroll
    for (int d0 = 0; d0 < 4; ++d0) qr[d0] = *(const bf16x8*)(Qw + d0 * 16 + hi * 8);
    asm volatile("" : "+v"(qr[0]), "+v"(qr[1]), "+v"(qr[2]), "+v"(qr[3]));
    float m_run = 0.f, l_run = 0.f; f32x16 o[4];
#pragma unroll
    for (int d = 0; d < 4; ++d) o[d] = f32x16{};
    const int qrel = 32 * wq + r32; int ko[4], vo[4][2]; kread_offs(ko, r32, hi); vread_offs<4>(vo, lane);
    int sl = 0;
    for (int t = 0; t < NT; ++t) {
        if (t + 1 < NT) ATT_WAITV(4); else ATT_WAITV(0);
        ATT_BAR();
        if (t + 2 < NT) DIFF_ISSUE(t + 2, (sl >= 1 ? sl - 1 : 2));
        const lds_cptr S = L + sl * 32768;
        f32x16 p0, p1;
        qkt(p0, p1, S + p * 8192, qr, ko, -m_run);
        const int jb = t - (NT - 2);
        if (jb >= 0) { const int kb = 64 * jb + 4 * hi;
#pragma unroll
            for (int r = 0; r < 16; ++r) { const int kv = kb + (r & 3) + 8 * (r >> 2); if (kv > qrel) p0[r] = -INFINITY; if (kv + 32 > qrel) p1[r] = -INFINITY; } }
        softmax_pv<4>(p0, p1, m_run, l_run, t == 0, o, S + 16384, vo, wsf, r32, hi);
        sl = sl == 2 ? 0 : sl + 1;
    }
#undef DIFF_ISSUE
    finish_o<4>(l_run, o, wsf, r32, hi);
    ATT_BAR();
    lds_fptr X = (lds_fptr)(F.lds + RING_OFF) + wq * 4096;
    if (p == 1) {
#pragma unroll
        for (int d = 0; d < 4; ++d)
#pragma unroll
            for (int r = 0; r < 16; ++r) X[(d * 16 + r) * 64 + lane] = o[d][r];
    }
    ATT_BAR();
    if (p == 0) {
        float ss[16];
#pragma unroll
        for (int r = 0; r < 16; ++r) ss[r] = 0.f;
#pragma unroll
        for (int d = 0; d < 4; ++d)
#pragma unroll
            for (int r = 0; r < 16; ++r) { const float v = o[d][r] - lam * X[(d * 16 + r) * 64 + lane]; o[d][r] = v; ss[r] += v * v; }
#pragma unroll
        for (int r = 0; r < 16; ++r) {
            float s = ss[r];
            s = half32_sum(s);
            ss[r] = oml / sqrtf(s * (1.f / 128.f) + EPS);
        }
        LAS unsigned short* stg = (LAS unsigned short*)(F.lds + RING_OFF + 65536 + wq * 8192);
#pragma unroll
        for (int d = 0; d < 4; ++d) { const float g = subg[32 * d + r32];
#pragma unroll
            for (int r = 0; r < 16; ++r) { const unsigned short hb = (unsigned short)(cvtpk(o[d][r] * ss[r] * g, 0.f) & 0xffffu); stg[crow(r, hi) * 128 + 32 * d + r32] = hb; } }
        ATT_WAITL();
        bf16* Ow = MIX + (rb + 128 * ib + 32 * wq) * DM + h * 128;
#pragma unroll
        for (int i = 0; i < 8; ++i) { const int idx = i * 64 + lane, row = idx >> 4, ch = idx & 15;
            const u32x4 v = *(const LAS u32x4*)(stg + row * 128 + ch * 8); *(u32x4*)(Ow + (size_t)row * DM + ch * 8) = v; }
    }
    ATT_BAR();
}

constexpr int WP_STRIDE = 16384;
struct MemMap {
    int base;
    __device__ __forceinline__ int nt() const { return 4; }
    __device__ __forceinline__ int first() const { return 0; }
    __device__ __forceinline__ int krow(int tt, int j) const { return base + 64 * tt + j; }
    __device__ __forceinline__ void mask(int, att::f32x16&, att::f32x16&, int, int) const {}
};
struct DilMap {
    int rowbase, d, res, m0, ks, Lm1;
    __device__ __forceinline__ int nt() const { return 3; }
    __device__ __forceinline__ int first() const { return ks + 64 <= 0 ? (ks + 128 <= 0 ? 2 : 1) : 0; }
    __device__ __forceinline__ int krow(int tt, int j) const { int mp = ks + 64 * tt + j; mp = mp < 0 ? 0 : (mp > Lm1 ? Lm1 : mp); return rowbase + mp * d + res; }
    __device__ __forceinline__ void mask(int tt, att::f32x16& p0, att::f32x16& p1, int r32, int hi) const {
        const int m = m0 + r32, kb = ks + 64 * tt + 4 * hi;
#pragma unroll
        for (int r = 0; r < 16; ++r) { const int mp = kb + (r & 3) + 8 * (r >> 2);
            if (mp < 0 || mp > m || mp < m - 128) p0[r] = -INFINITY;
            if (mp + 32 < 0 || mp + 32 > m || mp + 32 < m - 128) p1[r] = -INFINITY; }
    }
};
template <class KM>
__device__ __forceinline__ void win_attn(Frame& F, const KM& km, const bf16* qp, const bf16* Kg, int pitchK, const bf16* Vg, int pitchV, att::f32x16 (&o)[2], float& m_out, float& l_out) {
    using namespace att;
    const int lane = F.lane, r32 = lane & 31, hi = lane >> 5, w = F.wave;
    const unsigned kdst = (unsigned)(uintptr_t)(F.lds + RING_OFF + w * WP_STRIDE), vdst = kdst + 8192;
    const lds_cptr Ks = (lds_cptr)(F.lds + RING_OFF + w * WP_STRIDE), Vs = Ks + 8192;
    lds_fptr wsf = (lds_fptr)(F.lds + PEER_SCR + w * 256);
    bf16x8 qr[4];
#pragma unroll
    for (int d0 = 0; d0 < 4; ++d0) qr[d0] = *(const bf16x8*)(qp + d0 * 16 + hi * 8);
    asm volatile("" : "+v"(qr[0]), "+v"(qr[1]), "+v"(qr[2]), "+v"(qr[3]));
    float m_run = 0.f, l_run = 0.f;
    o[0] = f32x16{}; o[1] = f32x16{};
    int ko[4], vo[2][2]; kread_offs(ko, r32, hi); vread_offs<2>(vo, lane);
#define WP_ISSUE_K(tt) do { _Pragma("unroll") for (int i_ = 0; i_ < 8; ++i_) { const int row_ = 8 * i_ + (lane >> 3); \
        glds16(Kg + (size_t)km.krow(tt, row_) * pitchK + (((lane & 7) ^ kswz(row_)) << 3), (unsigned)__builtin_amdgcn_readfirstlane(kdst + i_ * 1024)); } } while (0)
#define WP_ISSUE_V(tt) do { _Pragma("unroll") for (int i_ = 0; i_ < 8; ++i_) { const int row_ = 8 * i_ + (lane >> 3); \
        glds16(Vg + (size_t)km.krow(tt, row_) * pitchV + (((lane & 7) ^ kswz(row_)) << 3), (unsigned)__builtin_amdgcn_readfirstlane(vdst + i_ * 1024)); } } while (0)
    const int t0 = km.first(), nt = km.nt();
    ATT_WAITL();
    WP_ISSUE_K(t0); WP_ISSUE_V(t0);
    for (int tt = t0; tt < nt; ++tt) {
        ATT_WAITV(8);
        f32x16 p0, p1;
        qkt(p0, p1, Ks, qr, ko, -m_run);
        if (tt + 1 < nt) { ATT_WAITL(); WP_ISSUE_K(tt + 1); ATT_WAITV(8); } else { ATT_WAITV(0); }
        km.mask(tt, p0, p1, r32, hi);
        softmax_pv<2>(p0, p1, m_run, l_run, tt == t0, o, Vs, vo, wsf, r32, hi);
        if (tt + 1 < nt) { ATT_WAITL(); WP_ISSUE_V(tt + 1); }
    }
#undef WP_ISSUE_K
#undef WP_ISSUE_V
    l_out = finish_o<2>(l_run, o, wsf, r32, hi);
    m_out = m_run;
}
template <class RowOff>
__device__ __forceinline__ void win_store(Frame& F, const att::f32x16 (&o)[2], bf16* dst, const RowOff& rowoff) {
    using namespace att;
    const int lane = F.lane, r32 = lane & 31, hi = lane >> 5;
    LAS unsigned short* stg = (LAS unsigned short*)(F.lds + RING_OFF + F.wave * WP_STRIDE);
    ATT_WAITL();
#pragma unroll
    for (int r = 0; r < 16; ++r) { const int orow = crow(r, hi);
#pragma unroll
        for (int d0 = 0; d0 < 2; ++d0) stg[orow * 64 + d0 * 32 + r32] = (unsigned short)(cvtpk(o[d0][r], 0.f) & 0xffffu); }
    ATT_WAITL();
#pragma unroll
    for (int i = 0; i < 4; ++i) { const int row = i * 8 + (lane >> 3), ch = lane & 7; const u32x4 v = *(const LAS u32x4*)(stg + row * 64 + ch * 8); *(u32x4*)(dst + rowoff(row) + ch * 8) = v; }
    ATT_WAITL();
}
__device__ __forceinline__ void mem_attn_all(Frame& F, const bf16* PROJ, const bf16* MKV, bf16* MIX) {
    const int gw = F.vcu * NWAVES + F.wave, NGW = F.G * NWAVES, r32 = F.lane & 31;
    for (int qb = gw; qb < NB * 4 * (SEQ / 32); qb += NGW) {
        const int blk = qb % (SEQ / 32), mh = (qb / (SEQ / 32)) & 3, b = qb / (4 * (SEQ / 32));
        const size_t row0 = (size_t)b * SEQ + 32 * blk;
        MemMap km{b * MEMT};
        att::f32x16 o[2]; float m_, l_;
        win_attn(F, km, PROJ + (row0 + r32) * INW + 2304 + mh * 64, MKV + mh * 64, MKVW, MKV + 256 + mh * 64, MKVW, o, m_, l_);
        win_store(F, o, MIX + row0 * DM + 768 + mh * 64, [](int i) { return (size_t)i * DM; });
    }
}
__device__ __forceinline__ void dil_strip(Frame& F, int b, int head, int res, int s, int d, const bf16* PROJ, const bf16* SKV, bf16* OG, float* LSEG) {
    using namespace att;
    const int lane = F.lane, r32 = lane & 31, hi = lane >> 5, w = F.wave;
    const lds_cptr L = (lds_cptr)(F.lds + RING_OFF);
    const unsigned lds0 = (unsigned)(uintptr_t)(F.lds + RING_OFF);
    lds_fptr wsf = (lds_fptr)(F.lds + PEER_SCR + w * 256);
    const int rb = b * SEQ, Lm1 = SEQ / d - 1, kb0 = 256 * s - 128, m0 = 256 * s + 32 * w;
    const bf16* Kg = SKV + head * 64; const bf16* Vg = Kg + 2304;
    {   const int row_ = 8 * w + (lane >> 3), co_ = ((lane & 7) ^ kswz(row_)) << 3;
#pragma unroll
        for (int j = 0; j < 6; ++j) if (kb0 + 64 * j + 64 > 0) {
            int mp = kb0 + 64 * j + row_; mp = mp < 0 ? 0 : (mp > Lm1 ? Lm1 : mp);
            const size_t go = (size_t)(rb + mp * d + res) * SKVW + co_;
            glds16(Kg + go, (unsigned)__builtin_amdgcn_readfirstlane(lds0 + j * 16384 + w * 1024)); glds16(Vg + go, (unsigned)__builtin_amdgcn_readfirstlane(lds0 + j * 16384 + 8192 + w * 1024)); } }
    const size_t qrow = (size_t)rb + (size_t)(m0 + r32) * d + res;
    bf16x8 qr[4];
#pragma unroll
    for (int d0 = 0; d0 < 4; ++d0) qr[d0] = *(const bf16x8*)(PROJ + qrow * INW + head * 64 + d0 * 16 + hi * 8);
    asm volatile("" : "+v"(qr[0]), "+v"(qr[1]), "+v"(qr[2]), "+v"(qr[3]));
    int ko[4], vo[2][2]; kread_offs(ko, r32, hi); vread_offs<2>(vo, lane);
    ATT_WAITV(0); ATT_BAR();
    float m_run = 0.f, l_run = 0.f; f32x16 o[2]; o[0] = f32x16{}; o[1] = f32x16{};
    DilMap km{rb, d, res, m0, kb0, Lm1};
    bool first = true;
    for (int jj = 0; jj < 3; ++jj) {
        const int j = (w >> 1) + jj;
        if (kb0 + 64 * j + 64 <= 0) continue;
        f32x16 p0, p1;
        qkt(p0, p1, L + j * 16384, qr, ko, -m_run);
        km.mask(j, p0, p1, r32, hi);
        softmax_pv<2>(p0, p1, m_run, l_run, first, o, L + j * 16384 + 8192, vo, wsf, r32, hi);
        first = false;
    }
    const float l = finish_o<2>(l_run, o, wsf, r32, hi);
    {   LAS unsigned short* stg = (LAS unsigned short*)(F.lds + RING_OFF + 98304 + w * 4096);
#pragma unroll
        for (int r = 0; r < 16; ++r) { const int orow = crow(r, hi);
#pragma unroll
            for (int d0 = 0; d0 < 2; ++d0) stg[orow * 64 + d0 * 32 + r32] = (unsigned short)(cvtpk(o[d0][r], 0.f) & 0xffffu); }
        ATT_WAITL();
        bf16* dst = OG + ((size_t)rb + (size_t)m0 * d + res) * 2304 + head * 64;
#pragma unroll
        for (int i = 0; i < 4; ++i) { const int row = i * 8 + (lane >> 3), ch = lane & 7; const u32x4 v = *(const LAS u32x4*)(stg + row * 64 + ch * 8); *(u32x4*)(dst + (size_t)row * d * 2304 + ch * 8) = v; }
        if (hi == 0) LSEG[qrow * 36 + head] = m_run + __builtin_amdgcn_logf(l); }
    ATT_BAR();
}
__device__ __forceinline__ void dil_combine_all(Frame& F, const bf16* OG, const float* LSEG, bf16* MIX) {
    const int gt = F.vcu * (NWAVES * 64) + F.tid, NT_ = F.G * NWAVES * 64;
    for (int it = gt; it < TT * 12; it += NT_) {
        const int row = it / 12, j = it - row * 12;
        const float* lp = LSEG + (size_t)row * 36 + j; const float l0 = lp[0], l1 = lp[12], l2 = lp[24];
        const float mx = __builtin_fmaxf(l0, __builtin_fmaxf(l1, l2));
        float a0 = __builtin_amdgcn_exp2f(l0 - mx), a1 = __builtin_amdgcn_exp2f(l1 - mx), a2 = __builtin_amdgcn_exp2f(l2 - mx);
        const float inv = 1.0f / (a0 + a1 + a2); a0 *= inv; a1 *= inv; a2 *= inv;
        const v4u* g0 = (const v4u*)(OG + (size_t)row * 2304 + j * 64); const v4u* g1 = g0 + 12 * 8; const v4u* g2 = g1 + 12 * 8;
        v4u* dst = (v4u*)(MIX + (size_t)row * DM + j * 64);
#pragma unroll
        for (int c = 0; c < 8; ++c) {
            const v4u x = g0[c], y = g1[c], z = g2[c]; v4u r;
#pragma unroll
            for (int k = 0; k < 4; ++k) {
                const unsigned xk = x[k], yk = y[k], zk = z[k];
                const float lo = a0 * __uint_as_float(xk << 16) + a1 * __uint_as_float(yk << 16) + a2 * __uint_as_float(zk << 16);
                const float hh = a0 * __uint_as_float(xk & 0xffff0000u) + a1 * __uint_as_float(yk & 0xffff0000u) + a2 * __uint_as_float(zk & 0xffff0000u);
                r[k] = cvtpk(lo, hh);
            }
            dst[c] = r;
        }
    }
}
#ifndef REPMASK
#define REPMASK 0
#endif
#define NREP(b) (((REPMASK) & (b)) ? 2 : 1)

#define CEX(a, b) do { const float hi_ = __builtin_fmaxf(a, b), lo_ = __builtin_fminf(a, b); a = hi_; b = lo_; } while (0)
template <int K, int J> __device__ __forceinline__ void bstage(float (&a)[16]) {
#pragma unroll
    for (int i = 0; i < 16; ++i) { constexpr int k = K, j = J; const int l = i ^ j; if (l > i) { if ((i & k) == 0) CEX(a[i], a[l]); else CEX(a[l], a[i]); } }
}
__device__ __forceinline__ void sort16_desc(float (&a)[16]) {
    bstage<2, 1>(a); bstage<4, 2>(a); bstage<4, 1>(a); bstage<8, 4>(a); bstage<8, 2>(a); bstage<8, 1>(a); bstage<16, 8>(a); bstage<16, 4>(a); bstage<16, 2>(a); bstage<16, 1>(a);
}
__device__ __forceinline__ void merge16(float (&a)[16], const float (&b)[16]) {
#pragma unroll
    for (int i = 0; i < 16; ++i) a[i] = __builtin_fmaxf(a[i], b[15 - i]);
    bstage<16, 8>(a); bstage<16, 4>(a); bstage<16, 2>(a); bstage<16, 1>(a);
}
__device__ __forceinline__ void top16_of_64(const float (&v)[64], float (&out)[16]) {
    float c1[16], c2[16], c3[16];
#pragma unroll
    for (int i = 0; i < 16; ++i) { out[i] = v[i]; c1[i] = v[16 + i]; }
    sort16_desc(out); sort16_desc(c1); merge16(out, c1);
#pragma unroll
    for (int i = 0; i < 16; ++i) { c2[i] = v[32 + i]; c3[i] = v[48 + i]; }
    sort16_desc(c2); sort16_desc(c3); merge16(c2, c3); merge16(out, c2);
}
struct CandTab { int pos[16][16]; int inv[64]; int n;
    constexpr CandTab() : pos{}, inv{}, n(0) { for (int q = 0; q < 64; ++q) inv[q] = -1; for (int a = 0; a < 16; ++a) for (int b = 0; b < 16; ++b) { if ((a + 1) * (b + 1) <= 16) { pos[a][b] = n; inv[n] = a * 16 + b; ++n; } else pos[a][b] = -1; } } };
static constexpr CandTab kCand{};
static_assert(kCand.n == 50, "50 candidate pairs");
__device__ __forceinline__ float gelu1(float v) { pg8::f32x2 t = {v, v}; return pg8::gelu_pk(t).x; }
__device__ __forceinline__ float half32_max(float v) {
    v = dpp_maxc<0xB1>(v); v = dpp_maxc<0x4E>(v); v = dpp_maxc<0x141>(v); v = dpp_maxc<0x140>(v);
    auto r = __builtin_amdgcn_permlane16_swap(__float_as_uint(v), __float_as_uint(v), false, false); return __builtin_fmaxf(__uint_as_float(r[0]), __uint_as_float(r[1]));
}

__device__ __forceinline__ void peer_phase(Frame& F, int l) {
    using att::f32x16; using att::crow;
    const int lane = F.lane, r32 = lane & 31, hi = lane >> 5, w = F.wave;
    const auto kp_ = ka_fresh(F); unsigned char* const ws_ = KA_WS(kp_); float* const out_ = KA_OUT(kp_);
    const bf16* PQ = WSP(bf16, WS_PROJ);
    const bf16* keys = WSP(bf16, WS_PKEYS) + (size_t)l * 16 * 128 * 128;
    const unsigned char* U6 = WSP(unsigned char, WS_PU) + (size_t)l * NEXP * PROW;
    const unsigned char* V6 = WSP(unsigned char, WS_PV) + (size_t)l * NEXP * PROW;
    LAS unsigned* ids = (LAS unsigned*)(F.lds + RING_OFF);
    const unsigned kbuf = (unsigned)(uintptr_t)(F.lds + RING_OFF + 65536 + (w >> 2) * 32768);
    const att::lds_cptr KB = (att::lds_cptr)(F.lds + RING_OFF + 65536 + (w >> 2) * 32768);
    LAS unsigned char* scr = F.lds + PEER_SCR + w * 2048 + lane * 32;
    const float* gf = KA_IN(kp_, 10) + l * DM;
    for (int tile = F.bx; tile < TT / 128; tile += F.G) {
        {
            const int tokl = 32 * (w & 3) + r32; const size_t tok = (size_t)tile * 128 + tokl;
#define KEYS_ISSUE(gi) do { const bf16* kg_ = keys + (size_t)((4 * (w >> 2)) * 2 + (gi)) * 16384; int ln_ = lane; asm volatile("" : "+v"(ln_)); _Pragma("unroll") for (int i_ = 0; i_ < 8; ++i_) { const int q_ = 8 * (w & 3) + i_, row_ = 4 * q_ + (ln_ >> 4); \
                att::glds16(kg_ + row_ * 128 + (((ln_ & 15) ^ (row_ & 15)) << 3), (unsigned)__builtin_amdgcn_readfirstlane(kbuf + q_ * 1024)); } } while (0)
            for (int rep_ = 0; rep_ < NREP(256); ++rep_) {
            KEYS_ISSUE(0);
            bf16x8 bq[8];
            { const bf16* qp = PQ + tok * PQW + (4 * (w >> 2)) * 256 + hi * 8;
#pragma unroll
              for (int ks = 0; ks < 8; ++ks) bq[ks] = *(const bf16x8*)(qp + ks * 16); }
            for (int hh = 0; hh < 4; ++hh) {
                const int h = 4 * (w >> 2) + hh;
                float L0[16], L1[16];
#pragma unroll
                for (int p = 0; p < 2; ++p) {
                    asm volatile("" : "+v"(bq[0]), "+v"(bq[1]), "+v"(bq[2]), "+v"(bq[3]), "+v"(bq[4]), "+v"(bq[5]), "+v"(bq[6]), "+v"(bq[7]));
                    ATT_WAITV(0); ATT_BAR();
                    f32x16 acc[4];
#pragma unroll
                    for (int kb = 0; kb < 4; ++kb) acc[kb] = f32x16{};
                    const int kro = r32 * 256, ksw = r32 & 15;
#pragma unroll
                    for (int ks = 0; ks < 8; ++ks) {
#pragma unroll
                        for (int kb = 0; kb < 4; ++kb) { const bf16x8 ak = *(const __attribute__((address_space(3))) bf16x8*)(KB + kb * 8192 + kro + (((2 * ks + hi) ^ ksw) << 4)); acc[kb] = __builtin_amdgcn_mfma_f32_32x32x16_bf16(ak, bq[ks], acc[kb], 0, 0, 0); } }
                    asm volatile("" : "+v"(acc[0]), "+v"(acc[1]), "+v"(acc[2]), "+v"(acc[3]));
                    ATT_BAR();
                    if (hh * 2 + p + 1 < 8) { KEYS_ISSUE(hh * 2 + p + 1);
                        const bf16* qp = PQ + tok * PQW + (4 * (w >> 2)) * 256 + (hh * 2 + p + 1) * 128 + hi * 8;
#pragma unroll
                        for (int ks = 0; ks < 8; ++ks) bq[ks] = *(const bf16x8*)(qp + ks * 16); }
                    float t[16];
#pragma unroll
                    for (int kb = 0; kb < 4; ++kb) { float c[16];
#pragma unroll
                        for (int r = 0; r < 16; ++r) c[r] = __uint_as_float((__float_as_uint(acc[kb][r]) & ~127u) | (unsigned)(kb * 32 + (r & 3) + 8 * (r >> 2)));
                        sort16_desc(c);
                        if (kb == 0) {
#pragma unroll
                            for (int r = 0; r < 16; ++r) t[r] = c[r];
                        } else merge16(t, c); }
                    float a[16], b[16];
#pragma unroll
                    for (int i = 0; i < 16; ++i) { auto rr = __builtin_amdgcn_permlane32_swap(__float_as_uint(t[i]), __float_as_uint(t[i]), false, false); a[i] = __uint_as_float(rr[0]); b[i] = __uint_as_float(rr[1] | 4u); }
                    merge16(a, b);
#pragma unroll
                    for (int i = 0; i < 16; ++i) { if (p == 0) L0[i] = a[i]; else L1[i] = a[i]; }
                }
#pragma unroll
                for (int q = 0; q < 4; ++q) {
                    ((LAS unsigned*)scr)[q] = (__float_as_uint(L0[4 * q]) & 127u) | ((__float_as_uint(L0[4 * q + 1]) & 127u) << 8) | ((__float_as_uint(L0[4 * q + 2]) & 127u) << 16) | ((__float_as_uint(L0[4 * q + 3]) & 127u) << 24);
                    ((LAS unsigned*)scr)[4 + q] = (__float_as_uint(L1[4 * q]) & 127u) | ((__float_as_uint(L1[4 * q + 1]) & 127u) << 8) | ((__float_as_uint(L1[4 * q + 2]) & 127u) << 16) | ((__float_as_uint(L1[4 * q + 3]) & 127u) << 24);
                }
                float sel[16];
#pragma unroll
                for (int ch = 0; ch < 4; ++ch) { float c[16];
#pragma unroll
                    for (int q = 0; q < 16; ++q) { constexpr int dummy = 0; const int code = kCand.inv[ch * 16 + q];
                        c[q] = code >= 0 ? __uint_as_float((__float_as_uint(L0[code >= 0 ? (code >> 4) : 0] + L1[code >= 0 ? (code & 15) : 0]) & ~255u) | (unsigned)(code >= 0 ? code : 0)) : -INFINITY; }
                    sort16_desc(c);
                    if (ch == 0) {
#pragma unroll
                        for (int q = 0; q < 16; ++q) sel[q] = c[q];
                    } else merge16(sel, c); }
                asm volatile("s_waitcnt lgkmcnt(0)" ::: "memory");
                float ev[16]; unsigned eid[16]; float esum = 0.f;
                const float s0 = __uint_as_float(__float_as_uint(sel[0]) & ~255u);
#pragma unroll
                for (int k = 0; k < 16; ++k) { const unsigned bits = __float_as_uint(sel[k]); const unsigned code = bits & 255u;
                    const unsigned i1 = scr[code >> 4], i2 = scr[16 + (code & 15u)];
                    eid[k] = i1 * 128u + i2; ev[k] = __expf(__uint_as_float(bits & ~255u) - s0); esum += ev[k]; }
                const float rinv = 1.0f / esum;
                asm volatile("s_waitcnt lgkmcnt(0)" ::: "memory");
#pragma unroll
                for (int k = 0; k < 8; ++k) { const unsigned idv = hi ? eid[k + 8] : eid[k]; const float gv = (hi ? ev[k + 8] : ev[k]) * rinv;
                    ids[tokl * 128 + h * 16 + 8 * hi + k] = idv | (cvtpk(0.f, gv) & 0xffff0000u); }
            }
            }
#undef KEYS_ISSUE
        }
        __syncthreads();
        {
        const Frame F2 = make_frame(); const int lane = F2.lane, w = F2.wave, bl = lane & 31, hf = lane >> 5;
        typedef __bf16 bf2 __attribute__((ext_vector_type(2))); typedef float f32x2_t __attribute__((ext_vector_type(2)));
        {   LAS unsigned* lst = ids + w * 2048; unsigned ent[16][2];
#pragma unroll
            for (int t = 0; t < 16; ++t) { ent[t][0] = lst[t * 128 + lane]; ent[t][1] = lst[t * 128 + 64 + lane]; }
            asm volatile("s_waitcnt lgkmcnt(0)" ::: "memory");
#pragma unroll
            for (int t = 0; t < 16; ++t) {
                LAS unsigned* L = lst + t * 128; const unsigned q0 = ent[t][0], q1 = ent[t][1]; const int r0 = (int)((q0 >> 10) & 15u), r1 = (int)((q1 >> 10) & 15u);
                int base = 0;
                for (int r = 0; r < 16; ++r) {
                    const unsigned long long m0 = __ballot(r0 == r), m1 = __ballot(r1 == r); const int c0 = __popcll(m0);
                    if (r0 == r) L[base + __builtin_amdgcn_mbcnt_hi((unsigned)(m0 >> 32), __builtin_amdgcn_mbcnt_lo((unsigned)m0, 0))] = q0;
                    if (r1 == r) L[base + c0 + __builtin_amdgcn_mbcnt_hi((unsigned)(m1 >> 32), __builtin_amdgcn_mbcnt_lo((unsigned)m1, 0))] = q1;
                    base += c0 + __popcll(m1);
                }
            }
            asm volatile("s_waitcnt lgkmcnt(0)" ::: "memory");
        }
        const __amdgpu_buffer_rsrc_t rsu = __builtin_amdgcn_make_buffer_rsrc((void*)U6, 0, NEXP * PROW, 0x00020000), rsv = __builtin_amdgcn_make_buffer_rsrc((void*)V6, 0, NEXP * PROW, 0x00020000);
        {
            const int ci = lane & 15, cg = lane >> 4;
            const unsigned xq8 = (unsigned)(uintptr_t)(F2.lds + RING_OFF + 65536 + w * 8192);
            const bool wr = ((ci & 7) == 0) && ((cg >> 1) == (ci >> 3));
            typedef int v8i_t __attribute__((ext_vector_type(8))); typedef unsigned v2u_t __attribute__((ext_vector_type(2)));
            for (int h = 0; h < 2; ++h) {
                int eb_v = 127;
                for (int p = 0; p < 4; ++p) {
                    const int tokl = 16 * w + 8 * h + 2 * p + hf; const size_t tok = (size_t)tile * 128 + tokl;
                    const bf16* xrow = WSP(bf16, WS_XB) + tok * DM + 32 * bl;
            {   v4u xw[4]; float ssq = 0.f; f32x4 x[8];
#pragma unroll
                for (int j = 0; j < 4; ++j) xw[j] = ((const v4u*)xrow)[j];
#pragma unroll
                for (int j = 0; j < 4; ++j) { const unsigned a_ = xw[j].x, b_ = xw[j].y, c_ = xw[j].z, d_ = xw[j].w;
                    x[2 * j] = (f32x4){__uint_as_float(a_ << 16), __uint_as_float(a_ & 0xffff0000u), __uint_as_float(b_ << 16), __uint_as_float(b_ & 0xffff0000u)};
                    x[2 * j + 1] = (f32x4){__uint_as_float(c_ << 16), __uint_as_float(c_ & 0xffff0000u), __uint_as_float(d_ << 16), __uint_as_float(d_ & 0xffff0000u)}; }
#pragma unroll
                for (int j = 0; j < 8; ++j) ssq += (x[j][0] * x[j][0] + x[j][1] * x[j][1]) + (x[j][2] * x[j][2] + x[j][3] * x[j][3]);
                const float rstd = 1.0f / sqrtf(half32_sum(ssq) * (1.f / DM) + EPS);
                float am = 0.f;
#pragma unroll
                for (int j = 0; j < 8; ++j) { const f32x4 gg = ((const f32x4*)(gf + 32 * bl))[j]; x[j] = x[j] * rstd * gg;
                    am = __builtin_fmaxf(am, __builtin_fmaxf(__builtin_fmaxf(__builtin_fabsf(x[j][0]), __builtin_fabsf(x[j][1])), __builtin_fmaxf(__builtin_fabsf(x[j][2]), __builtin_fabsf(x[j][3])))); }
                am = __builtin_fmaxf(half32_max(am), 1e-30f);
                auto rr = __builtin_amdgcn_permlane32_swap(__float_as_uint(am), __float_as_uint(am), false, false);
                const int ebA = (int)(rr[0] >> 23), ebB = (int)(rr[1] >> 23), ebO = hf ? ebB : ebA;
                const float mult = __uint_as_float((unsigned)(261 - ebO) << 23);
                if (lane == 2 * p) eb_v = ebA; if (lane == 2 * p + 1) eb_v = ebB;
                unsigned q8[8];
#pragma unroll
                for (int j = 0; j < 8; ++j) { int p_ = __builtin_amdgcn_cvt_pk_fp8_f32(x[j][0] * mult, x[j][1] * mult, 0, false); p_ = __builtin_amdgcn_cvt_pk_fp8_f32(x[j][2] * mult, x[j][3] * mult, p_, true); q8[j] = (unsigned)p_; }
                { const unsigned xo_ = xq8 + (2 * p + hf) * 1024 + bl * 32; *(LAS v4u*)(uintptr_t)xo_ = (v4u){q8[0], q8[1], q8[2], q8[3]}; *(LAS v4u*)(uintptr_t)(xo_ + 16) = (v4u){q8[4], q8[5], q8[6], q8[7]}; }
                asm volatile("s_waitcnt lgkmcnt(0)" ::: "memory");
            }
                }
                asm volatile("s_waitcnt lgkmcnt(0)" ::: "memory");
                v4u a0, a1, a2, a3, a4, a5, a6, a7, b0, b1, b2, b3, b4, b5, b6, b7, c0, c1, c2, c3, c4, c5, c6, c7; v2u_t sa, sb, sc;
#define U_REQ(B0, B1, B2, B3, B4, B5, B6, B7, S, k_) do { const int G_ = (k_) >> 2, p_ = (k_) & 3; \
                    const unsigned e_ = ids[(16 * w + 8 * h + 2 * p_ + (ci >> 3)) * 128 + 8 * G_ + (ci & 7)] & 0x3fffu; const int uo_ = (int)(e_ * (unsigned)PROW) + 16 * cg; \
                    B0 = __builtin_bit_cast(v4u, __builtin_amdgcn_raw_buffer_load_b128(rsu, uo_, 0, 0)); B1 = __builtin_bit_cast(v4u, __builtin_amdgcn_raw_buffer_load_b128(rsu, uo_ + 64, 0, 0)); \
                    B2 = __builtin_bit_cast(v4u, __builtin_amdgcn_raw_buffer_load_b128(rsu, uo_ + 128, 0, 0)); B3 = __builtin_bit_cast(v4u, __builtin_amdgcn_raw_buffer_load_b128(rsu, uo_ + 192, 0, 0)); \
                    B4 = __builtin_bit_cast(v4u, __builtin_amdgcn_raw_buffer_load_b128(rsu, uo_ + 256, 0, 0)); B5 = __builtin_bit_cast(v4u, __builtin_amdgcn_raw_buffer_load_b128(rsu, uo_ + 320, 0, 0)); \
                    B6 = __builtin_bit_cast(v4u, __builtin_amdgcn_raw_buffer_load_b128(rsu, uo_ + 384, 0, 0)); B7 = __builtin_bit_cast(v4u, __builtin_amdgcn_raw_buffer_load_b128(rsu, uo_ + 448, 0, 0)); \
                    S = __builtin_bit_cast(v2u_t, __builtin_amdgcn_raw_buffer_load_b64(rsu, uo_ + 512 - 8 * cg, 0, 0)); } while (0)
#define MF1(UB, S, j_) do { const v4u x0_ = *(const LAS v4u*)(uintptr_t)(xrd_ + 128 * (j_)), x1_ = *(const LAS v4u*)(uintptr_t)(xrd_ + 128 * (j_) + 64);     \
                    const v8i_t a_ = {(int)UB.x, (int)UB.y, (int)UB.z, (int)UB.w, 0, 0, 0, 0}, b_ = {(int)x0_.x, (int)x0_.y, (int)x0_.z, (int)x0_.w, (int)x1_.x, (int)x1_.y, (int)x1_.z, (int)x1_.w}; \
                    D_ = __builtin_amdgcn_mfma_scale_f32_16x16x128_f8f6f4(a_, b_, D_, 4, 0, (j_) & 3, (int)S[(j_) >> 2], 0, sbx_); } while (0)
#define STEP(C0, C1, C2, C3, C4, C5, C6, C7, SC_, N0, N1, N2, N3, N4, N5, N6, N7, SN_, k_) do { \
                    { const int k2_ = (k_) + 2 < 64 ? (k_) + 2 : 63; U_REQ(N0, N1, N2, N3, N4, N5, N6, N7, SN_, k2_); } \
                    const int G_ = (k_) >> 2, p_ = (k_) & 3; const int ebA_ = __builtin_amdgcn_readlane(eb_v, 2 * p_), ebB_ = __builtin_amdgcn_readlane(eb_v, 2 * p_ + 1); \
                    const int sbx_ = ((ci >> 3) ? ebB_ : ebA_) - 7; const unsigned xrd_ = xq8 + (2 * p_ + (ci >> 3)) * 1024 + cg * 16; \
                    f32x4 D_ = {0.f, 0.f, 0.f, 0.f}; \
                    MF1(C0, SC_, 0); MF1(C1, SC_, 1); MF1(C2, SC_, 2); MF1(C3, SC_, 3); MF1(C4, SC_, 4); MF1(C5, SC_, 5); MF1(C6, SC_, 6); MF1(C7, SC_, 7); \
                    { float d0_ = D_[0], d1_ = D_[1], d2_ = D_[2], d3_ = D_[3]; asm volatile("" : "+v"(d0_), "+v"(d1_), "+v"(d2_), "+v"(d3_)); D_ = (f32x4){d0_, d1_, d2_, d3_}; }     \
                    LAS unsigned* idc_ = ids + (16 * w + 8 * h + 2 * p_ + hf) * 128 + 8 * G_ + 4 * (cg & 1);       \
                    const v4u q_ = *(const LAS v4u*)idc_; pg8::f32x2 t0_ = {D_[0], D_[1]}, t1_ = {D_[2], D_[3]}; t0_ = pg8::gelu_pk(t0_); t1_ = pg8::gelu_pk(t1_); \
                    const v4u n_ = {(q_.x & 0xffffu) | (cvtpk(0.f, __uint_as_float(q_.x & 0xffff0000u) * t0_.x) & 0xffff0000u), (q_.y & 0xffffu) | (cvtpk(0.f, __uint_as_float(q_.y & 0xffff0000u) * t0_.y) & 0xffff0000u), \
                                    (q_.z & 0xffffu) | (cvtpk(0.f, __uint_as_float(q_.z & 0xffff0000u) * t1_.x) & 0xffff0000u), (q_.w & 0xffffu) | (cvtpk(0.f, __uint_as_float(q_.w & 0xffff0000u) * t1_.y) & 0xffff0000u)}; \
                    if (wr) *(LAS v4u*)idc_ = n_; } while (0)
                U_REQ(a0, a1, a2, a3, a4, a5, a6, a7, sa, 0); U_REQ(b0, b1, b2, b3, b4, b5, b6, b7, sb, 1);
#pragma nounroll
                for (int k = 0; k < 64; k += 3) {
                    STEP(a0, a1, a2, a3, a4, a5, a6, a7, sa, c0, c1, c2, c3, c4, c5, c6, c7, sc, k);
                    if (k + 1 >= 64) break;
                    STEP(b0, b1, b2, b3, b4, b5, b6, b7, sb, a0, a1, a2, a3, a4, a5, a6, a7, sa, k + 1);
                    STEP(c0, c1, c2, c3, c4, c5, c6, c7, sc, b0, b1, b2, b3, b4, b5, b6, b7, sb, k + 2);
                }
#undef STEP
#undef MF1
#undef U_REQ
                asm volatile("s_waitcnt lgkmcnt(0)" ::: "memory");
            }
        }

        v4u vb0, vb1, vb2, vb3, vb4, vb5, vb6, vb7; unsigned vs0, vs1, vs2, vs3, vs4, vs5, vs6, vs7;
#define V_LD(VB, VS, ent) do { const unsigned e_ = (ent) & 0x3fffu; const int ro_ = (int)(e_ * (unsigned)PROW) + 16 * bl; \
                VB = __builtin_bit_cast(v4u, __builtin_amdgcn_raw_buffer_load_b128(rsv, ro_, 0, 0)); VS = (unsigned)__builtin_amdgcn_raw_buffer_load_b8(rsv, ro_ + 512 - 15 * bl, 0, 0); } while (0)
#define V_FMA(VB, VS, ent) do { const float c_ = __uint_as_float((ent) & 0xffff0000u), sv_ = __uint_as_float(VS << 23); \
                _Pragma("unroll") for (int k_ = 0; k_ < 4; ++k_) { const unsigned vw_ = VB[k_]; \
                    { const f32x2_t f_ = __builtin_amdgcn_cvt_scalef32_pk_f32_fp4(vw_, sv_, 0); acc[8 * k_] += c_ * f_.x; acc[8 * k_ + 1] += c_ * f_.y; } \
                    { const f32x2_t f_ = __builtin_amdgcn_cvt_scalef32_pk_f32_fp4(vw_, sv_, 1); acc[8 * k_ + 2] += c_ * f_.x; acc[8 * k_ + 3] += c_ * f_.y; } \
                    { const f32x2_t f_ = __builtin_amdgcn_cvt_scalef32_pk_f32_fp4(vw_, sv_, 2); acc[8 * k_ + 4] += c_ * f_.x; acc[8 * k_ + 5] += c_ * f_.y; } \
                    { const f32x2_t f_ = __builtin_amdgcn_cvt_scalef32_pk_f32_fp4(vw_, sv_, 3); acc[8 * k_ + 6] += c_ * f_.x; acc[8 * k_ + 7] += c_ * f_.y; } } } while (0)
        { const LAS unsigned* id0 = ids + (16 * w + hf) * 128; const v4u e4_ = *(const LAS v4u*)id0, e5_ = *(const LAS v4u*)(id0 + 4);
          V_LD(vb0, vs0, e4_.x); V_LD(vb1, vs1, e4_.y); V_LD(vb2, vs2, e4_.z); V_LD(vb3, vs3, e4_.w); V_LD(vb4, vs4, e5_.x); V_LD(vb5, vs5, e5_.y); V_LD(vb6, vs6, e5_.z); V_LD(vb7, vs7, e5_.w); }
        for (int pp = 0; pp < 8; ++pp) {
            const int tokl = 16 * w + 2 * pp + hf; const size_t tok = (size_t)tile * 128 + tokl;
            bf16* xrow = WSP(bf16, WS_XB) + tok * DM + 32 * bl;
            v4u xo[4];
#pragma unroll
            for (int j = 0; j < 4; ++j) xo[j] = ((const v4u*)xrow)[j];
            float acc[32];
#pragma unroll
            for (int i = 0; i < 32; ++i) acc[i] = 0.f;
            const LAS unsigned* idp = ids + tokl * 128;
            const LAS unsigned* idx = ids + (tokl + (pp < 7 ? 2 : 0)) * 128;
#pragma nounroll
            for (int G = 0; G < 16; ++G) {
                const LAS unsigned* idn = G < 15 ? idp + 8 * (G + 1) : idx;
                const v4u ca = *(const LAS v4u*)(idp + 8 * G), cb = *(const LAS v4u*)(idp + 8 * G + 4), na = *(const LAS v4u*)idn, nb = *(const LAS v4u*)(idn + 4);
#define OPAQUE_ONE(x) int x; asm volatile("s_mov_b32 %0, 1" : "=s"(x))
                { OPAQUE_ONE(t_); if (t_) { V_FMA(vb0, vs0, ca.x); } V_LD(vb0, vs0, na.x); }
                { OPAQUE_ONE(t_); if (t_) { V_FMA(vb1, vs1, ca.y); } V_LD(vb1, vs1, na.y); }
                { OPAQUE_ONE(t_); if (t_) { V_FMA(vb2, vs2, ca.z); } V_LD(vb2, vs2, na.z); }
                { OPAQUE_ONE(t_); if (t_) { V_FMA(vb3, vs3, ca.w); } V_LD(vb3, vs3, na.w); }
                { OPAQUE_ONE(t_); if (t_) { V_FMA(vb4, vs4, cb.x); } V_LD(vb4, vs4, nb.x); }
                { OPAQUE_ONE(t_); if (t_) { V_FMA(vb5, vs5, cb.y); } V_LD(vb5, vs5, nb.y); }
                { OPAQUE_ONE(t_); if (t_) { V_FMA(vb6, vs6, cb.z); } V_LD(vb6, vs6, nb.z); }
                { OPAQUE_ONE(t_); if (t_) { V_FMA(vb7, vs7, cb.w); } V_LD(vb7, vs7, nb.w); }
#undef OPAQUE_ONE
            }
            f32x4 y[8]; float s2_ = 0.f;
            {
#pragma unroll
              for (int j = 0; j < 4; ++j) { const unsigned a_ = xo[j].x, b_ = xo[j].y, c_ = xo[j].z, d_ = xo[j].w;
                y[2 * j] = (f32x4){__uint_as_float(a_ << 16) + acc[8 * j], __uint_as_float(a_ & 0xffff0000u) + acc[8 * j + 1], __uint_as_float(b_ << 16) + acc[8 * j + 2], __uint_as_float(b_ & 0xffff0000u) + acc[8 * j + 3]};
                y[2 * j + 1] = (f32x4){__uint_as_float(c_ << 16) + acc[8 * j + 4], __uint_as_float(c_ & 0xffff0000u) + acc[8 * j + 5], __uint_as_float(d_ << 16) + acc[8 * j + 6], __uint_as_float(d_ & 0xffff0000u) + acc[8 * j + 7]}; }
#pragma unroll
              for (int j = 0; j < 8; ++j) s2_ += (y[j][0] * y[j][0] + y[j][1] * y[j][1]) + (y[j][2] * y[j][2] + y[j][3] * y[j][3]); }
            const float r2 = 1.0f / sqrtf(half32_sum(s2_) * (1.f / DM) + EPS);
            const int eo = 32 * bl;
            if (l < 3) {
#pragma unroll
                for (int j = 0; j < 4; ++j) ((v4u*)xrow)[j] = (v4u){cvtpk(y[2 * j][0], y[2 * j][1]), cvtpk(y[2 * j][2], y[2 * j][3]), cvtpk(y[2 * j + 1][0], y[2 * j + 1][1]), cvtpk(y[2 * j + 1][2], y[2 * j + 1][3])};
                { const float* gn = KA_IN(kp_, 2) + (l + 1) * DM + eo; bf16* xn = WSP(bf16, WS_XN) + tok * DM + eo;
#pragma unroll
                  for (int j = 0; j < 4; ++j) { const f32x4 n0 = y[2 * j] * r2 * ((const f32x4*)gn)[2 * j], n1 = y[2 * j + 1] * r2 * ((const f32x4*)gn)[2 * j + 1]; ((v4u*)xn)[j] = (v4u){cvtpk(n0[0], n0[1]), cvtpk(n0[2], n0[3]), cvtpk(n1[0], n1[1]), cvtpk(n1[2], n1[3])}; } }
                if (l == 1) { const float* gs = KA_IN(kp_, 15) + eo; bf16* xs = WSP(bf16, WS_MIX) + tok * DM + eo;
#pragma unroll
                  for (int j = 0; j < 4; ++j) { const f32x4 n0 = y[2 * j] * r2 * ((const f32x4*)gs)[2 * j], n1 = y[2 * j + 1] * r2 * ((const f32x4*)gs)[2 * j + 1]; ((v4u*)xs)[j] = (v4u){cvtpk(n0[0], n0[1]), cvtpk(n0[2], n0[3]), cvtpk(n1[0], n1[1]), cvtpk(n1[2], n1[3])}; } }
            } else {
                const float* gn = KA_IN(kp_, 17) + eo; float* oh = out_ + tok * DM + eo;
#pragma unroll
                for (int j = 0; j < 8; ++j) ((f32x4*)oh)[j] = y[j] * r2 * ((const f32x4*)gn)[j];
            }
        }
#undef V_LD
#undef V_FMA
        }
        __syncthreads();
    }
}

struct Args { const float* in[18]; float* out; unsigned char* ws; int ph_lo, ph_hi; };
__global__ void __launch_bounds__(NWAVES * 64, 2) hyb_fwd(Args args) {
    { Frame F = make_frame();
      for (int u = F.tid; u < 1024 / 4; u += NWAVES * 64) ((LAS unsigned*)(F.lds + LDSCTL_OFF))[u] = 0u; }
    __syncthreads();
    if (__builtin_amdgcn_readfirstlane((int)threadIdx.x) >= 256) __builtin_amdgcn_s_setprio(1);
    const int lo = args.ph_lo, hi = args.ph_hi;
    if (hi - lo > 1) { Frame F = make_frame(); const auto kp_ = ka_fresh(F); (void)xcd_barrier_post((unsigned*)(KA_WS(kp_) + WS_CTL) + CW_BAR, F.MISC + 8); }
#ifndef PHMASK
#define PHMASK 0xff
#endif

#define PHM(b) ((PHMASK & (b)) != 0)
#define IN(k) (lo <= (k) && (k) < hi)
#define SEAM(k) do { if (IN(k) && IN((k) + 1)) { Frame F = make_frame(); const auto kq_ = ka_fresh(F); XcdBarrier b_; b_.bar = (unsigned*)(KA_WS(kq_) + WS_CTL) + CW_BAR; b_.x = xb_xcc_id(); b_.st = F.MISC + 8; xcd_barrier(b_); if (NREP(512) == 2) xcd_barrier(b_); } } while (0)

    if (PHM(1) && IN(0)) { for (int rep_ = 0; rep_ < NREP(1); ++rep_) { Frame F = make_frame(); p0_prologue(F); } }
    SEAM(0);
    for (int l = 0; l < 4; ++l) {
        const int pb = 1 + 6 * l;
        if (PHM(2) && IN(pb)) {
            const int njobs = (l == 0) ? 5 : (l == 2 ? 2 : 1);
            for (int rep_ = 0; rep_ < NREP(2); ++rep_)
            for (int jb = 0; jb < njobs; ++jb) {
                Frame F = make_frame(); const auto kp_ = ka_fresh(F); unsigned char* const ws_ = KA_WS(kp_);
                pg8::Gemm g; pg8::EpiProj E; int cid = F.bx;
                E.rope = WSP(float, WS_ROPE); E.sc = att::C2; E.hm = 0; E.hs = 0;
                const bool is_skv = (l == 2 && jb == 0), is_proj = (l == 2) ? (jb == 1) : (jb == 0);
                if (is_skv) { g = pg8::Gemm{WSP(pg8::bf16_t, WS_MIX), WSP(pg8::bf16_t, WS_WSKV), TT, SKVW, DM}; E.O = WSP(pg8::bf16_t, WS_SKV); E.ldc = SKVW; E.rope_lim = 9; E.scale_lim = 0; E.scale_tile = -1; }
                else if (is_proj) { g = pg8::Gemm{WSP(pg8::bf16_t, WS_XN), (l < 2 ? WSP(pg8::bf16_t, WS_WA) + (size_t)l * INW * DM : WSP(pg8::bf16_t, WS_WB) + (size_t)(l - 2) * INW * DM), TT, INW, DM};
                    E.O = WSP(pg8::bf16_t, WS_PROJ); E.ldc = INW; E.rope_lim = (l < 2) ? 6 : 9; E.scale_lim = (l < 2) ? 3 : 9; E.scale_tile = 9; }
                else { const int lm = jb - 1; g = pg8::Gemm{WSP(pg8::bf16_t, WS_MEMN) + (size_t)lm * MEMROWS * DM, WSP(pg8::bf16_t, WS_WMKV) + (size_t)lm * MKVW * DM, MEMROWS, MKVW, DM};
                    E.O = WSP(pg8::bf16_t, WS_MEMKV) + (size_t)lm * MEMROWS * MKVW; E.ldc = MKVW; E.rope_lim = 0; E.scale_lim = 0; E.scale_tile = -1; cid = (int)((F.bx + F.G - 16 * lm) % F.G); }
                pg8::StaticOrder S; S.init(g.M, g.N, F.G, cid);
                pg8::gemm_phase<pg8::EpiProj, pg8::StaticOrder, true, true>(F.lds + RING_OFF, g, S, E);
                __syncthreads();
            }
        }
        SEAM(pb);
        if (IN(pb + 1)) {
            if (__builtin_amdgcn_readfirstlane((int)threadIdx.x) >= 256) __builtin_amdgcn_s_setprio(1);
            Frame F = make_frame(); const auto kp_ = ka_fresh(F); unsigned char* const ws_ = KA_WS(kp_);
            const bf16* PROJ = WSP(bf16, WS_PROJ); bf16* MIX = WSP(bf16, WS_MIX);
            if (PHM(4) && l < 2) {
                for (int rep_ = 0; rep_ < NREP(4); ++rep_) {
                const float li = 0.8f - 0.6f * expf(-0.3f * (float)l);
                const float* lp = KA_IN(kp_, 4) + l * 256;
                const float d01 = wave_sum(lp[F.lane] * lp[64 + F.lane]), d23 = wave_sum(lp[128 + F.lane] * lp[192 + F.lane]);
                const float lam = expf(d01) - expf(d23) + li;
                const float* subg = KA_IN(kp_, 5) + l * 128;
                const int nper = (768 + F.G - 1) / F.G;
                for (int k = 0; k < nper; ++k) {
                    const int P = F.vcu * nper + k; if (P >= 768) break;
                    const int bh = P >> 4, s = P & 15;
                    diff_unit(F, bh / 6, bh % 6, s, PROJ, MIX, lam, 1.0f - li, subg);
                    diff_unit(F, bh / 6, bh % 6, 31 - s, PROJ, MIX, lam, 1.0f - li, subg);
                }
                }
            } else if (PHM(8)) {
                for (int rep2_ = 0; rep2_ < NREP(8); ++rep2_) {
                const bf16* SKV = WSP(bf16, WS_SKV);
                const int nper = (4608 + F.G - 1) / F.G;
                for (int k = 0; k < nper; ++k) {
                    const int U = F.vcu * nper + k; if (U >= 4608) break;
                    const int w16 = U & 15, bh = U >> 4, head = bh % 36, b = bh / 36, g = head / 12;
                    const int d = g == 0 ? 1 : (g == 1 ? 4 : 16), res = g == 0 ? 0 : (g == 1 ? (w16 >> 2) : w16), s = g == 0 ? w16 : (g == 1 ? (w16 & 3) : 0);
                    dil_strip(F, b, head, res, s, d, PROJ, SKV, WSP(bf16, WS_OG), WSP(float, WS_LSEG));
                }
                }
            }
            if (l < 2) { for (int rep3_ = 0; rep3_ < NREP(16); ++rep3_) if (PHM(16)) mem_attn_all(F, PROJ, WSP(bf16, WS_MEMKV) + (size_t)l * MEMROWS * MKVW, MIX); }
            asm volatile("s_waitcnt vmcnt(0) lgkmcnt(0)" ::: "memory"); __syncthreads();
        }
        SEAM(pb + 1);
        if (IN(pb + 2) && l >= 2) {
            if (__builtin_amdgcn_readfirstlane((int)threadIdx.x) >= 256) __builtin_amdgcn_s_setprio(1);
            Frame F = make_frame(); const auto kp_ = ka_fresh(F); unsigned char* const ws_ = KA_WS(kp_);
            if (PHM(8)) dil_combine_all(F, WSP(bf16, WS_OG), WSP(float, WS_LSEG), WSP(bf16, WS_MIX));
            for (int rep3_ = 0; rep3_ < NREP(16); ++rep3_) if (PHM(16)) mem_attn_all(F, WSP(bf16, WS_PROJ), WSP(bf16, WS_MEMKV) + (size_t)l * MEMROWS * MKVW, WSP(bf16, WS_MIX));
            asm volatile("s_waitcnt vmcnt(0) lgkmcnt(0)" ::: "memory"); __syncthreads();
        }
        if (l >= 2) SEAM(pb + 2);
        if (PHM(32) && IN(pb + 3)) {
            Frame F = make_frame(); const auto kp_ = ka_fresh(F); unsigned char* const ws_ = KA_WS(kp_);
            pg8::Gemm g{WSP(pg8::bf16_t, WS_MIX), WSP(pg8::bf16_t, WS_WOUT) + (size_t)l * DM * DM, TT, DM, DM};
            pg8::EpiRes E{WSP(pg8::bf16_t, WS_XB), WSP(float, WS_SS), DM};
            pg8::StaticOrder S; S.init(TT, DM, F.G, F.bx);
            pg8::gemm_phase<pg8::EpiRes, pg8::StaticOrder, true, true>(F.lds + RING_OFF, g, S, E);
            __syncthreads();
        }
        SEAM(pb + 3);
        if (PHM(64) && IN(pb + 4)) {
            Frame F = make_frame(); const auto kp_ = ka_fresh(F); unsigned char* const ws_ = KA_WS(kp_);
            pg8::Gemm g{WSP(pg8::bf16_t, WS_XB), WSP(pg8::bf16_t, WS_WPQ) + (size_t)l * PQW * DM, TT, PQW, DM};
            pg8::EpiScaleRow E{WSP(pg8::bf16_t, WS_PROJ), PQW, WSP(float, WS_SS), EPS};
            pg8::StaticOrder S; S.init(TT, PQW, F.G, F.bx);
            for (int rep_ = 0; rep_ < NREP(64); ++rep_) {
            pg8::gemm_phase<pg8::EpiScaleRow, pg8::StaticOrder, true, true>(F.lds + RING_OFF, g, S, E);
            __syncthreads(); }
        }
        SEAM(pb + 4);
        if (PHM(128) && IN(pb + 5)) { if (__builtin_amdgcn_readfirstlane((int)threadIdx.x) >= 256) __builtin_amdgcn_s_setprio(1); Frame F = make_frame(); peer_phase(F, l); }
        SEAM(pb + 5);
    }
#undef IN
#undef SEAM
}

#ifndef HYB_N_LAUNCHES
#define HYB_N_LAUNCHES 1
#endif
extern "C" void kernel_launch(void* const* d_in, const int* in_sizes, int n_in, void* d_out, int out_size, void* d_ws, size_t ws_size, hipStream_t stream) {
    static int grid = 0;
    if (grid == 0) {
        if (n_in != 18 || out_size != TT * DM || ws_size < WS_END) { fprintf(stderr, "kernel_launch: unexpected shapes (n_in %d, out %d, ws %zu)\n", n_in, out_size, ws_size); grid = -1; return; }
        int dev = 0, cus = 0, per_cu = 0;
        if (hipGetDevice(&dev) != hipSuccess || hipDeviceGetAttribute(&cus, hipDeviceAttributeMultiprocessorCount, dev) != hipSuccess) { grid = -1; return; }
        if (hipFuncSetAttribute((const void*)hyb_fwd, hipFuncAttributeMaxDynamicSharedMemorySize, LDS_BYTES) != hipSuccess) { fprintf(stderr, "kernel_launch: hipFuncSetAttribute failed\n"); grid = -1; return; }
        if (hipOccupancyMaxActiveBlocksPerMultiprocessor(&per_cu, (const void*)hyb_fwd, NWAVES * 64, LDS_BYTES) != hipSuccess || per_cu < 1) { fprintf(stderr, "kernel_launch: occupancy query says %d\n", per_cu); }
        (void)hipGetLastError();
        grid = cus;
    }
    if (grid < 0) return;
    (void)hipMemsetAsync((char*)d_ws + WS_CTL, 0, CTL_ZERO_BYTES, stream);
    Args a{};
    for (int i = 0; i < 18; ++i) a.in[i] = (const float*)d_in[i];
    a.out = (float*)d_out; a.ws = (unsigned char*)d_ws;
    if (HYB_N_LAUNCHES == 1) { a.ph_lo = 0; a.ph_hi = NPHASE; hipLaunchKernelGGL(hyb_fwd, dim3(grid), dim3(NWAVES * 64), LDS_BYTES, stream, a); }
    else { for (int p = 0; p < NPHASE; ++p) { a.ph_lo = p; a.ph_hi = p + 1; hipLaunchKernelGGL(hyb_fwd, dim3(grid), dim3(NWAVES * 64), LDS_BYTES, stream, a); } }
}
```

```cpp
#include <hip/hip_runtime.h>
#include <cstdio>
#include <cstdint>
#include <cmath>
template <int CTRL> __device__ __forceinline__ float dpp_addc(float v) { return v + __uint_as_float((unsigned)__builtin_amdgcn_update_dpp(0, (int)__float_as_uint(v), CTRL, 0xf, 0xf, true)); }
template <int CTRL> __device__ __forceinline__ float dpp_maxc(float v) { return __builtin_fmaxf(v, __uint_as_float((unsigned)__builtin_amdgcn_update_dpp(0, (int)__float_as_uint(v), CTRL, 0xf, 0xf, true))); }
__device__ __forceinline__ float xor16_sum(float v) { auto r = __builtin_amdgcn_permlane16_swap(__float_as_uint(v), __float_as_uint(v), false, false); return __uint_as_float(r[0]) + __uint_as_float(r[1]); }
__device__ __forceinline__ float xor32_sum(float v) { auto r = __builtin_amdgcn_permlane32_swap(__float_as_uint(v), __float_as_uint(v), false, false); return __uint_as_float(r[0]) + __uint_as_float(r[1]); }
__device__ __forceinline__ float xor16_get(float v, bool odd_row) { auto r = __builtin_amdgcn_permlane16_swap(__float_as_uint(v), __float_as_uint(v), false, false); return __uint_as_float(odd_row ? r[0] : r[1]); }
__device__ __forceinline__ float row16_sum(float v) { v = dpp_addc<0xB1>(v); v = dpp_addc<0x4E>(v); v = dpp_addc<0x141>(v); return dpp_addc<0x140>(v); }
__device__ __forceinline__ float half32_sum(float v) { return xor16_sum(row16_sum(v)); }
__device__ __forceinline__ float wave_sum_valu(float v) { return xor32_sum(half32_sum(v)); }
__device__ __forceinline__ float wave_max_valu(float v) {
    v = dpp_maxc<0xB1>(v); v = dpp_maxc<0x4E>(v); v = dpp_maxc<0x141>(v); v = dpp_maxc<0x140>(v);
    { auto r = __builtin_amdgcn_permlane16_swap(__float_as_uint(v), __float_as_uint(v), false, false); v = __builtin_fmaxf(__uint_as_float(r[0]), __uint_as_float(r[1])); }
    { auto r = __builtin_amdgcn_permlane32_swap(__float_as_uint(v), __float_as_uint(v), false, false); v = __builtin_fmaxf(__uint_as_float(r[0]), __uint_as_float(r[1])); }
    return v;
}
namespace pg8 {
#define PG8_LAS __attribute__((address_space(3)))
typedef unsigned short bf16_t;
typedef short bf16x8 __attribute__((ext_vector_type(8)));
typedef float f32x4 __attribute__((ext_vector_type(4)));
typedef unsigned u32x4 __attribute__((ext_vector_type(4)));
constexpr int BM = 256, BK = 64, HALF = 128, HTB = HALF * BK * 2  , STAGE_BYTES = 8 * HTB, NXCD = 8, WGM = 8;

__host__ __device__ __forceinline__ int lds_byte(int r, int c) { const int st = (r >> 4) * 2 + (c >> 5), rr = r & 15, cc = c & 31, ob = rr * 64 + cc * 2; return st * 1024 + (ob ^ (((ob >> 9) & 1) << 5)); }
__host__ __device__ __forceinline__ void stage_rc(int b, int& R, int& C) { const int st = b / 1024, sb = b % 1024, swz = sb ^ (((sb >> 9) & 1) << 5); R = (st >> 1) * 16 + swz / 64; C = (st & 1) * 32 + (swz % 64) / 2; }
__host__ __device__ __forceinline__ int perm32(int rho) { const int n = rho >> 4, i = rho & 15; return 8 * (i >> 2) + 4 * n + (i & 3); }

struct Unit { int pm, pn; };
struct Gemm { const bf16_t* A; const bf16_t* Bt; int M, N, K; };

struct StaticOrder {
    int nM, nN, nwg, G, c;
    __host__ __device__ void init(int M, int N, int G_, int c_) { nM = M / BM; nN = N / BM; nwg = nM * nN; G = G_; c = c_; }
    __host__ __device__ bool next(int i, Unit& u) const {
        const long L = (long)i * G + c; if (L >= nwg) return false;
        int wgid = (int)L; { const int q = nwg / NXCD, r = nwg % NXCD, xcd = wgid % NXCD, off = wgid / NXCD; wgid = (xcd < r ? xcd * (q + 1) : r * (q + 1) + (xcd - r) * q) + off; }
        const int nig = WGM * nN, gid = wgid / nig, fm = gid * WGM, gsz = (nM - fm) < WGM ? (nM - fm) : WGM;
        u.pm = fm + ((wgid % nig) % gsz); u.pn = (wgid % nig) / gsz; return true;
    }
    __device__ __forceinline__ void a_ready(const Unit&) const {}
    __device__ __forceinline__ void done(const Unit&) const {}
};

__device__ __forceinline__ unsigned cvt_pk_bf16(float lo, float hi) { unsigned r; asm volatile("v_cvt_pk_bf16_f32 %0, %1, %2" : "=v"(r) : "v"(lo), "v"(hi)); return r; }
typedef float f32x2 __attribute__((ext_vector_type(2)));
__device__ __forceinline__ f32x2 gelu_pk(f32x2 v) {
    const f32x2 av = __builtin_elementwise_abs(v), d = av * 0.2316418882f + 1.0f;
    f32x2 t; t.x = __builtin_amdgcn_rcpf(d.x); t.y = __builtin_amdgcn_rcpf(d.y);
    f32x2 q = t * 0.5307027145f + (-0.7265760135f); q = q * t + 0.7107068705f; q = q * t + (-0.142248368f); q = q * t + 0.127414796f; q = q * t;
    const f32x2 s = (v * v) * (-0.72134752044f);
    f32x2 e; e.x = __builtin_amdgcn_exp2f(s.x); e.y = __builtin_amdgcn_exp2f(s.y);
    const f32x2 m = v * (q * e), r = v - m;
    f32x2 o; o.x = v.x < 0.f ? m.x : r.x; o.y = v.y < 0.f ? m.y : r.y; return o;
}


struct EpiProj {
    static constexpr bool PERM = true, AFTER_DRAIN = false;
    bf16_t* O; int ldc; const float* rope; int rope_lim, scale_lim, scale_tile; float sc; int hm; size_t hs;
    __device__ __forceinline__ void operator()(const f32x4 (&acc)[2][2][4][2], const Unit& u, int wr, int wc, int fr, int fq) const {
        const int row0 = u.pm * BM + wr * 64 + fr, col0 = u.pn * BM + wc * 32 + 8 * fq;
        const bool do_rope = (u.pn < rope_lim) && ((wc & 1) == 0);
        const float s = (u.pn < scale_lim || u.pn == scale_tile) ? sc : 1.f;
        const float sg = (fq == 0) ? -1.f : 1.f;
#pragma unroll
        for (int ai = 0; ai < 2; ++ai)
#pragma unroll
            for (int m = 0; m < 4; ++m) {
                const int row = row0 + ai * HALF + m * 16;
                f32x4 c0 = {1.f, 1.f, 1.f, 1.f}, c1 = c0, s0 = {0.f, 0.f, 0.f, 0.f}, s1 = s0;
                if (do_rope) { const f32x4* rp = (const f32x4*)(rope + (size_t)(row & 4095) * 16); c0 = rp[0]; c1 = rp[1]; s0 = rp[2]; s1 = rp[3]; }
                bf16_t* rowp = hm ? O + ((size_t)(row >> 12) * hm + (col0 >> 6)) * hs + (size_t)(row & 4095) * 64 + (col0 & 63) : O + (size_t)row * ldc + col0;
                const size_t bjstep = hm ? 2 * hs : (size_t)HALF;
#pragma unroll
                for (int bj = 0; bj < 2; ++bj) {
                    f32x4 v0 = acc[ai][bj][m][0], v1 = acc[ai][bj][m][1];
                    if (do_rope) {
                        f32x4 p0, p1;
#pragma unroll
                        for (int j = 0; j < 4; ++j) { p0[j] = xor16_get(v0[j], (fq & 1) != 0); p1[j] = xor16_get(v1[j], (fq & 1) != 0); }
                        if (fq < 2) { v0 = v0 * c0 + (p0 * s0) * sg; v1 = v1 * c1 + (p1 * s1) * sg; }
                    }
                    v0 = v0 * s; v1 = v1 * s;
                    u32x4 w; w.x = cvt_pk_bf16(v0[0], v0[1]); w.y = cvt_pk_bf16(v0[2], v0[3]); w.z = cvt_pk_bf16(v1[0], v1[1]); w.w = cvt_pk_bf16(v1[2], v1[3]);
                    *(u32x4*)(rowp + bj * bjstep) = w;
                }
            }
    }
};
struct EpiRes {
    static constexpr bool PERM = true, AFTER_DRAIN = false;
    bf16_t* XR; float* SS; int ldc;
    __device__ __forceinline__ void operator()(const f32x4 (&acc)[2][2][4][2], const Unit& u, int wr, int wc, int fr, int fq) const {
        const int row0 = u.pm * BM + wr * 64 + fr, col0 = u.pn * BM + wc * 32 + 8 * fq;
#pragma unroll
        for (int ai = 0; ai < 2; ++ai)
#pragma unroll
            for (int m = 0; m < 4; ++m) {
                const int row = row0 + ai * HALF + m * 16;
                float q = 0.f;
#pragma unroll
                for (int bj = 0; bj < 2; ++bj) {
                    bf16_t* xp = XR + (size_t)row * ldc + col0 + bj * HALF;
                    const u32x4 xw = *(const u32x4*)xp;
                    f32x4 x0 = {__uint_as_float(xw.x << 16), __uint_as_float(xw.x & 0xffff0000u), __uint_as_float(xw.y << 16), __uint_as_float(xw.y & 0xffff0000u)};
                    f32x4 x1 = {__uint_as_float(xw.z << 16), __uint_as_float(xw.z & 0xffff0000u), __uint_as_float(xw.w << 16), __uint_as_float(xw.w & 0xffff0000u)};
                    x0 = x0 + acc[ai][bj][m][0]; x1 = x1 + acc[ai][bj][m][1];
                    u32x4 w; w.x = cvt_pk_bf16(x0[0], x0[1]); w.y = cvt_pk_bf16(x0[2], x0[3]); w.z = cvt_pk_bf16(x1[0], x1[1]); w.w = cvt_pk_bf16(x1[2], x1[3]);
                    *(u32x4*)xp = w;
                    q += (x0[0] * x0[0] + x0[1] * x0[1]) + (x0[2] * x0[2] + x0[3] * x0[3]) + (x1[0] * x1[0] + x1[1] * x1[1]) + (x1[2] * x1[2] + x1[3] * x1[3]);
                }
                q = xor32_sum(xor16_sum(q));
                if (fq == 0) SS[(size_t)row * 16 + u.pn * 4 + wc] = q;
            }
    }
};
struct EpiScaleRow {
    static constexpr bool PERM = true, AFTER_DRAIN = false;
    bf16_t* O; int ldc; const float* SS; float eps;
    __device__ __forceinline__ void operator()(const f32x4 (&acc)[2][2][4][2], const Unit& u, int wr, int wc, int fr, int fq) const {
        const int row0 = u.pm * BM + wr * 64 + fr, col0 = u.pn * BM + wc * 32 + 8 * fq;
#pragma unroll
        for (int ai = 0; ai < 2; ++ai)
#pragma unroll
            for (int m = 0; m < 4; ++m) {
                const int row = row0 + ai * HALF + m * 16;
                const f32x4* sp = (const f32x4*)(SS + (size_t)row * 16);
                const f32x4 a = sp[0], b = sp[1], c = sp[2], d = sp[3];
                const float tot = (((a[0] + a[1]) + (a[2] + a[3])) + ((b[0] + b[1]) + (b[2] + b[3]))) + (((c[0] + c[1]) + (c[2] + c[3])) + ((d[0] + d[1]) + (d[2] + d[3])));
                const float rs = 1.0f / sqrtf(tot * (1.0f / 1024.0f) + eps);
                bf16_t* rowp = O + (size_t)row * ldc + col0;
#pragma unroll
                for (int bj = 0; bj < 2; ++bj) {
                    const f32x4 v0 = acc[ai][bj][m][0] * rs, v1 = acc[ai][bj][m][1] * rs;
                    u32x4 w; w.x = cvt_pk_bf16(v0[0], v0[1]); w.y = cvt_pk_bf16(v0[2], v0[3]); w.z = cvt_pk_bf16(v1[0], v1[1]); w.w = cvt_pk_bf16(v1[2], v1[3]);
                    *(u32x4*)(rowp + bj * HALF) = w;
                }
            }
    }
};

template <class Epi, class Sched, bool ALIGN_EPI = false, bool SP2 = false>
__device__ __forceinline__ void gemm_phase(PG8_LAS unsigned char* lds, const Gemm g, const Sched& S, const Epi& E) {
    int tid_ = threadIdx.x; asm volatile("" : "+v"(tid_));
    const int tid = tid_, wid = __builtin_amdgcn_readfirstlane(tid >> 6), lane = tid & 63, wr = wid >> 2, wc = wid & 3, fr = lane & 15, fq = lane >> 4;
    const int K = g.K, nt = K / BK;
    unsigned voffA[2], voffB[2];
#pragma unroll
    for (int i = 0; i < 2; ++i) { int R, C; stage_rc(tid * 16 + i * 8192, R, C); const int Rb = Epi::PERM ? ((R & ~31) + perm32(R & 31)) : R;
        voffA[i] = (unsigned)(R * K + C) * 2u; voffB[i] = (unsigned)(Rb * K + C) * 2u; }
    const size_t kstep = (size_t)(BK * 2);
    const size_t hstep = (size_t)HALF * K * 2;
    const size_t tstep = 2 * hstep;
    const unsigned ldsw = (unsigned)wid * 1024u;
    const int aoff = lds_byte(wr * 64 + fr, fq * 8), boff = lds_byte(wc * 32 + fr, fq * 8);
#define PG8_SA(b, h) (((b) * 2 + (h)) * HTB)
#define PG8_SB(b, h) ((4 + (b) * 2 + (h)) * HTB)
#define PG8_STAGE(bufoff, gbase, voff) do { _Pragma("unroll") for (int _i = 0; _i < 2; ++_i) \
        __builtin_amdgcn_global_load_lds((const unsigned*)((const char*)(gbase) + (voff)[_i]), (PG8_LAS unsigned*)(lds + (bufoff) + ldsw + _i * 8192), 16, 0, 0); } while (0)
#define PG8_LDA(dst, b, h) do { _Pragma("unroll") for (int m = 0; m < 4; ++m) _Pragma("unroll") for (int k = 0; k < 2; ++k) dst[m][k] = *(const PG8_LAS bf16x8*)(lds + PG8_SA(b, h) + aoff + m * 2048 + k * 1024); } while (0)
#define PG8_LDB(dst, b, h) do { _Pragma("unroll") for (int n = 0; n < 2; ++n) _Pragma("unroll") for (int k = 0; k < 2; ++k) dst[n][k] = *(const PG8_LAS bf16x8*)(lds + PG8_SB(b, h) + boff + n * 2048 + k * 1024); } while (0)
#define PG8_MMA(ai, bj, At, Bt) do { __builtin_amdgcn_s_setprio(1); _Pragma("unroll") for (int m = 0; m < 4; ++m) _Pragma("unroll") for (int n = 0; n < 2; ++n) _Pragma("unroll") for (int k = 0; k < 2; ++k) \
        acc[ai][bj][m][n] = __builtin_amdgcn_mfma_f32_16x16x32_bf16(Bt[n][k], At[m][k], acc[ai][bj][m][n], 0, 0, 0); __builtin_amdgcn_s_setprio(0); } while (0)
#define PG8_WAIT_V(n) asm volatile("s_waitcnt vmcnt(" #n ")" ::: "memory")
#define PG8_WAIT_L(n) asm volatile("s_waitcnt lgkmcnt(" #n ")" ::: "memory")
#define PG8_BAR __builtin_amdgcn_s_barrier()
#define PG8_SCHED __builtin_amdgcn_sched_barrier(0)
    Unit cur, nxt; int ui = 0;
    if (!S.next(0, cur)) return;
    f32x4 acc[2][2][4][2];
#pragma unroll
    for (int a = 0; a < 2; ++a)
#pragma unroll
        for (int b = 0; b < 2; ++b)
#pragma unroll
            for (int m = 0; m < 4; ++m)
#pragma unroll
                for (int n = 0; n < 2; ++n) acc[a][b][m][n] = (f32x4){0.f, 0.f, 0.f, 0.f};
    bf16x8 At[4][2], B0[2][2], B1[2][2];
    const char* cA = (const char*)g.A + (size_t)cur.pm * tstep; const char* cB = (const char*)g.Bt + (size_t)cur.pn * tstep;
    S.a_ready(cur);
    if constexpr (SP2) {
        PG8_STAGE(PG8_SB(0, 0), cB, voffB); PG8_STAGE(PG8_SB(0, 1), cB + hstep, voffB); PG8_STAGE(PG8_SA(0, 0), cA, voffA); PG8_STAGE(PG8_SA(0, 1), cA + hstep, voffA);
        if (wr == 1) PG8_BAR;
        PG8_WAIT_V(2); PG8_BAR;
        PG8_STAGE(PG8_SB(1, 0), cB + kstep, voffB); PG8_STAGE(PG8_SA(1, 0), cA + kstep, voffA); PG8_STAGE(PG8_SB(1, 1), cB + hstep + kstep, voffB);
        PG8_WAIT_V(6); PG8_BAR;
    } else {
        PG8_STAGE(PG8_SB(0, 0), cB, voffB); PG8_STAGE(PG8_SA(0, 0), cA, voffA); PG8_STAGE(PG8_SB(0, 1), cB + hstep, voffB); PG8_STAGE(PG8_SA(0, 1), cA + hstep, voffA);
        if (wr == 1) PG8_BAR;
        PG8_WAIT_V(4); PG8_BAR;
        PG8_STAGE(PG8_SB(1, 0), cB + kstep, voffB); PG8_STAGE(PG8_SA(1, 0), cA + kstep, voffA); PG8_STAGE(PG8_SB(1, 1), cB + hstep + kstep, voffB);
        PG8_WAIT_V(6); PG8_BAR;
    }
    for (;;) {
        const bool has_next = S.next(ui + 1, nxt);
        const char* nA = has_next ? (const char*)g.A + (size_t)nxt.pm * tstep : cA; const char* nB = has_next ? (const char*)g.Bt + (size_t)nxt.pn * tstep : cB;
        for (int t = 0; t < nt; t += 2) {
            const bool last = (t == nt - 2);
            const char* a1 = cA + (size_t)(t + 1) * kstep;
            const char* a2 = last ? nA : cA + (size_t)(t + 2) * kstep; const char* b2 = last ? nB : cB + (size_t)(t + 2) * kstep;
            const char* a3 = a2 + kstep; const char* b3 = b2 + kstep;
            if (last && has_next) S.a_ready(nxt);
            if constexpr (SP2) {
            PG8_LDB(B0, 0, 0); PG8_LDB(B1, 0, 1); PG8_SCHED; PG8_LDA(At, 0, 0); PG8_STAGE(PG8_SA(1, 1), a1 + hstep, voffA);
            PG8_WAIT_V(8); PG8_WAIT_L(0); PG8_BAR; PG8_MMA(0, 0, At, B0); PG8_MMA(0, 1, At, B1); PG8_BAR; PG8_SCHED;
            PG8_LDA(At, 0, 1); PG8_STAGE(PG8_SB(0, 0), b2, voffB); PG8_STAGE(PG8_SB(0, 1), b2 + hstep, voffB); PG8_STAGE(PG8_SA(0, 0), a2, voffA);
            PG8_WAIT_V(8); PG8_WAIT_L(0); PG8_BAR; PG8_MMA(1, 0, At, B0); PG8_MMA(1, 1, At, B1); PG8_BAR; PG8_SCHED;
            PG8_LDB(B0, 1, 0); PG8_LDB(B1, 1, 1); PG8_SCHED; PG8_LDA(At, 1, 0); PG8_STAGE(PG8_SA(0, 1), a2 + hstep, voffA);
            PG8_WAIT_V(8); PG8_WAIT_L(0); PG8_BAR; PG8_MMA(0, 0, At, B0); PG8_MMA(0, 1, At, B1); PG8_BAR; PG8_SCHED;
            PG8_LDA(At, 1, 1); PG8_STAGE(PG8_SB(1, 0), b3, voffB); PG8_STAGE(PG8_SB(1, 1), b3 + hstep, voffB); PG8_STAGE(PG8_SA(1, 0), a3, voffA);
            PG8_WAIT_V(8); PG8_WAIT_L(0); PG8_BAR; PG8_MMA(1, 0, At, B0); PG8_MMA(1, 1, At, B1); PG8_BAR; PG8_SCHED;
            } else {
            PG8_LDB(B0, 0, 0); PG8_SCHED; PG8_LDA(At, 0, 0); PG8_STAGE(PG8_SA(1, 1), a1 + hstep, voffA);
            PG8_WAIT_L(8); PG8_BAR; PG8_WAIT_L(0); PG8_MMA(0, 0, At, B0); PG8_BAR; PG8_SCHED;
            PG8_LDB(B1, 0, 1); PG8_STAGE(PG8_SB(0, 0), b2, voffB);
            PG8_BAR; PG8_WAIT_L(0); PG8_MMA(0, 1, At, B1); PG8_BAR;
            PG8_LDA(At, 0, 1); PG8_STAGE(PG8_SA(0, 0), a2, voffA);
            PG8_BAR; PG8_WAIT_L(0); PG8_MMA(1, 0, At, B0); PG8_BAR; PG8_SCHED;
            PG8_STAGE(PG8_SB(0, 1), b2 + hstep, voffB);
            PG8_WAIT_V(6); PG8_BAR; PG8_MMA(1, 1, At, B1); PG8_BAR;
            PG8_LDB(B0, 1, 0); PG8_SCHED; PG8_LDA(At, 1, 0); PG8_STAGE(PG8_SA(0, 1), a2 + hstep, voffA);
            PG8_WAIT_L(8); PG8_BAR; PG8_WAIT_L(0); PG8_MMA(0, 0, At, B0); PG8_BAR; PG8_SCHED;
            PG8_LDB(B1, 1, 1); PG8_STAGE(PG8_SB(1, 0), b3, voffB);
            PG8_BAR; PG8_WAIT_L(0); PG8_MMA(0, 1, At, B1); PG8_BAR;
            PG8_LDA(At, 1, 1); PG8_STAGE(PG8_SA(1, 0), a3, voffA);
            PG8_BAR; PG8_WAIT_L(0); PG8_MMA(1, 0, At, B0); PG8_BAR; PG8_SCHED;
            PG8_STAGE(PG8_SB(1, 1), b3 + hstep, voffB);
            PG8_WAIT_V(6); PG8_BAR; PG8_MMA(1, 1, At, B1); PG8_BAR;
            }
        }
        if constexpr (ALIGN_EPI) { if (wr == 0) PG8_BAR; }
        if constexpr (!Epi::AFTER_DRAIN) { E(acc, cur, wr, wc, fr, fq); S.done(cur); }
        if (!has_next) break;
#pragma unroll
        for (int a = 0; a < 2; ++a)
#pragma unroll
            for (int b = 0; b < 2; ++b)
#pragma unroll
                for (int m = 0; m < 4; ++m)
#pragma unroll
                    for (int n = 0; n < 2; ++n) acc[a][b][m][n] = (f32x4){0.f, 0.f, 0.f, 0.f};
        cur = nxt; cA = nA; cB = nB; ++ui;
        if constexpr (ALIGN_EPI) { if (wr == 1) PG8_BAR; }
    }
    PG8_WAIT_V(0);
    if constexpr (!ALIGN_EPI) { if (wr == 0) PG8_BAR; }
    PG8_BAR;
    if constexpr (Epi::AFTER_DRAIN) { E.fused(acc, cur, wr, wc, fr, fq, lds, wid, lane); S.done(cur); }
#undef PG8_SA
#undef PG8_SB
#undef PG8_STAGE
#undef PG8_LDA
#undef PG8_LDB
#undef PG8_MMA
#undef PG8_WAIT_V
#undef PG8_WAIT_L
#undef PG8_BAR
#undef PG8_SCHED
}
}
#define GAS __attribute__((address_space(1)))
#define LAS __attribute__((address_space(3)))
typedef unsigned short bf16;
typedef unsigned v4u __attribute__((ext_vector_type(4)));
typedef float f32x4 __attribute__((ext_vector_type(4)));
typedef short bf16x8 __attribute__((ext_vector_type(8)));
typedef GAS unsigned gu32;
typedef GAS unsigned long long gu64;
#define RLX_AGENT __ATOMIC_RELAXED, __HIP_MEMORY_SCOPE_AGENT
#define LDS_WAIT() asm volatile("s_waitcnt lgkmcnt(0)" ::: "memory")
#define VM_WAIT() asm volatile("s_waitcnt vmcnt(0)" ::: "memory")
__device__ __forceinline__ unsigned long long rt() { return __builtin_amdgcn_s_memrealtime(); }
__device__ __forceinline__ unsigned f2bf(float f) { unsigned u = __builtin_bit_cast(unsigned, f); return (u + 0x7fffu + ((u >> 16) & 1u)) >> 16; }
__device__ __forceinline__ unsigned pk2(float lo, float hi) { return f2bf(lo) | (f2bf(hi) << 16); }

namespace att {
typedef __attribute__((address_space(3))) const char* lds_cptr;
typedef __attribute__((address_space(3))) char* lds_ptr;
typedef __attribute__((address_space(3))) float* lds_fptr;
using s16x4 = __attribute__((ext_vector_type(4))) short;
using f32x16 = __attribute__((ext_vector_type(16))) float;
using u32x4 = __attribute__((ext_vector_type(4))) unsigned;
typedef short v4i16_t __attribute__((ext_vector_type(4)));
typedef float f32x2_t __attribute__((ext_vector_type(2))); typedef __bf16 bf16x2_t __attribute__((ext_vector_type(2)));
constexpr float C2 = 0.125f * 1.4426950408889634f;
__device__ __forceinline__ int crow(int r, int hi) { return (r & 3) + 8 * (r >> 2) + 4 * hi; }
__device__ __forceinline__ unsigned cvtpk_s(float lo, float hi) { f32x2_t v = {lo, hi}; bf16x2_t b = __builtin_convertvector(v, bf16x2_t); return __builtin_bit_cast(unsigned, b); }
__device__ __forceinline__ void glds16(const void* gsrc, unsigned lds_dst) { unsigned keep;
    asm volatile("s_mov_b32 %0, m0\n\ts_mov_b32 m0, %2\n\ts_nop 0\n\tglobal_load_lds_dwordx4 %1, off\n\ts_mov_b32 m0, %0" : "=&s"(keep) : "v"(gsrc), "s"(lds_dst) : "memory"); }
#define ATT_WAITV(N) asm volatile("s_waitcnt vmcnt(" #N ")" ::: "memory")
#define ATT_WAITL() asm volatile("s_waitcnt lgkmcnt(0)" ::: "memory")
#define ATT_BAR() asm volatile("s_waitcnt lgkmcnt(0)\n\ts_barrier" ::: "memory")
__device__ __forceinline__ s16x4 vtr(lds_cptr p) { return __builtin_bit_cast(s16x4, __builtin_amdgcn_ds_read_tr16_b64_v4i16((__attribute__((address_space(3))) v4i16_t*)p)); }

__device__ __forceinline__ int kswz(int row) { return (((row >> 1) & 1) << 2) | ((row >> 2) & 3); }
__device__ __forceinline__ void kread_offs(int (&ko)[4], int r32, int hi) {
#pragma unroll
    for (int d0 = 0; d0 < 4; ++d0) ko[d0] = r32 * 128 + (((2 * d0 + hi) ^ kswz(r32)) << 4);
}
__device__ __forceinline__ void qkt(f32x16& p0, f32x16& p1, lds_cptr kslot, const bf16x8* qr, const int (&ko)[4], float cinit) {
    f32x16 z;
#pragma unroll
    for (int r = 0; r < 16; ++r) z[r] = cinit;
    bf16x8 kf[8];
#pragma unroll
    for (int d0 = 0; d0 < 4; ++d0) { kf[2 * d0] = *(const __attribute__((address_space(3))) bf16x8*)(kslot + ko[d0]); kf[2 * d0 + 1] = *(const __attribute__((address_space(3))) bf16x8*)(kslot + ko[d0] + 4096); }
    __builtin_amdgcn_sched_barrier(0);
#pragma unroll
    for (int d0 = 0; d0 < 4; ++d0) {
        if (d0 == 0) { p0 = __builtin_amdgcn_mfma_f32_32x32x16_bf16(kf[0], qr[0], z, 0, 0, 0); p1 = __builtin_amdgcn_mfma_f32_32x32x16_bf16(kf[1], qr[0], z, 0, 0, 0); }
        else { p0 = __builtin_amdgcn_mfma_f32_32x32x16_bf16(kf[2 * d0], qr[d0], p0, 0, 0, 0); p1 = __builtin_amdgcn_mfma_f32_32x32x16_bf16(kf[2 * d0 + 1], qr[d0], p1, 0, 0, 0); }
    }
}
__device__ __forceinline__ int rowmax_bits(const f32x16& p0, const f32x16& p1) {
    int a, b;
    { const float f0 = p0[0], f1 = p1[0]; a = __float_as_int(f0); b = __float_as_int(f1); }
#pragma unroll
    for (int r = 1; r < 16; ++r) { const float f0 = p0[r], f1 = p1[r]; const int x = __float_as_int(f0), y = __float_as_int(f1); a = a > x ? a : x; b = b > y ? b : y; }
    const int m = a > b ? a : b;
    auto rr = __builtin_amdgcn_permlane32_swap((unsigned)m, (unsigned)m, false, false);
    return (int)rr[0] > (int)rr[1] ? (int)rr[0] : (int)rr[1];
}
__device__ __forceinline__ float rowmax(const f32x16& p0, const f32x16& p1) {
    float a = __builtin_fmaxf(p0[0], p1[0]), b = __builtin_fmaxf(p0[1], p1[1]);
#pragma unroll
    for (int r = 2; r < 16; r += 2) { a = __builtin_fmaxf(a, __builtin_fmaxf(p0[r], p1[r])); b = __builtin_fmaxf(b, __builtin_fmaxf(p0[r + 1], p1[r + 1])); }
    const float m = __builtin_fmaxf(a, b);
    auto rr = __builtin_amdgcn_permlane32_swap(__float_as_uint(m), __float_as_uint(m), false, false);
    return __builtin_fmaxf(__uint_as_float(rr[0]), __uint_as_float(rr[1]));
}
__device__ __forceinline__ float halfsum(float v) {
    auto rr = __builtin_amdgcn_permlane32_swap(__float_as_uint(v), __float_as_uint(v), false, false);
    return __uint_as_float(rr[0]) + __uint_as_float(rr[1]);
}
template <int NDB> __device__ __forceinline__ void vread_offs(int (&vo)[NDB][2], int lane) {
    const int hi = lane >> 5, g1 = (lane >> 4) & 1, q = (lane & 15) >> 2, p = lane & 3, cl = 2 * g1 + (p >> 1);
#pragma unroll
    for (int d0 = 0; d0 < NDB; ++d0)
#pragma unroll
        for (int h8 = 0; h8 < 2; ++h8) {
            const int row = 8 * h8 + 4 * hi + q, c = 4 * d0 + cl;
            if (NDB == 2) vo[d0][h8] = row * 128 + ((c ^ kswz(row)) << 4) + 8 * (p & 1);
            else vo[d0][h8] = row * 256 + ((c ^ ((row & 3) << 2)) << 4) + 8 * (p & 1);
        }
}
constexpr float SM_THR = 4.0f;
template <int NDB>
__device__ __forceinline__ void softmax_pv(f32x16& p0, f32x16& p1, float& m_run, float& l_run, bool first, f32x16 (&o)[NDB], lds_cptr vslot, const int (&vo)[NDB][2], lds_fptr wsf, int r32, int hi) {
    const int mb = rowmax_bits(p0, p1);
    if (__any(first || mb > __builtin_bit_cast(int, SM_THR))) {
        const float rm = rowmax(p0, p1);
        const float dl = first ? rm : __builtin_fmaxf(rm, 0.f);
        m_run += dl;
#pragma unroll
        for (int r = 0; r < 16; ++r) { p0[r] -= dl; p1[r] -= dl; }
        if (!first) {
            const float alpha = __builtin_amdgcn_exp2f(-dl);
            l_run *= alpha;
            if (hi == 0) wsf[r32] = alpha;
            ATT_WAITL();
#pragma unroll
            for (int g = 0; g < 4; ++g) {
                const f32x4 a4 = *(const __attribute__((address_space(3))) f32x4*)(wsf + 8 * g + 4 * hi);
#pragma unroll
                for (int d = 0; d < NDB; ++d) { o[d][4 * g + 0] *= a4[0]; o[d][4 * g + 1] *= a4[1]; o[d][4 * g + 2] *= a4[2]; o[d][4 * g + 3] *= a4[3]; }
            }
        }
    }
    float s = 0.f;
#pragma unroll
    for (int r = 0; r < 16; ++r) { p0[r] = __builtin_amdgcn_exp2f(p0[r]); p1[r] = __builtin_amdgcn_exp2f(p1[r]); s += p0[r] + p1[r]; }
    l_run += s;
    u32x4 pw[4];
#pragma unroll
    for (int k = 0; k < 2; ++k) { pw[k] = (u32x4){cvtpk_s(p0[8 * k], p0[8 * k + 1]), cvtpk_s(p0[8 * k + 2], p0[8 * k + 3]), cvtpk_s(p0[8 * k + 4], p0[8 * k + 5]), cvtpk_s(p0[8 * k + 6], p0[8 * k + 7])};
        pw[2 + k] = (u32x4){cvtpk_s(p1[8 * k], p1[8 * k + 1]), cvtpk_s(p1[8 * k + 2], p1[8 * k + 3]), cvtpk_s(p1[8 * k + 4], p1[8 * k + 5]), cvtpk_s(p1[8 * k + 6], p1[8 * k + 7])}; }
    s16x4 fa[8], fb[8];
#pragma unroll
    for (int ks = 0; ks < 4; ++ks) { fa[2 * ks] = vtr(vslot + vo[0][0] + ks * (1024 * NDB)); fa[2 * ks + 1] = vtr(vslot + vo[0][1] + ks * (1024 * NDB)); }
#pragma unroll
    for (int d0 = 0; d0 < NDB; ++d0) {
        __builtin_amdgcn_sched_barrier(0);
        if (d0 + 1 < NDB) {
#pragma unroll
            for (int ks = 0; ks < 4; ++ks) { if (d0 & 1) { fa[2 * ks] = vtr(vslot + vo[d0 + 1 < NDB ? d0 + 1 : 0][0] + ks * (1024 * NDB)); fa[2 * ks + 1] = vtr(vslot + vo[d0 + 1 < NDB ? d0 + 1 : 0][1] + ks * (1024 * NDB)); }
                else { fb[2 * ks] = vtr(vslot + vo[d0 + 1 < NDB ? d0 + 1 : 0][0] + ks * (1024 * NDB)); fb[2 * ks + 1] = vtr(vslot + vo[d0 + 1 < NDB ? d0 + 1 : 0][1] + ks * (1024 * NDB)); } }
        }
        __builtin_amdgcn_sched_barrier(0);
#pragma unroll
        for (int ks = 0; ks < 4; ++ks) {
            const s16x4 lo = (d0 & 1) ? fb[2 * ks] : fa[2 * ks], hh = (d0 & 1) ? fb[2 * ks + 1] : fa[2 * ks + 1];
            const bf16x8 vb = (bf16x8){lo[0], lo[1], lo[2], lo[3], hh[0], hh[1], hh[2], hh[3]};
            o[d0] = __builtin_amdgcn_mfma_f32_32x32x16_bf16(__builtin_bit_cast(bf16x8, pw[ks]), vb, o[d0], 0, 0, 0);
        }
    }
}
template <int NDB>
__device__ __forceinline__ void pv_only(f32x16 (&o)[NDB], const u32x4 (&pw)[4], lds_cptr vslot, const int (&vo)[NDB][2]) {
#pragma unroll
    for (int d0 = 0; d0 < NDB; ++d0)
#pragma unroll
        for (int ks = 0; ks < 4; ++ks) {
            const s16x4 lo = vtr(vslot + vo[d0][0] + ks * (1024 * NDB)), hh = vtr(vslot + vo[d0][1] + ks * (1024 * NDB));
            const bf16x8 vb = (bf16x8){lo[0], lo[1], lo[2], lo[3], hh[0], hh[1], hh[2], hh[3]};
            o[d0] = __builtin_amdgcn_mfma_f32_32x32x16_bf16(__builtin_bit_cast(bf16x8, pw[ks]), vb, o[d0], 0, 0, 0);
        }
}
template <int NDB>
__device__ __forceinline__ float finish_o(float l_run, f32x16 (&o)[NDB], lds_fptr wsf, int r32, int hi) {
    const float l = halfsum(l_run);
    if (hi == 0) wsf[32 + r32] = 1.0f / l;
    ATT_WAITL();
#pragma unroll
    for (int g = 0; g < 4; ++g) {
        const f32x4 a4 = *(const __attribute__((address_space(3))) f32x4*)(wsf + 32 + 8 * g + 4 * hi);
#pragma unroll
        for (int d = 0; d < NDB; ++d) { o[d][4 * g + 0] *= a4[0]; o[d][4 * g + 1] *= a4[1]; o[d][4 * g + 2] *= a4[2]; o[d][4 * g + 3] *= a4[3]; }
    }
    return l;
}
}

constexpr int NWAVES = 8;
constexpr int NB = 8, SEQ = 4096, DM = 1024, TT = NB * SEQ;
constexpr int MEMT = 256, MEMROWS = NB * MEMT;
constexpr int INW = 2560, SKVW = 4608, PQW = 2048, MKVW = 512;
constexpr int NEXP = 16384;
constexpr float EPS = 1e-5f;
constexpr int NPHASE = 25;

constexpr size_t MiB = 1u << 20;
constexpr size_t WS_CTL = 0, CTL_ZERO_BYTES = 1 * MiB;
constexpr size_t WS_WA = 1 * MiB, WS_WB = 11 * MiB, WS_WMKV = 21 * MiB, WS_WOUT = 25 * MiB, WS_WPQ = 33 * MiB, WS_WSKV = 49 * MiB, WS_PKEYS = 58 * MiB, WS_ROPE = 60 * MiB, WS_SS = 61 * MiB, WS_MEMKV = 63 * MiB;
constexpr size_t WS_PU = 96 * MiB, WS_PV = 160 * MiB;
constexpr int PROW = 544;
constexpr size_t WS_XN = 352 * MiB, WS_XB = 416 * MiB, WS_PROJ = 480 * MiB, WS_MIX = 640 * MiB, WS_SKV = 704 * MiB, WS_END = 992 * MiB;
constexpr size_t WS_MEMN = WS_SKV;
constexpr size_t WS_OG = 224 * MiB;
constexpr size_t WS_LSEG = 368 * MiB;
static_assert(WS_OG + (size_t)TT * 2304 * 2 <= WS_LSEG && WS_LSEG + (size_t)TT * 36 * 4 <= WS_XB + 64 * MiB && WS_OG >= WS_PV + 50 * MiB, "OG scratch");
constexpr int CW_BAR = 4096;

constexpr int RING_OFF = 0, RING_BYTES = 131072;
constexpr int LDSCTL_OFF = RING_BYTES, MISC_OFF = LDSCTL_OFF + 320;
constexpr int PEER_SCR = LDSCTL_OFF + 1024;
constexpr int LDS_BYTES = 163840;
static_assert(PEER_SCR + 8 * 2048 <= LDS_BYTES, "LDS map");

#define XB_TMO      128
#define XB_XCNT(j)  (256  + 64 * (j))
#define XB_XSUB(j)  (1280 + 64 * (j))
#define XB_XGEN(j)  (2304 + 64 * (j))
#define XB_TOP      3328
#define XB_TOPGEN   3392
#define XCD_BAR_WORDS 3456
#define XB_SPIN_CAP (1u << 18)

__device__ __forceinline__ unsigned xb_ld(unsigned* p)              { return __hip_atomic_load(p, __ATOMIC_RELAXED, __HIP_MEMORY_SCOPE_AGENT); }
__device__ __forceinline__ unsigned xb_add(unsigned* p, unsigned v) { return __hip_atomic_fetch_add(p, v, __ATOMIC_RELAXED, __HIP_MEMORY_SCOPE_AGENT); }
__device__ __forceinline__ unsigned xb_xcc_id() { return (unsigned)__builtin_amdgcn_s_getreg((3 << 11) | 20) & 0xFu; }
#define XB_SPIN(cond, bar) do { unsigned _sp = 0; while (cond) { __builtin_amdgcn_s_sleep(1); \
    if ((++_sp & 255u) == 0u) { if (xb_ld(&(bar)[XB_TMO])) break; if (_sp > XB_SPIN_CAP) { atomicAdd(&(bar)[XB_TMO], 1u); break; } } } } while (0)

struct XcdBarrier {
    unsigned* bar; unsigned x;
    volatile LAS unsigned* st;
};

__device__ __forceinline__ XcdBarrier xcd_barrier_post(unsigned* bar, volatile LAS unsigned* st) {
    XcdBarrier b; b.bar = bar; b.x = xb_xcc_id(); b.st = st;
    if (threadIdx.x == 0) (void)xb_add(&bar[XB_XCNT(b.x)], 1u);
    return b;
}
__device__ __forceinline__ void xcd_barrier_complete(unsigned* bar, unsigned x, unsigned& nloc, unsigned& nx) {
    const unsigned G = gridDim.x * gridDim.y * gridDim.z;
    unsigned sum, cnt, mine, sp = 0u;
    for (;;) {
        sum = 0u; cnt = 0u; mine = 0u;
#pragma unroll
        for (unsigned j = 0; j < 16; ++j) { const unsigned c = xb_ld(&bar[XB_XCNT(j)]); sum += c; cnt += (c > 0u) ? 1u : 0u; mine = (j == x) ? c : mine; }
        if (sum == G) break;
        __builtin_amdgcn_s_sleep(1);
        if ((++sp & 255u) == 0u) { if (xb_ld(&bar[XB_TMO])) break; if (sp > XB_SPIN_CAP) { atomicAdd(&bar[XB_TMO], 1u); break; } }
    }
    nloc = mine > 0u ? mine : 1u; nx = cnt > 0u ? cnt : 1u;
}

__device__ __forceinline__ void xcd_barrier(const XcdBarrier& b) {
    asm volatile("s_waitcnt vmcnt(0)" ::: "memory");
    __syncthreads();
    if (threadIdx.x == 0) {
        unsigned* bar = b.bar;
        __builtin_amdgcn_s_waitcnt(0);
        unsigned nloc = b.st[0], nx = b.st[1];
        if (nloc == 0u) { xcd_barrier_complete(bar, b.x, nloc, nx); b.st[0] = nloc; b.st[1] = nx; }
        const unsigned old = xb_add(&bar[XB_XSUB(b.x)], 1u);
        const unsigned gen = old / nloc;
        if (old + 1u == (gen + 1u) * nloc) {
            __builtin_amdgcn_fence(__ATOMIC_RELEASE, "agent");
            asm volatile("s_waitcnt vmcnt(0)" ::: "memory");
            const unsigned og = xb_add(&bar[XB_TOP], 1u);
            const unsigned tg = og / nx;
            if (og + 1u == (tg + 1u) * nx) xb_add(&bar[XB_TOPGEN], 1u);
            else XB_SPIN(xb_ld(&bar[XB_TOPGEN]) == tg, bar);
            __builtin_amdgcn_fence(__ATOMIC_ACQUIRE, "agent");
            xb_add(&bar[XB_XGEN(b.x)], 1u);
            asm volatile("s_waitcnt vmcnt(0)" ::: "memory");
        } else {
            XB_SPIN(xb_ld(&bar[XB_XGEN(b.x)]) == gen, bar);
            __builtin_amdgcn_fence(__ATOMIC_ACQUIRE, "agent");
            asm volatile("s_waitcnt vmcnt(0)" ::: "memory");
        }
    }
    __syncthreads();
}

struct Frame {
    LAS unsigned char* lds;
    volatile LAS unsigned* MISC;
    int tid, lane, wave, vcu, G, bx;
    const unsigned char __attribute__((address_space(4)))* ka;
};
__device__ __forceinline__ Frame make_frame() {
    extern __shared__ __attribute__((aligned(16))) unsigned char lds_dyn_[];
    Frame F; int tid = threadIdx.x, bx = blockIdx.x, G = gridDim.x;
    asm volatile("" : "+v"(tid)); asm volatile("" : "+s"(bx), "+s"(G));
    F.lds = (LAS unsigned char*)lds_dyn_; F.MISC = (volatile LAS unsigned*)(F.lds + MISC_OFF);
    F.tid = tid; F.lane = tid & 63; F.wave = __builtin_amdgcn_readfirstlane(tid >> 6);
    F.G = G; F.vcu = (G % 8 == 0) ? (bx % 8) * (G / 8) + bx / 8 : bx; F.bx = bx;
    F.ka = (const unsigned char __attribute__((address_space(4)))*)__builtin_amdgcn_kernarg_segment_ptr();
    return F;
}
__device__ __forceinline__ const unsigned char __attribute__((address_space(4)))* ka_fresh(const Frame& F) { const unsigned char __attribute__((address_space(4)))* p = F.ka; asm volatile("" : "+s"(p)); return p; }
#define KA_IN(kp, i) (*(const float* const __attribute__((address_space(4)))*)((kp) + 8 * (i)))
#define KA_OUT(kp) (*(float* const __attribute__((address_space(4)))*)((kp) + 144))
#define KA_WS(kp) (*(unsigned char* const __attribute__((address_space(4)))*)((kp) + 152))
#define WSP(T, off) ((T*)(ws_ + (off)))
__device__ __forceinline__ float wave_sum(float v) { return wave_sum_valu(v); }
__device__ __forceinline__ unsigned cvtpk(float lo, float hi) { return att::cvtpk_s(lo, hi); }

__device__ __forceinline__ void p0_transpose_item(const float* W, int K, int N, bf16* WT, const float* gain, LAS float* scr, int item, int lane) {
    const int nblk = N / 32, kb = item / nblk, nb = item % nblk, k0 = 64 * kb, n0 = 32 * nb;
#pragma unroll 8
    for (int i = 0; i < 32; ++i) { const int kk = 2 * i + (lane >> 5); float w = W[(size_t)(k0 + kk) * N + n0 + (lane & 31)]; if (gain) w *= gain[k0 + kk]; scr[kk * 33 + (lane & 31)] = w; }
    LDS_WAIT(); asm volatile("" ::: "memory");
    const int c = lane & 7;
#pragma unroll
    for (int j = 0; j < 4; ++j) { const int n = (lane >> 3) + 8 * j; const LAS float* s = scr + (8 * c) * 33 + n;
        v4u o; o.x = cvtpk(s[0 * 33], s[1 * 33]); o.y = cvtpk(s[2 * 33], s[3 * 33]); o.z = cvtpk(s[4 * 33], s[5 * 33]); o.w = cvtpk(s[6 * 33], s[7 * 33]);
        *(GAS v4u*)(WT + (size_t)(n0 + n) * K + k0 + 8 * c) = o; }
    LDS_WAIT(); asm volatile("" ::: "memory");
}
__device__ __forceinline__ void cvt_row(const float* src, bf16* dst, int lane) {
    const GAS f32x4* s = (const GAS f32x4*)src + lane; GAS unsigned long long* d = (GAS unsigned long long*)dst + lane;
    f32x4 v[4];
#pragma unroll
    for (int j = 0; j < 4; ++j) v[j] = s[64 * j];
#pragma unroll
    for (int j = 0; j < 4; ++j) d[64 * j] = (unsigned long long)cvtpk(v[j].x, v[j].y) | ((unsigned long long)cvtpk(v[j].z, v[j].w) << 32);
}
template <bool PERM> __device__ __forceinline__ void cvt_2rows_fp4(const float* src, unsigned char* dst, int lane) {
    const int l = lane & 31, h = lane >> 5;
    const GAS f32x4* s = (const GAS f32x4*)(src + (size_t)h * DM + 32 * l);
    f32x4 v[8]; float am = 0.f;
#pragma unroll
    for (int j = 0; j < 8; ++j) { v[j] = s[j]; am = __builtin_fmaxf(am, __builtin_fmaxf(__builtin_fmaxf(__builtin_fabsf(v[j].x), __builtin_fabsf(v[j].y)), __builtin_fmaxf(__builtin_fabsf(v[j].z), __builtin_fabsf(v[j].w)))); }
    const unsigned tb = __float_as_uint(am * (1.0f / 6.0f));
    int eb = (int)(tb >> 23) + ((tb & 0x7fffffu) ? 1 : 0); eb = eb < 1 ? 1 : (eb > 254 ? 254 : eb);
    const float sc = __uint_as_float((unsigned)eb << 23);
    unsigned p[4];
#pragma unroll
    for (int k = 0; k < 4; ++k) { unsigned w = 0u;
        w = __builtin_amdgcn_cvt_scalef32_pk_fp4_f32(w, v[2 * k].x, v[2 * k].y, sc, 0); w = __builtin_amdgcn_cvt_scalef32_pk_fp4_f32(w, v[2 * k].z, v[2 * k].w, sc, 1);
        w = __builtin_amdgcn_cvt_scalef32_pk_fp4_f32(w, v[2 * k + 1].x, v[2 * k + 1].y, sc, 2); w = __builtin_amdgcn_cvt_scalef32_pk_fp4_f32(w, v[2 * k + 1].z, v[2 * k + 1].w, sc, 3); p[k] = w; }
    unsigned char* d = dst + (size_t)h * PROW;
    *(GAS v4u*)(d + 16 * l) = (v4u){p[0], p[1], p[2], p[3]};
    d[512 + (PERM ? 8 * (l & 3) + (l >> 2) : l)] = (unsigned char)eb;
}
__device__ __forceinline__ void rms_row(const float* xrow, const float* g, bf16* orow, bf16* cp, int lane) {
    const GAS f32x4* xr = (const GAS f32x4*)xrow + lane; const GAS f32x4* gr = (const GAS f32x4*)g + lane;
    f32x4 v[4]; float s = 0.f;
#pragma unroll
    for (int j = 0; j < 4; ++j) { v[j] = xr[64 * j]; s += (v[j].x * v[j].x + v[j].y * v[j].y) + (v[j].z * v[j].z + v[j].w * v[j].w); }
    if (cp) { GAS unsigned long long* c = (GAS unsigned long long*)cp + lane;
#pragma unroll
        for (int j = 0; j < 4; ++j) c[64 * j] = (unsigned long long)cvtpk(v[j].x, v[j].y) | ((unsigned long long)cvtpk(v[j].z, v[j].w) << 32); }
    const float rstd = 1.0f / sqrtf(wave_sum(s) * (1.f / DM) + EPS);
    GAS unsigned long long* o8 = (GAS unsigned long long*)orow + lane;
#pragma unroll
    for (int j = 0; j < 4; ++j) { const f32x4 gg = gr[64 * j]; o8[64 * j] = (unsigned long long)cvtpk(v[j].x * rstd * gg.x, v[j].y * rstd * gg.y) | ((unsigned long long)cvtpk(v[j].z * rstd * gg.z, v[j].w * rstd * gg.w) << 32); }
}
__device__ __forceinline__ void p0_prologue(Frame& F) {
    const auto kp_ = ka_fresh(F); unsigned char* const ws_ = KA_WS(kp_); float* const out_ = KA_OUT(kp_);
#define FIN(i) KA_IN(kp_, i)
    LAS float* scr = (LAS float*)(F.lds + RING_OFF + F.wave * 16384);
    const int gw = F.vcu * NWAVES + F.wave, NGW = F.G * NWAVES, lane = F.lane;
    constexpr int I_IN = 16 * (INW / 32), I_MKV = 16 * (MKVW / 32), I_OUT = 16 * (DM / 32), I_PQ = 16 * (PQW / 32), I_SKV = 16 * (SKVW / 32);
    constexpr int E0 = 2 * I_IN, E1 = E0 + 2 * I_IN, E2 = E1 + 4 * I_MKV, E3 = E2 + 4 * I_OUT, E4 = E3 + 4 * I_PQ, E5 = E4 + I_SKV;
    for (int it = gw; it < E5; it += NGW) {
        if (it < E0) { const int l = it / I_IN, r = it % I_IN; p0_transpose_item(FIN(3) + (size_t)l * DM * INW, DM, INW, WSP(bf16, WS_WA) + (size_t)l * INW * DM, nullptr, scr, r, lane); }
        else if (it < E1) { const int q = it - E0, l = q / I_IN, r = q % I_IN; p0_transpose_item(FIN(6) + (size_t)l * DM * INW, DM, INW, WSP(bf16, WS_WB) + (size_t)l * INW * DM, nullptr, scr, r, lane); }
        else if (it < E2) { const int q = it - E1, l = q / I_MKV, r = q % I_MKV; p0_transpose_item(FIN(8) + (size_t)l * DM * MKVW, DM, MKVW, WSP(bf16, WS_WMKV) + (size_t)l * MKVW * DM, nullptr, scr, r, lane); }
        else if (it < E3) { const int q = it - E2, l = q / I_OUT, r = q % I_OUT; p0_transpose_item(FIN(9) + (size_t)l * DM * DM, DM, DM, WSP(bf16, WS_WOUT) + (size_t)l * DM * DM, nullptr, scr, r, lane); }
        else if (it < E4) { const int q = it - E3, l = q / I_PQ, r = q % I_PQ; p0_transpose_item(FIN(11) + (size_t)l * DM * PQW, DM, PQW, WSP(bf16, WS_WPQ) + (size_t)l * PQW * DM, FIN(10) + l * DM, scr, r, lane); }
        else { const int r = it - E4; p0_transpose_item(FIN(16), DM, SKVW, WSP(bf16, WS_WSKV), nullptr, scr, r, lane); }
    }
    for (int r2 = gw; r2 < 2 * NEXP; r2 += NGW) { cvt_2rows_fp4<true>(FIN(13) + (size_t)r2 * 2 * DM, WSP(unsigned char, WS_PU) + (size_t)r2 * 2 * PROW, lane); cvt_2rows_fp4<false>(FIN(14) + (size_t)r2 * 2 * DM, WSP(unsigned char, WS_PV) + (size_t)r2 * 2 * PROW, lane); }
    for (int r = gw; r < 1024; r += NGW) cvt_row(FIN(12) + (size_t)r * 1024, WSP(bf16, WS_PKEYS) + (size_t)r * 1024, lane);
    for (int e = gw * 64 + lane; e < SEQ * 8; e += NGW * 64) { const int t = e >> 3, i = e & 7;
        const double ang = (double)t * pow(500000.0, -(double)i / 8.0);
        WSP(float, WS_ROPE)[t * 16 + i] = (float)cos(ang); WSP(float, WS_ROPE)[t * 16 + 8 + i] = (float)sin(ang); }
    for (int r = gw; r < 4 * MEMROWS; r += NGW) { const int l = r / MEMROWS, m = r % MEMROWS; rms_row(FIN(1) + (size_t)m * DM, FIN(7) + l * DM, WSP(bf16, WS_MEMN) + (size_t)r * DM, nullptr, lane); }
    for (int m = gw; m < TT; m += NGW) rms_row(FIN(0) + (size_t)m * DM, FIN(2), WSP(bf16, WS_XN) + (size_t)m * DM, WSP(bf16, WS_XB) + (size_t)m * DM, lane);
}
#undef FIN

__device__ __forceinline__ void diff_unit(Frame& F, int b, int h, int ib, const bf16* PROJ, bf16* MIX, float lam, float oml, const float* subg) {
    using namespace att;
    const int lane = F.lane, r32 = lane & 31, hi = lane >> 5, w = F.wave, p = w >> 2, wq = w & 3;
    const lds_cptr L = (lds_cptr)(F.lds + RING_OFF);
    const unsigned lds0 = (unsigned)(uintptr_t)(F.lds + RING_OFF);
    lds_fptr wsf = (lds_fptr)(F.lds + RING_OFF + 98304 + w * 256);
    const size_t rb = (size_t)b * SEQ;
    const bf16* Qw = PROJ + (rb + 128 * ib + 32 * wq + r32) * INW + (2 * h + p) * 64;
    const bf16* Kg = PROJ + rb * INW + 768 + (2 * h) * 64;
    const bf16* Vg = PROJ + rb * INW + 1536 + h * 128;
    const int NT = 2 * (ib + 1);
    const int krow_ = 8 * w + (lane >> 3), kch_ = (lane & 7) ^ kswz(krow_);
    const bf16* ksrc0 = Kg + (size_t)krow_ * INW + kch_ * 8;
    const bf16* ksrc1 = ksrc0 + 64;
    const int vrow_ = 8 * w + (lane >> 4), vch_ = (lane & 15) ^ ((vrow_ & 3) << 2);
    const bf16* vsrc0 = Vg + (size_t)vrow_ * INW + vch_ * 8;
    const bf16* vsrc1 = vsrc0 + (size_t)4 * INW;
#define DIFF_ISSUE(t, slot) do { const size_t go_ = (size_t)(t) * 64 * INW; const unsigned sb_ = lds0 + (slot) * 32768; \
        glds16(ksrc0 + go_, (unsigned)__builtin_amdgcn_readfirstlane(sb_ + w * 1024)); glds16(ksrc1 + go_, (unsigned)__builtin_amdgcn_readfirstlane(sb_ + 8192 + w * 1024)); \
        glds16(vsrc0 + go_, (unsigned)__builtin_amdgcn_readfirstlane(sb_ + 16384 + w * 2048)); glds16(vsrc1 + go_, (unsigned)__builtin_amdgcn_readfirstlane(sb_ + 16384 + w * 2048 + 1024)); } while (0)
    DIFF_ISSUE(0, 0); DIFF_ISSUE(1, 1);
    bf16x8 qr[4];
#pragma unroll
    for (int d0 = 0; d0 < 4; ++d0) qr[d0] = *(const bf16x8*)(Qw + d0 * 16 + hi * 8);
    asm volatile("" : "+v"(qr[0]), "+v"(qr[1]), "+v"(qr[2]), "+v"(qr[3]));
    float m_run = 0.f, l_run = 0.f; f32x16 o[4];
#pragma unroll
    for (int d = 0; d < 4; ++d) o[d] = f32x16{};
    const int qrel = 32 * wq + r32; int ko[4], vo[4][2]; kread_offs(ko, r32, hi); vread_offs<4>(vo, lane);
    int sl = 0;
    for (int t = 0; t < NT; ++t) {
        if (t + 1 < NT) ATT_WAITV(4); else ATT_WAITV(0);
        ATT_BAR();
        if (t + 2 < NT) DIFF_ISSUE(t + 2, (sl >= 1 ? sl - 1 : 2));
        const lds_cptr S = L + sl * 32768;
        f32x16 p0, p1;
        qkt(p0, p1, S + p * 8192, qr, ko, -m_run);
        const int jb = t - (NT - 2);
        if (jb >= 0) { const int kb = 64 * jb + 4 * hi;
#pragma unroll
            for (int r = 0; r < 16; ++r) { const int kv = kb + (r & 3) + 8 * (r >> 2); if (kv > qrel) p0[r] = -INFINITY; if (kv + 32 > qrel) p1[r] = -INFINITY; } }
        softmax_pv<4>(p0, p1, m_run, l_run, t == 0, o, S + 16384, vo, wsf, r32, hi);
        sl = sl == 2 ? 0 : sl + 1;
    }
#undef DIFF_ISSUE
    finish_o<4>(l_run, o, wsf, r32, hi);
    ATT_BAR();
    lds_fptr X = (lds_fptr)(F.lds + RING_OFF) + wq * 4096;
    if (p == 1) {
#pragma unroll
        for (int d = 0; d < 4; ++d)
#pragma unroll
            for (int r = 0; r < 16; ++r) X[(d * 16 + r) * 64 + lane] = o[d][r];
    }
    ATT_BAR();
    if (p == 0) {
        float ss[16];
#pragma unroll
        for (int r = 0; r < 16; ++r) ss[r] = 0.f;
#pragma unroll
        for (int d = 0; d < 4; ++d)
#pragma unroll
            for (int r = 0; r < 16; ++r) { const float v = o[d][r] - lam * X[(d * 16 + r) * 64 + lane]; o[d][r] = v; ss[r] += v * v; }
#pragma unroll
        for (int r = 0; r < 16; ++r) {
            float s = ss[r];
            s = half32_sum(s);
            ss[r] = oml / sqrtf(s * (1.f / 128.f) + EPS);
        }
        LAS unsigned short* stg = (LAS unsigned short*)(F.lds + RING_OFF + 65536 + wq * 8192);
#pragma unroll
        for (int d = 0; d < 4; ++d) { const float g = subg[32 * d + r32];
#pragma unroll
            for (int r = 0; r < 16; ++r) { const unsigned short hb = (unsigned short)(cvtpk(o[d][r] * ss[r] * g, 0.f) & 0xffffu); stg[crow(r, hi) * 128 + 32 * d + r32] = hb; } }
        ATT_WAITL();
        bf16* Ow = MIX + (rb + 128 * ib + 32 * wq) * DM + h * 128;
#pragma unroll
        for (int i = 0; i < 8; ++i) { const int idx = i * 64 + lane, row = idx >> 4, ch = idx & 15;
            const u32x4 v = *(const LAS u32x4*)(stg + row * 128 + ch * 8); *(u32x4*)(Ow + (size_t)row * DM + ch * 8) = v; }
    }
    ATT_BAR();
}

constexpr int WP_STRIDE = 16384;
struct MemMap {
    int base;
    __device__ __forceinline__ int nt() const { return 4; }
    __device__ __forceinline__ int first() const { return 0; }
    __device__ __forceinline__ int krow(int tt, int j) const { return base + 64 * tt + j; }
    __device__ __forceinline__ void mask(int, att::f32x16&, att::f32x16&, int, int) const {}
};
struct DilMap {
    int rowbase, d, res, m0, ks, Lm1;
    __device__ __forceinline__ int nt() const { return 3; }
    __device__ __forceinline__ int first() const { return ks + 64 <= 0 ? (ks + 128 <= 0 ? 2 : 1) : 0; }
    __device__ __forceinline__ int krow(int tt, int j) const { int mp = ks + 64 * tt + j; mp = mp < 0 ? 0 : (mp > Lm1 ? Lm1 : mp); return rowbase + mp * d + res; }
    __device__ __forceinline__ void mask(int tt, att::f32x16& p0, att::f32x16& p1, int r32, int hi) const {
        const int m = m0 + r32, kb = ks + 64 * tt + 4 * hi;
#pragma unroll
        for (int r = 0; r < 16; ++r) { const int mp = kb + (r & 3) + 8 * (r >> 2);
            if (mp < 0 || mp > m || mp < m - 128) p0[r] = -INFINITY;
            if (mp + 32 < 0 || mp + 32 > m || mp + 32 < m - 128) p1[r] = -INFINITY; }
    }
};
template <class KM>
__device__ __forceinline__ void win_attn(Frame& F, const KM& km, const bf16* qp, const bf16* Kg, int pitchK, const bf16* Vg, int pitchV, att::f32x16 (&o)[2], float& m_out, float& l_out) {
    using namespace att;
    const int lane = F.lane, r32 = lane & 31, hi = lane >> 5, w = F.wave;
    const unsigned kdst = (unsigned)(uintptr_t)(F.lds + RING_OFF + w * WP_STRIDE), vdst = kdst + 8192;
    const lds_cptr Ks = (lds_cptr)(F.lds + RING_OFF + w * WP_STRIDE), Vs = Ks + 8192;
    lds_fptr wsf = (lds_fptr)(F.lds + PEER_SCR + w * 256);
    bf16x8 qr[4];
#pragma unroll
    for (int d0 = 0; d0 < 4; ++d0) qr[d0] = *(const bf16x8*)(qp + d0 * 16 + hi * 8);
    asm volatile("" : "+v"(qr[0]), "+v"(qr[1]), "+v"(qr[2]), "+v"(qr[3]));
    float m_run = 0.f, l_run = 0.f;
    o[0] = f32x16{}; o[1] = f32x16{};
    int ko[4], vo[2][2]; kread_offs(ko, r32, hi); vread_offs<2>(vo, lane);
#define WP_ISSUE_K(tt) do { _Pragma("unroll") for (int i_ = 0; i_ < 8; ++i_) { const int row_ = 8 * i_ + (lane >> 3); \
        glds16(Kg + (size_t)km.krow(tt, row_) * pitchK + (((lane & 7) ^ kswz(row_)) << 3), (unsigned)__builtin_amdgcn_readfirstlane(kdst + i_ * 1024)); } } while (0)
#define WP_ISSUE_V(tt) do { _Pragma("unroll") for (int i_ = 0; i_ < 8; ++i_) { const int row_ = 8 * i_ + (lane >> 3); \
        glds16(Vg + (size_t)km.krow(tt, row_) * pitchV + (((lane & 7) ^ kswz(row_)) << 3), (unsigned)__builtin_amdgcn_readfirstlane(vdst + i_ * 1024)); } } while (0)
    const int t0 = km.first(), nt = km.nt();
    ATT_WAITL();
    WP_ISSUE_K(t0); WP_ISSUE_V(t0);
    for (int tt = t0; tt < nt; ++tt) {
        ATT_WAITV(8);
        f32x16 p0, p1;
        qkt(p0, p1, Ks, qr, ko, -m_run);
        if (tt + 1 < nt) { ATT_WAITL(); WP_ISSUE_K(tt + 1); ATT_WAITV(8); } else { ATT_WAITV(0); }
        km.mask(tt, p0, p1, r32, hi);
        softmax_pv<2>(p0, p1, m_run, l_run, tt == t0, o, Vs, vo, wsf, r32, hi);
        if (tt + 1 < nt) { ATT_WAITL(); WP_ISSUE_V(tt + 1); }
    }
#undef WP_ISSUE_K
#undef WP_ISSUE_V
    l_out = finish_o<2>(l_run, o, wsf, r32, hi);
    m_out = m_run;
}
template <class RowOff>
__device__ __forceinline__ void win_store(Frame& F, const att::f32x16 (&o)[2], bf16* dst, const RowOff& rowoff) {
    using namespace att;
    const int lane = F.lane, r32 = lane & 31, hi = lane >> 5;
    LAS unsigned short* stg = (LAS unsigned short*)(F.lds + RING_OFF + F.wave * WP_STRIDE);
    ATT_WAITL();
#pragma unroll
    for (int r = 0; r < 16; ++r) { const int orow = crow(r, hi);
#pragma unroll
        for (int d0 = 0; d0 < 2; ++d0) stg[orow * 64 + d0 * 32 + r32] = (unsigned short)(cvtpk(o[d0][r], 0.f) & 0xffffu); }
    ATT_WAITL();
#pragma unroll
    for (int i = 0; i < 4; ++i) { const int row = i * 8 + (lane >> 3), ch = lane & 7; const u32x4 v = *(const LAS u32x4*)(stg + row * 64 + ch * 8); *(u32x4*)(dst + rowoff(row) + ch * 8) = v; }
    ATT_WAITL();
}
__device__ __forceinline__ void mem_attn_all(Frame& F, const bf16* PROJ, const bf16* MKV, bf16* MIX) {
    const int gw = F.vcu * NWAVES + F.wave, NGW = F.G * NWAVES, r32 = F.lane & 31;
    for (int qb = gw; qb < NB * 4 * (SEQ / 32); qb += NGW) {
        const int blk = qb % (SEQ / 32), mh = (qb / (SEQ / 32)) & 3, b = qb / (4 * (SEQ / 32));
        const size_t row0 = (size_t)b * SEQ + 32 * blk;
        MemMap km{b * MEMT};
        att::f32x16 o[2]; float m_, l_;
        win_attn(F, km, PROJ + (row0 + r32) * INW + 2304 + mh * 64, MKV + mh * 64, MKVW, MKV + 256 + mh * 64, MKVW, o, m_, l_);
        win_store(F, o, MIX + row0 * DM + 768 + mh * 64, [](int i) { return (size_t)i * DM; });
    }
}
__device__ __forceinline__ void dil_strip(Frame& F, int b, int head, int res, int s, int d, const bf16* PROJ, const bf16* SKV, bf16* OG, float* LSEG) {
    using namespace att;
    const int lane = F.lane, r32 = lane & 31, hi = lane >> 5, w = F.wave;
    const lds_cptr L = (lds_cptr)(F.lds + RING_OFF);
    const unsigned lds0 = (unsigned)(uintptr_t)(F.lds + RING_OFF);
    lds_fptr wsf = (lds_fptr)(F.lds + PEER_SCR + w * 256);
    const int rb = b * SEQ, Lm1 = SEQ / d - 1, kb0 = 256 * s - 128, m0 = 256 * s + 32 * w;
    const bf16* Kg = SKV + head * 64; const bf16* Vg = Kg + 2304;
    {   const int row_ = 8 * w + (lane >> 3), co_ = ((lane & 7) ^ kswz(row_)) << 3;
#pragma unroll
        for (int j = 0; j < 6; ++j) if (kb0 + 64 * j + 64 > 0) {
            int mp = kb0 + 64 * j + row_; mp = mp < 0 ? 0 : (mp > Lm1 ? Lm1 : mp);
            const size_t go = (size_t)(rb + mp * d + res) * SKVW + co_;
            glds16(Kg + go, (unsigned)__builtin_amdgcn_readfirstlane(lds0 + j * 16384 + w * 1024)); glds16(Vg + go, (unsigned)__builtin_amdgcn_readfirstlane(lds0 + j * 16384 + 8192 + w * 1024)); } }
    const size_t qrow = (size_t)rb + (size_t)(m0 + r32) * d + res;
    bf16x8 qr[4];
#pragma unroll
    for (int d0 = 0; d0 < 4; ++d0) qr[d0] = *(const bf16x8*)(PROJ + qrow * INW + head * 64 + d0 * 16 + hi * 8);
    asm volatile("" : "+v"(qr[0]), "+v"(qr[1]), "+v"(qr[2]), "+v"(qr[3]));
    int ko[4], vo[2][2]; kread_offs(ko, r32, hi); vread_offs<2>(vo, lane);
    ATT_WAITV(0); ATT_BAR();
    float m_run = 0.f, l_run = 0.f; f32x16 o[2]; o[0] = f32x16{}; o[1] = f32x16{};
    DilMap km{rb, d, res, m0, kb0, Lm1};
    bool first = true;
    for (int jj = 0; jj < 3; ++jj) {
        const int j = (w >> 1) + jj;
        if (kb0 + 64 * j + 64 <= 0) continue;
        f32x16 p0, p1;
        qkt(p0, p1, L + j * 16384, qr, ko, -m_run);
        km.mask(j, p0, p1, r32, hi);
        softmax_pv<2>(p0, p1, m_run, l_run, first, o, L + j * 16384 + 8192, vo, wsf, r32, hi);
        first = false;
    }
    const float l = finish_o<2>(l_run, o, wsf, r32, hi);
    {   LAS unsigned short* stg = (LAS unsigned short*)(F.lds + RING_OFF + 98304 + w * 4096);
#pragma unroll
        for (int r = 0; r < 16; ++r) { const int orow = crow(r, hi);
#pragma unroll
            for (int d0 = 0; d0 < 2; ++d0) stg[orow * 64 + d0 * 32 + r32] = (unsigned short)(cvtpk(o[d0][r], 0.f) & 0xffffu); }
        ATT_WAITL();
        bf16* dst = OG + ((size_t)rb + (size_t)m0 * d + res) * 2304 + head * 64;
#pragma unroll
        for (int i = 0; i < 4; ++i) { const int row = i * 8 + (lane >> 3), ch = lane & 7; const u32x4 v = *(const LAS u32x4*)(stg + row * 64 + ch * 8); *(u32x4*)(dst + (size_t)row * d * 2304 + ch * 8) = v; }
        if (hi == 0) LSEG[qrow * 36 + head] = m_run + __builtin_amdgcn_logf(l); }
    ATT_BAR();
}
__device__ __forceinline__ void dil_combine_all(Frame& F, const bf16* OG, const float* LSEG, bf16* MIX) {
    const int gt = F.vcu * (NWAVES * 64) + F.tid, NT_ = F.G * NWAVES * 64;
    for (int it = gt; it < TT * 12; it += NT_) {
        const int row = it / 12, j = it - row * 12;
        const float* lp = LSEG + (size_t)row * 36 + j; const float l0 = lp[0], l1 = lp[12], l2 = lp[24];
        const float mx = __builtin_fmaxf(l0, __builtin_fmaxf(l1, l2));
        float a0 = __builtin_amdgcn_exp2f(l0 - mx), a1 = __builtin_amdgcn_exp2f(l1 - mx), a2 = __builtin_amdgcn_exp2f(l2 - mx);
        const float inv = 1.0f / (a0 + a1 + a2); a0 *= inv; a1 *= inv; a2 *= inv;
        const v4u* g0 = (const v4u*)(OG + (size_t)row * 2304 + j * 64); const v4u* g1 = g0 + 12 * 8; const v4u* g2 = g1 + 12 * 8;
        v4u* dst = (v4u*)(MIX + (size_t)row * DM + j * 64);
#pragma unroll
        for (int c = 0; c < 8; ++c) {
            const v4u x = g0[c], y = g1[c], z = g2[c]; v4u r;
#pragma unroll
            for (int k = 0; k < 4; ++k) {
                const unsigned xk = x[k], yk = y[k], zk = z[k];
                const float lo = a0 * __uint_as_float(xk << 16) + a1 * __uint_as_float(yk << 16) + a2 * __uint_as_float(zk << 16);
                const float hh = a0 * __uint_as_float(xk & 0xffff0000u) + a1 * __uint_as_float(yk & 0xffff0000u) + a2 * __uint_as_float(zk & 0xffff0000u);
                r[k] = cvtpk(lo, hh);
            }
            dst[c] = r;
        }
    }
}
#ifndef REPMASK
#define REPMASK 0
#endif
#define NREP(b) (((REPMASK) & (b)) ? 2 : 1)

#define CEX(a, b) do { const float hi_ = __builtin_fmaxf(a, b), lo_ = __builtin_fminf(a, b); a = hi_; b = lo_; } while (0)
template <int K, int J> __device__ __forceinline__ void bstage(float (&a)[16]) {
#pragma unroll
    for (int i = 0; i < 16; ++i) { constexpr int k = K, j = J; const int l = i ^ j; if (l > i) { if ((i & k) == 0) CEX(a[i], a[l]); else CEX(a[l], a[i]); } }
}
__device__ __forceinline__ void sort16_desc(float (&a)[16]) {
    bstage<2, 1>(a); bstage<4, 2>(a); bstage<4, 1>(a); bstage<8, 4>(a); bstage<8, 2>(a); bstage<8, 1>(a); bstage<16, 8>(a); bstage<16, 4>(a); bstage<16, 2>(a); bstage<16, 1>(a);
}
__device__ __forceinline__ void merge16(float (&a)[16], const float (&b)[16]) {
#pragma unroll
    for (int i = 0; i < 16; ++i) a[i] = __builtin_fmaxf(a[i], b[15 - i]);
    bstage<16, 8>(a); bstage<16, 4>(a); bstage<16, 2>(a); bstage<16, 1>(a);
}
__device__ __forceinline__ void top16_of_64(const float (&v)[64], float (&out)[16]) {
    float c1[16], c2[16], c3[16];
#pragma unroll
    for (int i = 0; i < 16; ++i) { out[i] = v[i]; c1[i] = v[16 + i]; }
    sort16_desc(out); sort16_desc(c1); merge16(out, c1);
#pragma unroll
    for (int i = 0; i < 16; ++i) { c2[i] = v[32 + i]; c3[i] = v[48 + i]; }
    sort16_desc(c2); sort16_desc(c3); merge16(c2, c3); merge16(out, c2);
}
struct CandTab { int pos[16][16]; int inv[64]; int n;
    constexpr CandTab() : pos{}, inv{}, n(0) { for (int q = 0; q < 64; ++q) inv[q] = -1; for (int a = 0; a < 16; ++a) for (int b = 0; b < 16; ++b) { if ((a + 1) * (b + 1) <= 16) { pos[a][b] = n; inv[n] = a * 16 + b; ++n; } else pos[a][b] = -1; } } };
static constexpr CandTab kCand{};
static_assert(kCand.n == 50, "50 candidate pairs");
__device__ __forceinline__ float gelu1(float v) { pg8::f32x2 t = {v, v}; return pg8::gelu_pk(t).x; }
__device__ __forceinline__ float half32_max(float v) {
    v = dpp_maxc<0xB1>(v); v = dpp_maxc<0x4E>(v); v = dpp_maxc<0x141>(v); v = dpp_maxc<0x140>(v);
    auto r = __builtin_amdgcn_permlane16_swap(__float_as_uint(v), __float_as_uint(v), false, false); return __builtin_fmaxf(__uint_as_float(r[0]), __uint_as_float(r[1]));
}

__device__ __forceinline__ void peer_phase(Frame& F, int l) {
    using att::f32x16; using att::crow;
    const int lane = F.lane, r32 = lane & 31, hi = lane >> 5, w = F.wave;
    const auto kp_ = ka_fresh(F); unsigned char* const ws_ = KA_WS(kp_); float* const out_ = KA_OUT(kp_);
    const bf16* PQ = WSP(bf16, WS_PROJ);
    const bf16* keys = WSP(bf16, WS_PKEYS) + (size_t)l * 16 * 128 * 128;
    const unsigned char* U6 = WSP(unsigned char, WS_PU) + (size_t)l * NEXP * PROW;
    const unsigned char* V6 = WSP(unsigned char, WS_PV) + (size_t)l * NEXP * PROW;
    LAS unsigned* ids = (LAS unsigned*)(F.lds + RING_OFF);
    const unsigned kbuf = (unsigned)(uintptr_t)(F.lds + RING_OFF + 65536 + (w >> 2) * 32768);
    const att::lds_cptr KB = (att::lds_cptr)(F.lds + RING_OFF + 65536 + (w >> 2) * 32768);
    LAS unsigned char* scr = F.lds + PEER_SCR + w * 2048 + lane * 32;
    const float* gf = KA_IN(kp_, 10) + l * DM;
    for (int tile = F.bx; tile < TT / 128; tile += F.G) {
        {
            const int tokl = 32 * (w & 3) + r32; const size_t tok = (size_t)tile * 128 + tokl;
#define KEYS_ISSUE(gi) do { const bf16* kg_ = keys + (size_t)((4 * (w >> 2)) * 2 + (gi)) * 16384; int ln_ = lane; asm volatile("" : "+v"(ln_)); _Pragma("unroll") for (int i_ = 0; i_ < 8; ++i_) { const int q_ = 8 * (w & 3) + i_, row_ = 4 * q_ + (ln_ >> 4); \
                att::glds16(kg_ + row_ * 128 + (((ln_ & 15) ^ (row_ & 15)) << 3), (unsigned)__builtin_amdgcn_readfirstlane(kbuf + q_ * 1024)); } } while (0)
            for (int rep_ = 0; rep_ < NREP(256); ++rep_) {
            KEYS_ISSUE(0);
            bf16x8 bq[8];
            { const bf16* qp = PQ + tok * PQW + (4 * (w >> 2)) * 256 + hi * 8;
#pragma unroll
              for (int ks = 0; ks < 8; ++ks) bq[ks] = *(const bf16x8*)(qp + ks * 16); }
            for (int hh = 0; hh < 4; ++hh) {
                const int h = 4 * (w >> 2) + hh;
                float L0[16], L1[16];
#pragma unroll
                for (int p = 0; p < 2; ++p) {
                    asm volatile("" : "+v"(bq[0]), "+v"(bq[1]), "+v"(bq[2]), "+v"(bq[3]), "+v"(bq[4]), "+v"(bq[5]), "+v"(bq[6]), "+v"(bq[7]));
                    ATT_WAITV(0); ATT_BAR();
                    f32x16 acc[4];
#pragma unroll
                    for (int kb = 0; kb < 4; ++kb) acc[kb] = f32x16{};
                    const int kro = r32 * 256, ksw = r32 & 15;
#pragma unroll
                    for (int ks = 0; ks < 8; ++ks) {
#pragma unroll
                        for (int kb = 0; kb < 4; ++kb) { const bf16x8 ak = *(const __attribute__((address_space(3))) bf16x8*)(KB + kb * 8192 + kro + (((2 * ks + hi) ^ ksw) << 4)); acc[kb] = __builtin_amdgcn_mfma_f32_32x32x16_bf16(ak, bq[ks], acc[kb], 0, 0, 0); } }
                    asm volatile("" : "+v"(acc[0]), "+v"(acc[1]), "+v"(acc[2]), "+v"(acc[3]));
                    ATT_BAR();
                    if (hh * 2 + p + 1 < 8) { KEYS_ISSUE(hh * 2 + p + 1);
                        const bf16* qp = PQ + tok * PQW + (4 * (w >> 2)) * 256 + (hh * 2 + p + 1) * 128 + hi * 8;
#pragma unroll
                        for (int ks = 0; ks < 8; ++ks) bq[ks] = *(const bf16x8*)(qp + ks * 16); }
                    float t[16];
#pragma unroll
                    for (int kb = 0; kb < 4; ++kb) { float c[16];
#pragma unroll
                        for (int r = 0; r < 16; ++r) c[r] = __uint_as_float((__float_as_uint(acc[kb][r]) & ~127u) | (unsigned)(kb * 32 + (r & 3) + 8 * (r >> 2)));
                        sort16_desc(c);
                        if (kb == 0) {
#pragma unroll
                            for (int r = 0; r < 16; ++r) t[r] = c[r];
                        } else merge16(t, c); }
                    float a[16], b[16];
#pragma unroll
                    for (int i = 0; i < 16; ++i) { auto rr = __builtin_amdgcn_permlane32_swap(__float_as_uint(t[i]), __float_as_uint(t[i]), false, false); a[i] = __uint_as_float(rr[0]); b[i] = __uint_as_float(rr[1] | 4u); }
                    merge16(a, b);
#pragma unroll
                    for (int i = 0; i < 16; ++i) { if (p == 0) L0[i] = a[i]; else L1[i] = a[i]; }
                }
#pragma unroll
                for (int q = 0; q < 4; ++q) {
                    ((LAS unsigned*)scr)[q] = (__float_as_uint(L0[4 * q]) & 127u) | ((__float_as_uint(L0[4 * q + 1]) & 127u) << 8) | ((__float_as_uint(L0[4 * q + 2]) & 127u) << 16) | ((__float_as_uint(L0[4 * q + 3]) & 127u) << 24);
                    ((LAS unsigned*)scr)[4 + q] = (__float_as_uint(L1[4 * q]) & 127u) | ((__float_as_uint(L1[4 * q + 1]) & 127u) << 8) | ((__float_as_uint(L1[4 * q + 2]) & 127u) << 16) | ((__float_as_uint(L1[4 * q + 3]) & 127u) << 24);
                }
                float sel[16];
#pragma unroll
                for (int ch = 0; ch < 4; ++ch) { float c[16];
#pragma unroll
                    for (int q = 0; q < 16; ++q) { constexpr int dummy = 0; const int code = kCand.inv[ch * 16 + q];
                        c[q] = code >= 0 ? __uint_as_float((__float_as_uint(L0[code >= 0 ? (code >> 4) : 0] + L1[code >= 0 ? (code & 15) : 0]) & ~255u) | (unsigned)(code >= 0 ? code : 0)) : -INFINITY; }
                    sort16_desc(c);
                    if (ch == 0) {
#pragma unroll
                        for (int q = 0; q < 16; ++q) sel[q] = c[q];
                    } else merge16(sel, c); }
                asm volatile("s_waitcnt lgkmcnt(0)" ::: "memory");
                float ev[16]; unsigned eid[16]; float esum = 0.f;
                const float s0 = __uint_as_float(__float_as_uint(sel[0]) & ~255u);
#pragma unroll
                for (int k = 0; k < 16; ++k) { const unsigned bits = __float_as_uint(sel[k]); const unsigned code = bits & 255u;
                    const unsigned i1 = scr[code >> 4], i2 = scr[16 + (code & 15u)];
                    eid[k] = i1 * 128u + i2; ev[k] = __expf(__uint_as_float(bits & ~255u) - s0); esum += ev[k]; }
                const float rinv = 1.0f / esum;
                asm volatile("s_waitcnt lgkmcnt(0)" ::: "memory");
#pragma unroll
                for (int k = 0; k < 8; ++k) { const unsigned idv = hi ? eid[k + 8] : eid[k]; const float gv = (hi ? ev[k + 8] : ev[k]) * rinv;
                    ids[tokl * 128 + h * 16 + 8 * hi + k] = idv | (cvtpk(0.f, gv) & 0xffff0000u); }
            }
            }
#undef KEYS_ISSUE
        }
        __syncthreads();
        {
        const Frame F2 = make_frame(); const int lane = F2.lane, w = F2.wave, bl = lane & 31, hf = lane >> 5;
        typedef __bf16 bf2 __attribute__((ext_vector_type(2))); typedef float f32x2_t __attribute__((ext_vector_type(2)));
        {   LAS unsigned* lst = ids + w * 2048; unsigned ent[16][2];
#pragma unroll
            for (int t = 0; t < 16; ++t) { ent[t][0] = lst[t * 128 + lane]; ent[t][1] = lst[t * 128 + 64 + lane]; }
            asm volatile("s_waitcnt lgkmcnt(0)" ::: "memory");
#pragma unroll
            for (int t = 0; t < 16; ++t) {
                LAS unsigned* L = lst + t * 128; const unsigned q0 = ent[t][0], q1 = ent[t][1]; const int r0 = (int)((q0 >> 10) & 15u), r1 = (int)((q1 >> 10) & 15u);
                int base = 0;
                for (int r = 0; r < 16; ++r) {
                    const unsigned long long m0 = __ballot(r0 == r), m1 = __ballot(r1 == r); const int c0 = __popcll(m0);
                    if (r0 == r) L[base + __builtin_amdgcn_mbcnt_hi((unsigned)(m0 >> 32), __builtin_amdgcn_mbcnt_lo((unsigned)m0, 0))] = q0;
                    if (r1 == r) L[base + c0 + __builtin_amdgcn_mbcnt_hi((unsigned)(m1 >> 32), __builtin_amdgcn_mbcnt_lo((unsigned)m1, 0))] = q1;
                    base += c0 + __popcll(m1);
                }
            }
            asm volatile("s_waitcnt lgkmcnt(0)" ::: "memory");
        }
        const __amdgpu_buffer_rsrc_t rsu = __builtin_amdgcn_make_buffer_rsrc((void*)U6, 0, NEXP * PROW, 0x00020000), rsv = __builtin_amdgcn_make_buffer_rsrc((void*)V6, 0, NEXP * PROW, 0x00020000);
        {
            const int ci = lane & 15, cg = lane >> 4;
            const unsigned xq8 = (unsigned)(uintptr_t)(F2.lds + RING_OFF + 65536 + w * 8192);
            const bool wr = ((ci & 7) == 0) && ((cg >> 1) == (ci >> 3));
            typedef int v8i_t __attribute__((ext_vector_type(8))); typedef unsigned v2u_t __attribute__((ext_vector_type(2)));
        v4u vb0, vb1, vb2, vb3, vb4, vb5, vb6, vb7; unsigned vs0, vs1, vs2, vs3, vs4, vs5, vs6, vs7;
#define V_LD(VB, VS, ent) do { const unsigned e_ = (ent) & 0x3fffu; const int ro_ = (int)(e_ * (unsigned)PROW) + 16 * bl; \
                VB = __builtin_bit_cast(v4u, __builtin_amdgcn_raw_buffer_load_b128(rsv, ro_, 0, 0)); VS = (unsigned)__builtin_amdgcn_raw_buffer_load_b8(rsv, ro_ + 512 - 15 * bl, 0, 0); } while (0)
#define V_FMA(VB, VS, ent) do { const float c_ = __uint_as_float((ent) & 0xffff0000u), sv_ = __uint_as_float(VS << 23); \
                _Pragma("unroll") for (int k_ = 0; k_ < 4; ++k_) { const unsigned vw_ = VB[k_]; \
                    { const f32x2_t f_ = __builtin_amdgcn_cvt_scalef32_pk_f32_fp4(vw_, sv_, 0); acc[8 * k_] += c_ * f_.x; acc[8 * k_ + 1] += c_ * f_.y; } \
                    { const f32x2_t f_ = __builtin_amdgcn_cvt_scalef32_pk_f32_fp4(vw_, sv_, 1); acc[8 * k_ + 2] += c_ * f_.x; acc[8 * k_ + 3] += c_ * f_.y; } \
                    { const f32x2_t f_ = __builtin_amdgcn_cvt_scalef32_pk_f32_fp4(vw_, sv_, 2); acc[8 * k_ + 4] += c_ * f_.x; acc[8 * k_ + 5] += c_ * f_.y; } \
                    { const f32x2_t f_ = __builtin_amdgcn_cvt_scalef32_pk_f32_fp4(vw_, sv_, 3); acc[8 * k_ + 6] += c_ * f_.x; acc[8 * k_ + 7] += c_ * f_.y; } } } while (0)
            const int wq = __builtin_amdgcn_readfirstlane(w);
            for (int st = 0; st < 4; ++st) {
                const int code = (wq < 4) ? (st < 2 ? st : 2 + st) : ((st & 1) ? 4 + (st >> 1) : (st >> 1));
                if (code < 4) { const int h = code;
                int eb_v = 127;
                for (int p = 0; p < 4; ++p) {
                    const int tokl = 16 * w + 8 * h + 2 * p + hf; const size_t tok = (size_t)tile * 128 + tokl;
                    const bf16* xrow = WSP(bf16, WS_XB) + tok * DM + 32 * bl;
            {   v4u xw[4]; float ssq = 0.f; f32x4 x[8];
#pragma unroll
                for (int j = 0; j < 4; ++j) xw[j] = ((const v4u*)xrow)[j];
#pragma unroll
                for (int j = 0; j < 4; ++j) { const unsigned a_ = xw[j].x, b_ = xw[j].y, c_ = xw[j].z, d_ = xw[j].w;
                    x[2 * j] = (f32x4){__uint_as_float(a_ << 16), __uint_as_float(a_ & 0xffff0000u), __uint_as_float(b_ << 16), __uint_as_float(b_ & 0xffff0000u)};
                    x[2 * j + 1] = (f32x4){__uint_as_float(c_ << 16), __uint_as_float(c_ & 0xffff0000u), __uint_as_float(d_ << 16), __uint_as_float(d_ & 0xffff0000u)}; }
#pragma unroll
                for (int j = 0; j < 8; ++j) ssq += (x[j][0] * x[j][0] + x[j][1] * x[j][1]) + (x[j][2] * x[j][2] + x[j][3] * x[j][3]);
                const float rstd = 1.0f / sqrtf(half32_sum(ssq) * (1.f / DM) + EPS);
                float am = 0.f;
#pragma unroll
                for (int j = 0; j < 8; ++j) { const f32x4 gg = ((const f32x4*)(gf + 32 * bl))[j]; x[j] = x[j] * rstd * gg;
                    am = __builtin_fmaxf(am, __builtin_fmaxf(__builtin_fmaxf(__builtin_fabsf(x[j][0]), __builtin_fabsf(x[j][1])), __builtin_fmaxf(__builtin_fabsf(x[j][2]), __builtin_fabsf(x[j][3])))); }
                am = __builtin_fmaxf(half32_max(am), 1e-30f);
                auto rr = __builtin_amdgcn_permlane32_swap(__float_as_uint(am), __float_as_uint(am), false, false);
                const int ebA = (int)(rr[0] >> 23), ebB = (int)(rr[1] >> 23), ebO = hf ? ebB : ebA;
                const float mult = __uint_as_float((unsigned)(261 - ebO) << 23);
                if (lane == 2 * p) eb_v = ebA; if (lane == 2 * p + 1) eb_v = ebB;
                unsigned q8[8];
#pragma unroll
                for (int j = 0; j < 8; ++j) { int p_ = __builtin_amdgcn_cvt_pk_fp8_f32(x[j][0] * mult, x[j][1] * mult, 0, false); p_ = __builtin_amdgcn_cvt_pk_fp8_f32(x[j][2] * mult, x[j][3] * mult, p_, true); q8[j] = (unsigned)p_; }
                { const unsigned xo_ = xq8 + (2 * p + hf) * 1024 + bl * 32; *(LAS v4u*)(uintptr_t)xo_ = (v4u){q8[0], q8[1], q8[2], q8[3]}; *(LAS v4u*)(uintptr_t)(xo_ + 16) = (v4u){q8[4], q8[5], q8[6], q8[7]}; }
                asm volatile("s_waitcnt lgkmcnt(0)" ::: "memory");
            }
                }
                asm volatile("s_waitcnt lgkmcnt(0)" ::: "memory");
                v4u a0, a1, a2, a3, a4, a5, a6, a7, b0, b1, b2, b3, b4, b5, b6, b7, c0, c1, c2, c3, c4, c5, c6, c7; v2u_t sa, sb, sc;
#define U_REQ(B0, B1, B2, B3, B4, B5, B6, B7, S, k_) do { const int G_ = (k_) >> 2, p_ = (k_) & 3; \
                    const unsigned e_ = ids[(16 * w + 8 * h + 2 * p_ + (ci >> 3)) * 128 + 8 * G_ + (ci & 7)] & 0x3fffu; const int uo_ = (int)(e_ * (unsigned)PROW) + 16 * cg; \
                    B0 = __builtin_bit_cast(v4u, __builtin_amdgcn_raw_buffer_load_b128(rsu, uo_, 0, 0)); B1 = __builtin_bit_cast(v4u, __builtin_amdgcn_raw_buffer_load_b128(rsu, uo_ + 64, 0, 0)); \
                    B2 = __builtin_bit_cast(v4u, __builtin_amdgcn_raw_buffer_load_b128(rsu, uo_ + 128, 0, 0)); B3 = __builtin_bit_cast(v4u, __builtin_amdgcn_raw_buffer_load_b128(rsu, uo_ + 192, 0, 0)); \
                    B4 = __builtin_bit_cast(v4u, __builtin_amdgcn_raw_buffer_load_b128(rsu, uo_ + 256, 0, 0)); B5 = __builtin_bit_cast(v4u, __builtin_amdgcn_raw_buffer_load_b128(rsu, uo_ + 320, 0, 0)); \
                    B6 = __builtin_bit_cast(v4u, __builtin_amdgcn_raw_buffer_load_b128(rsu, uo_ + 384, 0, 0)); B7 = __builtin_bit_cast(v4u, __builtin_amdgcn_raw_buffer_load_b128(rsu, uo_ + 448, 0, 0)); \
                    S = __builtin_bit_cast(v2u_t, __builtin_amdgcn_raw_buffer_load_b64(rsu, uo_ + 512 - 8 * cg, 0, 0)); } while (0)
#define MF1(UB, S, j_) do { const v4u x0_ = *(const LAS v4u*)(uintptr_t)(xrd_ + 128 * (j_)), x1_ = *(const LAS v4u*)(uintptr_t)(xrd_ + 128 * (j_) + 64);     \
                    const v8i_t a_ = {(int)UB.x, (int)UB.y, (int)UB.z, (int)UB.w, 0, 0, 0, 0}, b_ = {(int)x0_.x, (int)x0_.y, (int)x0_.z, (int)x0_.w, (int)x1_.x, (int)x1_.y, (int)x1_.z, (int)x1_.w}; \
                    D_ = __builtin_amdgcn_mfma_scale_f32_16x16x128_f8f6f4(a_, b_, D_, 4, 0, (j_) & 3, (int)S[(j_) >> 2], 0, sbx_); } while (0)
#define STEP(C0, C1, C2, C3, C4, C5, C6, C7, SC_, N0, N1, N2, N3, N4, N5, N6, N7, SN_, k_) do { \
                    { const int k2_ = (k_) + 2 < 64 ? (k_) + 2 : 63; U_REQ(N0, N1, N2, N3, N4, N5, N6, N7, SN_, k2_); } \
                    const int G_ = (k_) >> 2, p_ = (k_) & 3; const int ebA_ = __builtin_amdgcn_readlane(eb_v, 2 * p_), ebB_ = __builtin_amdgcn_readlane(eb_v, 2 * p_ + 1); \
                    const int sbx_ = ((ci >> 3) ? ebB_ : ebA_) - 7; const unsigned xrd_ = xq8 + (2 * p_ + (ci >> 3)) * 1024 + cg * 16; \
                    f32x4 D_ = {0.f, 0.f, 0.f, 0.f}; \
                    MF1(C0, SC_, 0); MF1(C1, SC_, 1); MF1(C2, SC_, 2); MF1(C3, SC_, 3); MF1(C4, SC_, 4); MF1(C5, SC_, 5); MF1(C6, SC_, 6); MF1(C7, SC_, 7); \
                    { float d0_ = D_[0], d1_ = D_[1], d2_ = D_[2], d3_ = D_[3]; asm volatile("" : "+v"(d0_), "+v"(d1_), "+v"(d2_), "+v"(d3_)); D_ = (f32x4){d0_, d1_, d2_, d3_}; }     \
                    LAS unsigned* idc_ = ids + (16 * w + 8 * h + 2 * p_ + hf) * 128 + 8 * G_ + 4 * (cg & 1);       \
                    const v4u q_ = *(const LAS v4u*)idc_; pg8::f32x2 t0_ = {D_[0], D_[1]}, t1_ = {D_[2], D_[3]}; t0_ = pg8::gelu_pk(t0_); t1_ = pg8::gelu_pk(t1_); \
                    const v4u n_ = {(q_.x & 0xffffu) | (cvtpk(0.f, __uint_as_float(q_.x & 0xffff0000u) * t0_.x) & 0xffff0000u), (q_.y & 0xffffu) | (cvtpk(0.f, __uint_as_float(q_.y & 0xffff0000u) * t0_.y) & 0xffff0000u), \
                                    (q_.z & 0xffffu) | (cvtpk(0.f, __uint_as_float(q_.z & 0xffff0000u) * t1_.x) & 0xffff0000u), (q_.w & 0xffffu) | (cvtpk(0.f, __uint_as_float(q_.w & 0xffff0000u) * t1_.y) & 0xffff0000u)}; \
                    if (wr) *(LAS v4u*)idc_ = n_; } while (0)
                U_REQ(a0, a1, a2, a3, a4, a5, a6, a7, sa, 0); U_REQ(b0, b1, b2, b3, b4, b5, b6, b7, sb, 1);
#pragma nounroll
                for (int k = 0; k < 64; k += 3) {
                    STEP(a0, a1, a2, a3, a4, a5, a6, a7, sa, c0, c1, c2, c3, c4, c5, c6, c7, sc, k);
                    if (k + 1 >= 64) break;
                    STEP(b0, b1, b2, b3, b4, b5, b6, b7, sb, a0, a1, a2, a3, a4, a5, a6, a7, sa, k + 1);
                    STEP(c0, c1, c2, c3, c4, c5, c6, c7, sc, b0, b1, b2, b3, b4, b5, b6, b7, sb, k + 2);
                }
#undef STEP
#undef MF1
#undef U_REQ
                asm volatile("s_waitcnt lgkmcnt(0)" ::: "memory");
                } else { const int hv = code - 4;
        { const LAS unsigned* id0 = ids + (16 * w + 8 * hv + hf) * 128; const v4u e4_ = *(const LAS v4u*)id0, e5_ = *(const LAS v4u*)(id0 + 4);
          V_LD(vb0, vs0, e4_.x); V_LD(vb1, vs1, e4_.y); V_LD(vb2, vs2, e4_.z); V_LD(vb3, vs3, e4_.w); V_LD(vb4, vs4, e5_.x); V_LD(vb5, vs5, e5_.y); V_LD(vb6, vs6, e5_.z); V_LD(vb7, vs7, e5_.w); }
        for (int pp = 4 * hv; pp < 4 * hv + 4; ++pp) {
            const int tokl = 16 * w + 2 * pp + hf; const size_t tok = (size_t)tile * 128 + tokl;
            bf16* xrow = WSP(bf16, WS_XB) + tok * DM + 32 * bl;
            v4u xo[4];
#pragma unroll
            for (int j = 0; j < 4; ++j) xo[j] = ((const v4u*)xrow)[j];
            float acc[32];
#pragma unroll
            for (int i = 0; i < 32; ++i) acc[i] = 0.f;
            const LAS unsigned* idp = ids + tokl * 128;
            const LAS unsigned* idx = ids + (tokl + (pp < 4 * hv + 3 ? 2 : 0)) * 128;
#pragma nounroll
            for (int G = 0; G < 16; ++G) {
                const LAS unsigned* idn = G < 15 ? idp + 8 * (G + 1) : idx;
                const v4u ca = *(const LAS v4u*)(idp + 8 * G), cb = *(const LAS v4u*)(idp + 8 * G + 4), na = *(const LAS v4u*)idn, nb = *(const LAS v4u*)(idn + 4);
#define OPAQUE_ONE(x) int x; asm volatile("s_mov_b32 %0, 1" : "=s"(x))
                { OPAQUE_ONE(t_); if (t_) { V_FMA(vb0, vs0, ca.x); } V_LD(vb0, vs0, na.x); }
                { OPAQUE_ONE(t_); if (t_) { V_FMA(vb1, vs1, ca.y); } V_LD(vb1, vs1, na.y); }
                { OPAQUE_ONE(t_); if (t_) { V_FMA(vb2, vs2, ca.z); } V_LD(vb2, vs2, na.z); }
                { OPAQUE_ONE(t_); if (t_) { V_FMA(vb3, vs3, ca.w); } V_LD(vb3, vs3, na.w); }
                { OPAQUE_ONE(t_); if (t_) { V_FMA(vb4, vs4, cb.x); } V_LD(vb4, vs4, nb.x); }
                { OPAQUE_ONE(t_); if (t_) { V_FMA(vb5, vs5, cb.y); } V_LD(vb5, vs5, nb.y); }
                { OPAQUE_ONE(t_); if (t_) { V_FMA(vb6, vs6, cb.z); } V_LD(vb6, vs6, nb.z); }
                { OPAQUE_ONE(t_); if (t_) { V_FMA(vb7, vs7, cb.w); } V_LD(vb7, vs7, nb.w); }
#undef OPAQUE_ONE
            }
            f32x4 y[8]; float s2_ = 0.f;
            {
#pragma unroll
              for (int j = 0; j < 4; ++j) { const unsigned a_ = xo[j].x, b_ = xo[j].y, c_ = xo[j].z, d_ = xo[j].w;
                y[2 * j] = (f32x4){__uint_as_float(a_ << 16) + acc[8 * j], __uint_as_float(a_ & 0xffff0000u) + acc[8 * j + 1], __uint_as_float(b_ << 16) + acc[8 * j + 2], __uint_as_float(b_ & 0xffff0000u) + acc[8 * j + 3]};
                y[2 * j + 1] = (f32x4){__uint_as_float(c_ << 16) + acc[8 * j + 4], __uint_as_float(c_ & 0xffff0000u) + acc[8 * j + 5], __uint_as_float(d_ << 16) + acc[8 * j + 6], __uint_as_float(d_ & 0xffff0000u) + acc[8 * j + 7]}; }
#pragma unroll
              for (int j = 0; j < 8; ++j) s2_ += (y[j][0] * y[j][0] + y[j][1] * y[j][1]) + (y[j][2] * y[j][2] + y[j][3] * y[j][3]); }
            const float r2 = 1.0f / sqrtf(half32_sum(s2_) * (1.f / DM) + EPS);
            const int eo = 32 * bl;
            if (l < 3) {
#pragma unroll
                for (int j = 0; j < 4; ++j) ((v4u*)xrow)[j] = (v4u){cvtpk(y[2 * j][0], y[2 * j][1]), cvtpk(y[2 * j][2], y[2 * j][3]), cvtpk(y[2 * j + 1][0], y[2 * j + 1][1]), cvtpk(y[2 * j + 1][2], y[2 * j + 1][3])};
                { const float* gn = KA_IN(kp_, 2) + (l + 1) * DM + eo; bf16* xn = WSP(bf16, WS_XN) + tok * DM + eo;
#pragma unroll
                  for (int j = 0; j < 4; ++j) { const f32x4 n0 = y[2 * j] * r2 * ((const f32x4*)gn)[2 * j], n1 = y[2 * j + 1] * r2 * ((const f32x4*)gn)[2 * j + 1]; ((v4u*)xn)[j] = (v4u){cvtpk(n0[0], n0[1]), cvtpk(n0[2], n0[3]), cvtpk(n1[0], n1[1]), cvtpk(n1[2], n1[3])}; } }
                if (l == 1) { const float* gs = KA_IN(kp_, 15) + eo; bf16* xs = WSP(bf16, WS_MIX) + tok * DM + eo;
#pragma unroll
                  for (int j = 0; j < 4; ++j) { const f32x4 n0 = y[2 * j] * r2 * ((const f32x4*)gs)[2 * j], n1 = y[2 * j + 1] * r2 * ((const f32x4*)gs)[2 * j + 1]; ((v4u*)xs)[j] = (v4u){cvtpk(n0[0], n0[1]), cvtpk(n0[2], n0[3]), cvtpk(n1[0], n1[1]), cvtpk(n1[2], n1[3])}; } }
            } else {
                const float* gn = KA_IN(kp_, 17) + eo; float* oh = out_ + tok * DM + eo;
#pragma unroll
                for (int j = 0; j < 8; ++j) ((f32x4*)oh)[j] = y[j] * r2 * ((const f32x4*)gn)[j];
            }
        }
                }
            }
#undef V_LD
#undef V_FMA
        }
        }
        __syncthreads();
    }
}

struct Args { const float* in[18]; float* out; unsigned char* ws; int ph_lo, ph_hi; };
__global__ void __launch_bounds__(NWAVES * 64, 2) hyb_fwd(Args args) {
    { Frame F = make_frame();
      for (int u = F.tid; u < 1024 / 4; u += NWAVES * 64) ((LAS unsigned*)(F.lds + LDSCTL_OFF))[u] = 0u; }
    __syncthreads();
    if (__builtin_amdgcn_readfirstlane((int)threadIdx.x) >= 256) __builtin_amdgcn_s_setprio(1);
    const int lo = args.ph_lo, hi = args.ph_hi;
    if (hi - lo > 1) { Frame F = make_frame(); const auto kp_ = ka_fresh(F); (void)xcd_barrier_post((unsigned*)(KA_WS(kp_) + WS_CTL) + CW_BAR, F.MISC + 8); }
#ifndef PHMASK
#define PHMASK 0xff
#endif

#define PHM(b) ((PHMASK & (b)) != 0)
#define IN(k) (lo <= (k) && (k) < hi)
#define SEAM(k) do { if (IN(k) && IN((k) + 1)) { Frame F = make_frame(); const auto kq_ = ka_fresh(F); XcdBarrier b_; b_.bar = (unsigned*)(KA_WS(kq_) + WS_CTL) + CW_BAR; b_.x = xb_xcc_id(); b_.st = F.MISC + 8; xcd_barrier(b_); if (NREP(512) == 2) xcd_barrier(b_); } } while (0)

    if (PHM(1) && IN(0)) { for (int rep_ = 0; rep_ < NREP(1); ++rep_) { Frame F = make_frame(); p0_prologue(F); } }
    SEAM(0);
    for (int l = 0; l < 4; ++l) {
        const int pb = 1 + 6 * l;
        if (PHM(2) && IN(pb)) {
            const int njobs = (l == 0) ? 5 : (l == 2 ? 2 : 1);
            for (int rep_ = 0; rep_ < NREP(2); ++rep_)
            for (int jb = 0; jb < njobs; ++jb) {
                Frame F = make_frame(); const auto kp_ = ka_fresh(F); unsigned char* const ws_ = KA_WS(kp_);
                pg8::Gemm g; pg8::EpiProj E; int cid = F.bx;
                E.rope = WSP(float, WS_ROPE); E.sc = att::C2; E.hm = 0; E.hs = 0;
                const bool is_skv = (l == 2 && jb == 0), is_proj = (l == 2) ? (jb == 1) : (jb == 0);
                if (is_skv) { g = pg8::Gemm{WSP(pg8::bf16_t, WS_MIX), WSP(pg8::bf16_t, WS_WSKV), TT, SKVW, DM}; E.O = WSP(pg8::bf16_t, WS_SKV); E.ldc = SKVW; E.rope_lim = 9; E.scale_lim = 0; E.scale_tile = -1; }
                else if (is_proj) { g = pg8::Gemm{WSP(pg8::bf16_t, WS_XN), (l < 2 ? WSP(pg8::bf16_t, WS_WA) + (size_t)l * INW * DM : WSP(pg8::bf16_t, WS_WB) + (size_t)(l - 2) * INW * DM), TT, INW, DM};
                    E.O = WSP(pg8::bf16_t, WS_PROJ); E.ldc = INW; E.rope_lim = (l < 2) ? 6 : 9; E.scale_lim = (l < 2) ? 3 : 9; E.scale_tile = 9; }
                else { const int lm = jb - 1; g = pg8::Gemm{WSP(pg8::bf16_t, WS_MEMN) + (size_t)lm * MEMROWS * DM, WSP(pg8::bf16_t, WS_WMKV) + (size_t)lm * MKVW * DM, MEMROWS, MKVW, DM};
                    E.O = WSP(pg8::bf16_t, WS_MEMKV) + (size_t)lm * MEMROWS * MKVW; E.ldc = MKVW; E.rope_lim = 0; E.scale_lim = 0; E.scale_tile = -1; cid = (int)((F.bx + F.G - 16 * lm) % F.G); }
                pg8::StaticOrder S; S.init(g.M, g.N, F.G, cid);
                pg8::gemm_phase<pg8::EpiProj, pg8::StaticOrder, true, true>(F.lds + RING_OFF, g, S, E);
                __syncthreads();
            }
        }
        SEAM(pb);
        if (IN(pb + 1)) {
            if (__builtin_amdgcn_readfirstlane((int)threadIdx.x) >= 256) __builtin_amdgcn_s_setprio(1);
            Frame F = make_frame(); const auto kp_ = ka_fresh(F); unsigned char* const ws_ = KA_WS(kp_);
            const bf16* PROJ = WSP(bf16, WS_PROJ); bf16* MIX = WSP(bf16, WS_MIX);
            if (PHM(4) && l < 2) {
                for (int rep_ = 0; rep_ < NREP(4); ++rep_) {
                const float li = 0.8f - 0.6f * expf(-0.3f * (float)l);
                const float* lp = KA_IN(kp_, 4) + l * 256;
                const float d01 = wave_sum(lp[F.lane] * lp[64 + F.lane]), d23 = wave_sum(lp[128 + F.lane] * lp[192 + F.lane]);
                const float lam = expf(d01) - expf(d23) + li;
                const float* subg = KA_IN(kp_, 5) + l * 128;
                const int nper = (768 + F.G - 1) / F.G;
                for (int k = 0; k < nper; ++k) {
                    const int P = F.vcu * nper + k; if (P >= 768) break;
                    const int bh = P >> 4, s = P & 15;
                    diff_unit(F, bh / 6, bh % 6, s, PROJ, MIX, lam, 1.0f - li, subg);
                    diff_unit(F, bh / 6, bh % 6, 31 - s, PROJ, MIX, lam, 1.0f - li, subg);
                }
                }
            } else if (PHM(8)) {
                for (int rep2_ = 0; rep2_ < NREP(8); ++rep2_) {
                const bf16* SKV = WSP(bf16, WS_SKV);
                const int nper = (4608 + F.G - 1) / F.G;
                for (int k = 0; k < nper; ++k) {
                    const int U = F.vcu * nper + k; if (U >= 4608) break;
                    const int w16 = U & 15, bh = U >> 4, head = bh % 36, b = bh / 36, g = head / 12;
                    const int d = g == 0 ? 1 : (g == 1 ? 4 : 16), res = g == 0 ? 0 : (g == 1 ? (w16 >> 2) : w16), s = g == 0 ? w16 : (g == 1 ? (w16 & 3) : 0);
                    dil_strip(F, b, head, res, s, d, PROJ, SKV, WSP(bf16, WS_OG), WSP(float, WS_LSEG));
                }
                }
            }
            if (l < 2) { for (int rep3_ = 0; rep3_ < NREP(16); ++rep3_) if (PHM(16)) mem_attn_all(F, PROJ, WSP(bf16, WS_MEMKV) + (size_t)l * MEMROWS * MKVW, MIX); }
            asm volatile("s_waitcnt vmcnt(0) lgkmcnt(0)" ::: "memory"); __syncthreads();
        }
        SEAM(pb + 1);
        if (IN(pb + 2) && l >= 2) {
            if (__builtin_amdgcn_readfirstlane((int)threadIdx.x) >= 256) __builtin_amdgcn_s_setprio(1);
            Frame F = make_frame(); const auto kp_ = ka_fresh(F); unsigned char* const ws_ = KA_WS(kp_);
            if (PHM(8)) dil_combine_all(F, WSP(bf16, WS_OG), WSP(float, WS_LSEG), WSP(bf16, WS_MIX));
            for (int rep3_ = 0; rep3_ < NREP(16); ++rep3_) if (PHM(16)) mem_attn_all(F, WSP(bf16, WS_PROJ), WSP(bf16, WS_MEMKV) + (size_t)l * MEMROWS * MKVW, WSP(bf16, WS_MIX));
            asm volatile("s_waitcnt vmcnt(0) lgkmcnt(0)" ::: "memory"); __syncthreads();
        }
        if (l >= 2) SEAM(pb + 2);
        if (PHM(32) && IN(pb + 3)) {
            Frame F = make_frame(); const auto kp_ = ka_fresh(F); unsigned char* const ws_ = KA_WS(kp_);
            pg8::Gemm g{WSP(pg8::bf16_t, WS_MIX), WSP(pg8::bf16_t, WS_WOUT) + (size_t)l * DM * DM, TT, DM, DM};
            pg8::EpiRes E{WSP(pg8::bf16_t, WS_XB), WSP(float, WS_SS), DM};
            pg8::StaticOrder S; S.init(TT, DM, F.G, F.bx);
            pg8::gemm_phase<pg8::EpiRes, pg8::StaticOrder, true, true>(F.lds + RING_OFF, g, S, E);
            __syncthreads();
        }
        SEAM(pb + 3);
        if (PHM(64) && IN(pb + 4)) {
            Frame F = make_frame(); const auto kp_ = ka_fresh(F); unsigned char* const ws_ = KA_WS(kp_);
            pg8::Gemm g{WSP(pg8::bf16_t, WS_XB), WSP(pg8::bf16_t, WS_WPQ) + (size_t)l * PQW * DM, TT, PQW, DM};
            pg8::EpiScaleRow E{WSP(pg8::bf16_t, WS_PROJ), PQW, WSP(float, WS_SS), EPS};
            pg8::StaticOrder S; S.init(TT, PQW, F.G, F.bx);
            for (int rep_ = 0; rep_ < NREP(64); ++rep_) {
            pg8::gemm_phase<pg8::EpiScaleRow, pg8::StaticOrder, true, true>(F.lds + RING_OFF, g, S, E);
            __syncthreads(); }
        }
        SEAM(pb + 4);
        if (PHM(128) && IN(pb + 5)) { if (__builtin_amdgcn_readfirstlane((int)threadIdx.x) >= 256) __builtin_amdgcn_s_setprio(1); Frame F = make_frame(); peer_phase(F, l); }
        SEAM(pb + 5);
    }
#undef IN
#undef SEAM
}

#ifndef HYB_N_LAUNCHES
#define HYB_N_LAUNCHES 1
#endif
extern "C" void kernel_launch(void* const* d_in, const int* in_sizes, int n_in, void* d_out, int out_size, void* d_ws, size_t ws_size, hipStream_t stream) {
    static int grid = 0;
    if (grid == 0) {
        if (n_in != 18 || out_size != TT * DM || ws_size < WS_END) { fprintf(stderr, "kernel_launch: unexpected shapes (n_in %d, out %d, ws %zu)\n", n_in, out_size, ws_size); grid = -1; return; }
        int dev = 0, cus = 0, per_cu = 0;
        if (hipGetDevice(&dev) != hipSuccess || hipDeviceGetAttribute(&cus, hipDeviceAttributeMultiprocessorCount, dev) != hipSuccess) { grid = -1; return; }
        if (hipFuncSetAttribute((const void*)hyb_fwd, hipFuncAttributeMaxDynamicSharedMemorySize, LDS_BYTES) != hipSuccess) { fprintf(stderr, "kernel_launch: hipFuncSetAttribute failed\n"); grid = -1; return; }
        if (hipOccupancyMaxActiveBlocksPerMultiprocessor(&per_cu, (const void*)hyb_fwd, NWAVES * 64, LDS_BYTES) != hipSuccess || per_cu < 1) { fprintf(stderr, "kernel_launch: occupancy query says %d\n", per_cu); }
        (void)hipGetLastError();
        grid = cus;
    }
    if (grid < 0) return;
    (void)hipMemsetAsync((char*)d_ws + WS_CTL, 0, CTL_ZERO_BYTES, stream);
    Args a{};
    for (int i = 0; i < 18; ++i) a.in[i] = (const float*)d_in[i];
    a.out = (float*)d_out; a.ws = (unsigned char*)d_ws;
    if (HYB_N_LAUNCHES == 1) { a.ph_lo = 0; a.ph_hi = NPHASE; hipLaunchKernelGGL(hyb_fwd, dim3(grid), dim3(NWAVES * 64), LDS_BYTES, stream, a); }
    else { for (int p = 0; p < NPHASE; ++p) { a.ph_lo = p; a.ph_hi = p + 1; hipLaunchKernelGGL(hyb_fwd, dim3(grid), dim3(NWAVES * 64), LDS_BYTES, stream, a); } }
}
```

```cpp
#include <hip/hip_runtime.h>
#include <cstdio>
#include <cstdint>
#include <cmath>
template <int CTRL> __device__ __forceinline__ float dpp_addc(float v) { return v + __uint_as_float((unsigned)__builtin_amdgcn_update_dpp(0, (int)__float_as_uint(v), CTRL, 0xf, 0xf, true)); }
template <int CTRL> __device__ __forceinline__ float dpp_maxc(float v) { return __builtin_fmaxf(v, __uint_as_float((unsigned)__builtin_amdgcn_update_dpp(0, (int)__float_as_uint(v), CTRL, 0xf, 0xf, true))); }
__device__ __forceinline__ float xor16_sum(float v) { auto r = __builtin_amdgcn_permlane16_swap(__float_as_uint(v), __float_as_uint(v), false, false); return __uint_as_float(r[0]) + __uint_as_float(r[1]); }
__device__ __forceinline__ float xor32_sum(float v) { auto r = __builtin_amdgcn_permlane32_swap(__float_as_uint(v), __float_as_uint(v), false, false); return __uint_as_float(r[0]) + __uint_as_float(r[1]); }
__device__ __forceinline__ float xor16_get(float v, bool odd_row) { auto r = __builtin_amdgcn_permlane16_swap(__float_as_uint(v), __float_as_uint(v), false, false); return __uint_as_float(odd_row ? r[0] : r[1]); }
__device__ __forceinline__ float row16_sum(float v) { v = dpp_addc<0xB1>(v); v = dpp_addc<0x4E>(v); v = dpp_addc<0x141>(v); return dpp_addc<0x140>(v); }
__device__ __forceinline__ float half32_sum(float v) { return xor16_sum(row16_sum(v)); }
__device__ __forceinline__ float wave_sum_valu(float v) { return xor32_sum(half32_sum(v)); }
__device__ __forceinline__ float wave_max_valu(float v) {
    v = dpp_maxc<0xB1>(v); v = dpp_maxc<0x4E>(v); v = dpp_maxc<0x141>(v); v = dpp_maxc<0x140>(v);
    { auto r = __builtin_amdgcn_permlane16_swap(__float_as_uint(v), __float_as_uint(v), false, false); v = __builtin_fmaxf(__uint_as_float(r[0]), __uint_as_float(r[1])); }
    { auto r = __builtin_amdgcn_permlane32_swap(__float_as_uint(v), __float_as_uint(v), false, false); v = __builtin_fmaxf(__uint_as_float(r[0]), __uint_as_float(r[1])); }
    return v;
}
__device__ __forceinline__ float half32_max(float v) {
    v = dpp_maxc<0xB1>(v); v = dpp_maxc<0x4E>(v); v = dpp_maxc<0x141>(v); v = dpp_maxc<0x140>(v);
    auto r = __builtin_amdgcn_permlane16_swap(__float_as_uint(v), __float_as_uint(v), false, false); return __builtin_fmaxf(__uint_as_float(r[0]), __uint_as_float(r[1]));
}
namespace pg8 {
#define PG8_LAS __attribute__((address_space(3)))
typedef unsigned short bf16_t;
typedef short bf16x8 __attribute__((ext_vector_type(8)));
typedef float f32x4 __attribute__((ext_vector_type(4)));
typedef unsigned u32x4 __attribute__((ext_vector_type(4)));
constexpr int BM = 256, BK = 64, HALF = 128, HTB = HALF * BK * 2  , STAGE_BYTES = 8 * HTB, NXCD = 8, WGM = 8;

__host__ __device__ __forceinline__ int lds_byte(int r, int c) { const int st = (r >> 4) * 2 + (c >> 5), rr = r & 15, cc = c & 31, ob = rr * 64 + cc * 2; return st * 1024 + (ob ^ (((ob >> 9) & 1) << 5)); }
__host__ __device__ __forceinline__ void stage_rc(int b, int& R, int& C) { const int st = b / 1024, sb = b % 1024, swz = sb ^ (((sb >> 9) & 1) << 5); R = (st >> 1) * 16 + swz / 64; C = (st & 1) * 32 + (swz % 64) / 2; }
__host__ __device__ __forceinline__ int perm32(int rho) { const int n = rho >> 4, i = rho & 15; return 8 * (i >> 2) + 4 * n + (i & 3); }

struct Unit { int pm, pn; };
struct Gemm { const bf16_t* A; const bf16_t* Bt; int M, N, K; };

struct StaticOrder {
    int nM, nN, nwg, G, c;
    __host__ __device__ void init(int M, int N, int G_, int c_) { nM = M / BM; nN = N / BM; nwg = nM * nN; G = G_; c = c_; }
    __host__ __device__ bool next(int i, Unit& u) const {
        const long L = (long)i * G + c; if (L >= nwg) return false;
        int wgid = (int)L; { const int q = nwg / NXCD, r = nwg % NXCD, xcd = wgid % NXCD, off = wgid / NXCD; wgid = (xcd < r ? xcd * (q + 1) : r * (q + 1) + (xcd - r) * q) + off; }
        const int nig = WGM * nN, gid = wgid / nig, fm = gid * WGM, gsz = (nM - fm) < WGM ? (nM - fm) : WGM;
        u.pm = fm + ((wgid % nig) % gsz); u.pn = (wgid % nig) / gsz; return true;
    }
    __device__ __forceinline__ void a_ready(const Unit&) const {}
    __device__ __forceinline__ void done(const Unit&) const {}
};

__device__ __forceinline__ unsigned cvt_pk_bf16(float lo, float hi) { unsigned r; asm volatile("v_cvt_pk_bf16_f32 %0, %1, %2" : "=v"(r) : "v"(lo), "v"(hi)); return r; }
typedef float f32x2 __attribute__((ext_vector_type(2)));
__device__ __forceinline__ f32x2 gelu_pk(f32x2 v) {
    const f32x2 av = __builtin_elementwise_abs(v), d = av * 0.2316418882f + 1.0f;
    f32x2 t; t.x = __builtin_amdgcn_rcpf(d.x); t.y = __builtin_amdgcn_rcpf(d.y);
    f32x2 q = t * 0.5307027145f + (-0.7265760135f); q = q * t + 0.7107068705f; q = q * t + (-0.142248368f); q = q * t + 0.127414796f; q = q * t;
    const f32x2 s = (v * v) * (-0.72134752044f);
    f32x2 e; e.x = __builtin_amdgcn_exp2f(s.x); e.y = __builtin_amdgcn_exp2f(s.y);
    const f32x2 m = v * (q * e), r = v - m;
    f32x2 o; o.x = v.x < 0.f ? m.x : r.x; o.y = v.y < 0.f ? m.y : r.y; return o;
}


struct EpiProj {
    static constexpr bool PERM = true, AFTER_DRAIN = false;
    bf16_t* O; int ldc; const float* rope; int rope_lim, scale_lim, scale_tile; float sc; int hm; size_t hs;
    __device__ __forceinline__ void operator()(const f32x4 (&acc)[2][2][4][2], const Unit& u, int wr, int wc, int fr, int fq) const {
        const int row0 = u.pm * BM + wr * 64 + fr, col0 = u.pn * BM + wc * 32 + 8 * fq;
        const bool do_rope = (u.pn < rope_lim) && ((wc & 1) == 0);
        const float s = (u.pn < scale_lim || u.pn == scale_tile) ? sc : 1.f;
        const float sg = (fq == 0) ? -1.f : 1.f;
#pragma unroll
        for (int ai = 0; ai < 2; ++ai)
#pragma unroll
            for (int m = 0; m < 4; ++m) {
                const int row = row0 + ai * HALF + m * 16;
                f32x4 c0 = {1.f, 1.f, 1.f, 1.f}, c1 = c0, s0 = {0.f, 0.f, 0.f, 0.f}, s1 = s0;
                if (do_rope) { const f32x4* rp = (const f32x4*)(rope + (size_t)(row & 4095) * 16); c0 = rp[0]; c1 = rp[1]; s0 = rp[2]; s1 = rp[3]; }
                bf16_t* rowp = hm ? O + ((size_t)(row >> 12) * hm + (col0 >> 6)) * hs + (size_t)(row & 4095) * 64 + (col0 & 63) : O + (size_t)row * ldc + col0;
                const size_t bjstep = hm ? 2 * hs : (size_t)HALF;
#pragma unroll
                for (int bj = 0; bj < 2; ++bj) {
                    f32x4 v0 = acc[ai][bj][m][0], v1 = acc[ai][bj][m][1];
                    if (do_rope) {
                        f32x4 p0, p1;
#pragma unroll
                        for (int j = 0; j < 4; ++j) { p0[j] = xor16_get(v0[j], (fq & 1) != 0); p1[j] = xor16_get(v1[j], (fq & 1) != 0); }
                        if (fq < 2) { v0 = v0 * c0 + (p0 * s0) * sg; v1 = v1 * c1 + (p1 * s1) * sg; }
                    }
                    v0 = v0 * s; v1 = v1 * s;
                    u32x4 w; w.x = cvt_pk_bf16(v0[0], v0[1]); w.y = cvt_pk_bf16(v0[2], v0[3]); w.z = cvt_pk_bf16(v1[0], v1[1]); w.w = cvt_pk_bf16(v1[2], v1[3]);
                    *(u32x4*)(rowp + bj * bjstep) = w;
                }
            }
    }
};
struct EpiRes {
    static constexpr bool PERM = true, AFTER_DRAIN = false;
    bf16_t* XR; float* SS; int ldc;
    __device__ __forceinline__ void operator()(const f32x4 (&acc)[2][2][4][2], const Unit& u, int wr, int wc, int fr, int fq) const {
        const int row0 = u.pm * BM + wr * 64 + fr, col0 = u.pn * BM + wc * 32 + 8 * fq;
#pragma unroll
        for (int ai = 0; ai < 2; ++ai)
#pragma unroll
            for (int m = 0; m < 4; ++m) {
                const int row = row0 + ai * HALF + m * 16;
                float q = 0.f;
#pragma unroll
                for (int bj = 0; bj < 2; ++bj) {
                    bf16_t* xp = XR + (size_t)row * ldc + col0 + bj * HALF;
                    const u32x4 xw = *(const u32x4*)xp;
                    f32x4 x0 = {__uint_as_float(xw.x << 16), __uint_as_float(xw.x & 0xffff0000u), __uint_as_float(xw.y << 16), __uint_as_float(xw.y & 0xffff0000u)};
                    f32x4 x1 = {__uint_as_float(xw.z << 16), __uint_as_float(xw.z & 0xffff0000u), __uint_as_float(xw.w << 16), __uint_as_float(xw.w & 0xffff0000u)};
                    x0 = x0 + acc[ai][bj][m][0]; x1 = x1 + acc[ai][bj][m][1];
                    u32x4 w; w.x = cvt_pk_bf16(x0[0], x0[1]); w.y = cvt_pk_bf16(x0[2], x0[3]); w.z = cvt_pk_bf16(x1[0], x1[1]); w.w = cvt_pk_bf16(x1[2], x1[3]);
                    *(u32x4*)xp = w;
                    q += (x0[0] * x0[0] + x0[1] * x0[1]) + (x0[2] * x0[2] + x0[3] * x0[3]) + (x1[0] * x1[0] + x1[1] * x1[1]) + (x1[2] * x1[2] + x1[3] * x1[3]);
                }
                q = xor32_sum(xor16_sum(q));
                if (fq == 0) SS[(size_t)row * 16 + u.pn * 4 + wc] = q;
            }
    }
};
struct EpiScaleRow {
    static constexpr bool PERM = true, AFTER_DRAIN = false;
    bf16_t* O; int ldc; const float* SS; float eps;
    __device__ __forceinline__ void operator()(const f32x4 (&acc)[2][2][4][2], const Unit& u, int wr, int wc, int fr, int fq) const {
        const int row0 = u.pm * BM + wr * 64 + fr, col0 = u.pn * BM + wc * 32 + 8 * fq;
#pragma unroll
        for (int ai = 0; ai < 2; ++ai)
#pragma unroll
            for (int m = 0; m < 4; ++m) {
                const int row = row0 + ai * HALF + m * 16;
                const f32x4* sp = (const f32x4*)(SS + (size_t)row * 16);
                const f32x4 a = sp[0], b = sp[1], c = sp[2], d = sp[3];
                const float tot = (((a[0] + a[1]) + (a[2] + a[3])) + ((b[0] + b[1]) + (b[2] + b[3]))) + (((c[0] + c[1]) + (c[2] + c[3])) + ((d[0] + d[1]) + (d[2] + d[3])));
                const float rs = 1.0f / sqrtf(tot * (1.0f / 1024.0f) + eps);
                bf16_t* rowp = O + (size_t)row * ldc + col0;
#pragma unroll
                for (int bj = 0; bj < 2; ++bj) {
                    const f32x4 v0 = acc[ai][bj][m][0] * rs, v1 = acc[ai][bj][m][1] * rs;
                    u32x4 w; w.x = cvt_pk_bf16(v0[0], v0[1]); w.y = cvt_pk_bf16(v0[2], v0[3]); w.z = cvt_pk_bf16(v1[0], v1[1]); w.w = cvt_pk_bf16(v1[2], v1[3]);
                    *(u32x4*)(rowp + bj * HALF) = w;
                }
            }
    }
};

template <class Epi, class Sched, bool ALIGN_EPI = false, bool SP2 = false>
__device__ __forceinline__ void gemm_phase(PG8_LAS unsigned char* lds, const Gemm g, const Sched& S, const Epi& E) {
    int tid_ = threadIdx.x; asm volatile("" : "+v"(tid_));
    const int tid = tid_, wid = __builtin_amdgcn_readfirstlane(tid >> 6), lane = tid & 63, wr = wid >> 2, wc = wid & 3, fr = lane & 15, fq = lane >> 4;
    const int K = g.K, nt = K / BK;
    unsigned voffA[2], voffB[2];
#pragma unroll
    for (int i = 0; i < 2; ++i) { int R, C; stage_rc(tid * 16 + i * 8192, R, C); const int Rb = Epi::PERM ? ((R & ~31) + perm32(R & 31)) : R;
        voffA[i] = (unsigned)(R * K + C) * 2u; voffB[i] = (unsigned)(Rb * K + C) * 2u; }
    const size_t kstep = (size_t)(BK * 2);
    const size_t hstep = (size_t)HALF * K * 2;
    const size_t tstep = 2 * hstep;
    const unsigned ldsw = (unsigned)wid * 1024u;
    const int aoff = lds_byte(wr * 64 + fr, fq * 8), boff = lds_byte(wc * 32 + fr, fq * 8);
#define PG8_SA(b, h) (((b) * 2 + (h)) * HTB)
#define PG8_SB(b, h) ((4 + (b) * 2 + (h)) * HTB)
#define PG8_STAGE(bufoff, gbase, voff) do { _Pragma("unroll") for (int _i = 0; _i < 2; ++_i) \
        __builtin_amdgcn_global_load_lds((const unsigned*)((const char*)(gbase) + (voff)[_i]), (PG8_LAS unsigned*)(lds + (bufoff) + ldsw + _i * 8192), 16, 0, 0); } while (0)
#define PG8_LDA(dst, b, h) do { _Pragma("unroll") for (int m = 0; m < 4; ++m) _Pragma("unroll") for (int k = 0; k < 2; ++k) dst[m][k] = *(const PG8_LAS bf16x8*)(lds + PG8_SA(b, h) + aoff + m * 2048 + k * 1024); } while (0)
#define PG8_LDB(dst, b, h) do { _Pragma("unroll") for (int n = 0; n < 2; ++n) _Pragma("unroll") for (int k = 0; k < 2; ++k) dst[n][k] = *(const PG8_LAS bf16x8*)(lds + PG8_SB(b, h) + boff + n * 2048 + k * 1024); } while (0)
#define PG8_MMA(ai, bj, At, Bt) do { __builtin_amdgcn_s_setprio(1); _Pragma("unroll") for (int m = 0; m < 4; ++m) _Pragma("unroll") for (int n = 0; n < 2; ++n) _Pragma("unroll") for (int k = 0; k < 2; ++k) \
        acc[ai][bj][m][n] = __builtin_amdgcn_mfma_f32_16x16x32_bf16(Bt[n][k], At[m][k], acc[ai][bj][m][n], 0, 0, 0); __builtin_amdgcn_s_setprio(0); } while (0)
#define PG8_WAIT_V(n) asm volatile("s_waitcnt vmcnt(" #n ")" ::: "memory")
#define PG8_WAIT_L(n) asm volatile("s_waitcnt lgkmcnt(" #n ")" ::: "memory")
#define PG8_BAR __builtin_amdgcn_s_barrier()
#define PG8_SCHED __builtin_amdgcn_sched_barrier(0)
    Unit cur, nxt; int ui = 0;
    if (!S.next(0, cur)) return;
    f32x4 acc[2][2][4][2];
#pragma unroll
    for (int a = 0; a < 2; ++a)
#pragma unroll
        for (int b = 0; b < 2; ++b)
#pragma unroll
            for (int m = 0; m < 4; ++m)
#pragma unroll
                for (int n = 0; n < 2; ++n) acc[a][b][m][n] = (f32x4){0.f, 0.f, 0.f, 0.f};
    bf16x8 At[4][2], B0[2][2], B1[2][2];
    const char* cA = (const char*)g.A + (size_t)cur.pm * tstep; const char* cB = (const char*)g.Bt + (size_t)cur.pn * tstep;
    S.a_ready(cur);
    if constexpr (SP2) {
        PG8_STAGE(PG8_SB(0, 0), cB, voffB); PG8_STAGE(PG8_SB(0, 1), cB + hstep, voffB); PG8_STAGE(PG8_SA(0, 0), cA, voffA); PG8_STAGE(PG8_SA(0, 1), cA + hstep, voffA);
        if (wr == 1) PG8_BAR;
        PG8_WAIT_V(2); PG8_BAR;
        PG8_STAGE(PG8_SB(1, 0), cB + kstep, voffB); PG8_STAGE(PG8_SA(1, 0), cA + kstep, voffA); PG8_STAGE(PG8_SB(1, 1), cB + hstep + kstep, voffB);
        PG8_WAIT_V(6); PG8_BAR;
    } else {
        PG8_STAGE(PG8_SB(0, 0), cB, voffB); PG8_STAGE(PG8_SA(0, 0), cA, voffA); PG8_STAGE(PG8_SB(0, 1), cB + hstep, voffB); PG8_STAGE(PG8_SA(0, 1), cA + hstep, voffA);
        if (wr == 1) PG8_BAR;
        PG8_WAIT_V(4); PG8_BAR;
        PG8_STAGE(PG8_SB(1, 0), cB + kstep, voffB); PG8_STAGE(PG8_SA(1, 0), cA + kstep, voffA); PG8_STAGE(PG8_SB(1, 1), cB + hstep + kstep, voffB);
        PG8_WAIT_V(6); PG8_BAR;
    }
    for (;;) {
        const bool has_next = S.next(ui + 1, nxt);
        const char* nA = has_next ? (const char*)g.A + (size_t)nxt.pm * tstep : cA; const char* nB = has_next ? (const char*)g.Bt + (size_t)nxt.pn * tstep : cB;
        for (int t = 0; t < nt; t += 2) {
            const bool last = (t == nt - 2);
            const char* a1 = cA + (size_t)(t + 1) * kstep;
            const char* a2 = last ? nA : cA + (size_t)(t + 2) * kstep; const char* b2 = last ? nB : cB + (size_t)(t + 2) * kstep;
            const char* a3 = a2 + kstep; const char* b3 = b2 + kstep;
            if (last && has_next) S.a_ready(nxt);
            if constexpr (SP2) {
            PG8_LDB(B0, 0, 0); PG8_LDB(B1, 0, 1); PG8_SCHED; PG8_LDA(At, 0, 0); PG8_STAGE(PG8_SA(1, 1), a1 + hstep, voffA);
            PG8_WAIT_V(8); PG8_WAIT_L(0); PG8_BAR; PG8_MMA(0, 0, At, B0); PG8_MMA(0, 1, At, B1); PG8_BAR; PG8_SCHED;
            PG8_LDA(At, 0, 1); PG8_STAGE(PG8_SB(0, 0), b2, voffB); PG8_STAGE(PG8_SB(0, 1), b2 + hstep, voffB); PG8_STAGE(PG8_SA(0, 0), a2, voffA);
            PG8_WAIT_V(8); PG8_WAIT_L(0); PG8_BAR; PG8_MMA(1, 0, At, B0); PG8_MMA(1, 1, At, B1); PG8_BAR; PG8_SCHED;
            PG8_LDB(B0, 1, 0); PG8_LDB(B1, 1, 1); PG8_SCHED; PG8_LDA(At, 1, 0); PG8_STAGE(PG8_SA(0, 1), a2 + hstep, voffA);
            PG8_WAIT_V(8); PG8_WAIT_L(0); PG8_BAR; PG8_MMA(0, 0, At, B0); PG8_MMA(0, 1, At, B1); PG8_BAR; PG8_SCHED;
            PG8_LDA(At, 1, 1); PG8_STAGE(PG8_SB(1, 0), b3, voffB); PG8_STAGE(PG8_SB(1, 1), b3 + hstep, voffB); PG8_STAGE(PG8_SA(1, 0), a3, voffA);
            PG8_WAIT_V(8); PG8_WAIT_L(0); PG8_BAR; PG8_MMA(1, 0, At, B0); PG8_MMA(1, 1, At, B1); PG8_BAR; PG8_SCHED;
            } else {
            PG8_LDB(B0, 0, 0); PG8_SCHED; PG8_LDA(At, 0, 0); PG8_STAGE(PG8_SA(1, 1), a1 + hstep, voffA);
            PG8_WAIT_L(8); PG8_BAR; PG8_WAIT_L(0); PG8_MMA(0, 0, At, B0); PG8_BAR; PG8_SCHED;
            PG8_LDB(B1, 0, 1); PG8_STAGE(PG8_SB(0, 0), b2, voffB);
            PG8_BAR; PG8_WAIT_L(0); PG8_MMA(0, 1, At, B1); PG8_BAR;
            PG8_LDA(At, 0, 1); PG8_STAGE(PG8_SA(0, 0), a2, voffA);
            PG8_BAR; PG8_WAIT_L(0); PG8_MMA(1, 0, At, B0); PG8_BAR; PG8_SCHED;
            PG8_STAGE(PG8_SB(0, 1), b2 + hstep, voffB);
            PG8_WAIT_V(6); PG8_BAR; PG8_MMA(1, 1, At, B1); PG8_BAR;
            PG8_LDB(B0, 1, 0); PG8_SCHED; PG8_LDA(At, 1, 0); PG8_STAGE(PG8_SA(0, 1), a2 + hstep, voffA);
            PG8_WAIT_L(8); PG8_BAR; PG8_WAIT_L(0); PG8_MMA(0, 0, At, B0); PG8_BAR; PG8_SCHED;
            PG8_LDB(B1, 1, 1); PG8_STAGE(PG8_SB(1, 0), b3, voffB);
            PG8_BAR; PG8_WAIT_L(0); PG8_MMA(0, 1, At, B1); PG8_BAR;
            PG8_LDA(At, 1, 1); PG8_STAGE(PG8_SA(1, 0), a3, voffA);
            PG8_BAR; PG8_WAIT_L(0); PG8_MMA(1, 0, At, B0); PG8_BAR; PG8_SCHED;
            PG8_STAGE(PG8_SB(1, 1), b3 + hstep, voffB);
            PG8_WAIT_V(6); PG8_BAR; PG8_MMA(1, 1, At, B1); PG8_BAR;
            }
        }
        if constexpr (ALIGN_EPI) { if (wr == 0) PG8_BAR; }
        if constexpr (!Epi::AFTER_DRAIN) { E(acc, cur, wr, wc, fr, fq); S.done(cur); }
        if (!has_next) break;
#pragma unroll
        for (int a = 0; a < 2; ++a)
#pragma unroll
            for (int b = 0; b < 2; ++b)
#pragma unroll
                for (int m = 0; m < 4; ++m)
#pragma unroll
                    for (int n = 0; n < 2; ++n) acc[a][b][m][n] = (f32x4){0.f, 0.f, 0.f, 0.f};
        cur = nxt; cA = nA; cB = nB; ++ui;
        if constexpr (ALIGN_EPI) { if (wr == 1) PG8_BAR; }
    }
    PG8_WAIT_V(0);
    if constexpr (!ALIGN_EPI) { if (wr == 0) PG8_BAR; }
    PG8_BAR;
    if constexpr (Epi::AFTER_DRAIN) { E.fused(acc, cur, wr, wc, fr, fq, lds, wid, lane); S.done(cur); }
#undef PG8_SA
#undef PG8_SB
#undef PG8_STAGE
#undef PG8_LDA
#undef PG8_LDB
#undef PG8_MMA
#undef PG8_WAIT_V
#undef PG8_WAIT_L
#undef PG8_BAR
#undef PG8_SCHED
}
}
#define GAS __attribute__((address_space(1)))
#define LAS __attribute__((address_space(3)))
typedef unsigned short bf16;
typedef unsigned v4u __attribute__((ext_vector_type(4)));
typedef float f32x4 __attribute__((ext_vector_type(4)));
typedef short bf16x8 __attribute__((ext_vector_type(8)));
typedef GAS unsigned gu32;
typedef GAS unsigned long long gu64;
#define RLX_AGENT __ATOMIC_RELAXED, __HIP_MEMORY_SCOPE_AGENT
#define LDS_WAIT() asm volatile("s_waitcnt lgkmcnt(0)" ::: "memory")
#define VM_WAIT() asm volatile("s_waitcnt vmcnt(0)" ::: "memory")
__device__ __forceinline__ unsigned long long rt() { return __builtin_amdgcn_s_memrealtime(); }
__device__ __forceinline__ unsigned f2bf(float f) { unsigned u = __builtin_bit_cast(unsigned, f); return (u + 0x7fffu + ((u >> 16) & 1u)) >> 16; }
__device__ __forceinline__ unsigned pk2(float lo, float hi) { return f2bf(lo) | (f2bf(hi) << 16); }

namespace att {
typedef __attribute__((address_space(3))) const char* lds_cptr;
typedef __attribute__((address_space(3))) char* lds_ptr;
typedef __attribute__((address_space(3))) float* lds_fptr;
using s16x4 = __attribute__((ext_vector_type(4))) short;
using f32x16 = __attribute__((ext_vector_type(16))) float;
using u32x4 = __attribute__((ext_vector_type(4))) unsigned;
typedef short v4i16_t __attribute__((ext_vector_type(4)));
typedef float f32x2_t __attribute__((ext_vector_type(2))); typedef __bf16 bf16x2_t __attribute__((ext_vector_type(2)));
constexpr float C2 = 0.125f * 1.4426950408889634f;
__device__ __forceinline__ int crow(int r, int hi) { return (r & 3) + 8 * (r >> 2) + 4 * hi; }
__device__ __forceinline__ unsigned cvtpk_s(float lo, float hi) { f32x2_t v = {lo, hi}; bf16x2_t b = __builtin_convertvector(v, bf16x2_t); return __builtin_bit_cast(unsigned, b); }
__device__ __forceinline__ void glds16(const void* gsrc, unsigned lds_dst) { unsigned keep;
    asm volatile("s_mov_b32 %0, m0\n\ts_mov_b32 m0, %2\n\ts_nop 0\n\tglobal_load_lds_dwordx4 %1, off\n\ts_mov_b32 m0, %0" : "=&s"(keep) : "v"(gsrc), "s"(lds_dst) : "memory"); }
#define ATT_WAITV(N) asm volatile("s_waitcnt vmcnt(" #N ")" ::: "memory")
#define ATT_WAITL() asm volatile("s_waitcnt lgkmcnt(0)" ::: "memory")
#define ATT_BAR() asm volatile("s_waitcnt lgkmcnt(0)\n\ts_barrier" ::: "memory")
__device__ __forceinline__ s16x4 vtr(lds_cptr p) { return __builtin_bit_cast(s16x4, __builtin_amdgcn_ds_read_tr16_b64_v4i16((__attribute__((address_space(3))) v4i16_t*)p)); }

__device__ __forceinline__ int kswz(int row) { return (((row >> 1) & 1) << 2) | ((row >> 2) & 3); }
__device__ __forceinline__ void kread_offs(int (&ko)[4], int r32, int hi) {
#pragma unroll
    for (int d0 = 0; d0 < 4; ++d0) ko[d0] = r32 * 128 + (((2 * d0 + hi) ^ kswz(r32)) << 4);
}
__device__ __forceinline__ void qkt(f32x16& p0, f32x16& p1, lds_cptr kslot, const bf16x8* qr, const int (&ko)[4], float cinit) {
    f32x16 z;
#pragma unroll
    for (int r = 0; r < 16; ++r) z[r] = cinit;
    bf16x8 kf[8];
#pragma unroll
    for (int d0 = 0; d0 < 4; ++d0) { kf[2 * d0] = *(const __attribute__((address_space(3))) bf16x8*)(kslot + ko[d0]); kf[2 * d0 + 1] = *(const __attribute__((address_space(3))) bf16x8*)(kslot + ko[d0] + 4096); }
    __builtin_amdgcn_sched_barrier(0);
#pragma unroll
    for (int d0 = 0; d0 < 4; ++d0) {
        if (d0 == 0) { p0 = __builtin_amdgcn_mfma_f32_32x32x16_bf16(kf[0], qr[0], z, 0, 0, 0); p1 = __builtin_amdgcn_mfma_f32_32x32x16_bf16(kf[1], qr[0], z, 0, 0, 0); }
        else { p0 = __builtin_amdgcn_mfma_f32_32x32x16_bf16(kf[2 * d0], qr[d0], p0, 0, 0, 0); p1 = __builtin_amdgcn_mfma_f32_32x32x16_bf16(kf[2 * d0 + 1], qr[d0], p1, 0, 0, 0); }
    }
}
__device__ __forceinline__ int rowmax_bits(const f32x16& p0, const f32x16& p1) {
    int a, b;
    { const float f0 = p0[0], f1 = p1[0]; a = __float_as_int(f0); b = __float_as_int(f1); }
#pragma unroll
    for (int r = 1; r < 16; ++r) { const float f0 = p0[r], f1 = p1[r]; const int x = __float_as_int(f0), y = __float_as_int(f1); a = a > x ? a : x; b = b > y ? b : y; }
    const int m = a > b ? a : b;
    auto rr = __builtin_amdgcn_permlane32_swap((unsigned)m, (unsigned)m, false, false);
    return (int)rr[0] > (int)rr[1] ? (int)rr[0] : (int)rr[1];
}
__device__ __forceinline__ float rowmax(const f32x16& p0, const f32x16& p1) {
    float a = __builtin_fmaxf(p0[0], p1[0]), b = __builtin_fmaxf(p0[1], p1[1]);
#pragma unroll
    for (int r = 2; r < 16; r += 2) { a = __builtin_fmaxf(a, __builtin_fmaxf(p0[r], p1[r])); b = __builtin_fmaxf(b, __builtin_fmaxf(p0[r + 1], p1[r + 1])); }
    const float m = __builtin_fmaxf(a, b);
    auto rr = __builtin_amdgcn_permlane32_swap(__float_as_uint(m), __float_as_uint(m), false, false);
    return __builtin_fmaxf(__uint_as_float(rr[0]), __uint_as_float(rr[1]));
}
__device__ __forceinline__ float halfsum(float v) {
    auto rr = __builtin_amdgcn_permlane32_swap(__float_as_uint(v), __float_as_uint(v), false, false);
    return __uint_as_float(rr[0]) + __uint_as_float(rr[1]);
}
template <int NDB> __device__ __forceinline__ void vread_offs(int (&vo)[NDB][2], int lane) {
    const int hi = lane >> 5, g1 = (lane >> 4) & 1, q = (lane & 15) >> 2, p = lane & 3, cl = 2 * g1 + (p >> 1);
#pragma unroll
    for (int d0 = 0; d0 < NDB; ++d0)
#pragma unroll
        for (int h8 = 0; h8 < 2; ++h8) {
            const int row = 8 * h8 + 4 * hi + q, c = 4 * d0 + cl;
            if (NDB == 2) vo[d0][h8] = row * 128 + ((c ^ kswz(row)) << 4) + 8 * (p & 1);
            else vo[d0][h8] = row * 256 + ((c ^ ((row & 3) << 2)) << 4) + 8 * (p & 1);
        }
}
constexpr float SM_THR = 4.0f;
template <int NDB>
__device__ __forceinline__ void softmax_pv(f32x16& p0, f32x16& p1, float& m_run, float& l_run, bool first, f32x16 (&o)[NDB], lds_cptr vslot, const int (&vo)[NDB][2], lds_fptr wsf, int r32, int hi) {
    const int mb = rowmax_bits(p0, p1);
    if (__any(first || mb > __builtin_bit_cast(int, SM_THR))) {
        const float rm = rowmax(p0, p1);
        const float dl = first ? rm : __builtin_fmaxf(rm, 0.f);
        m_run += dl;
#pragma unroll
        for (int r = 0; r < 16; ++r) { p0[r] -= dl; p1[r] -= dl; }
        if (!first) {
            const float alpha = __builtin_amdgcn_exp2f(-dl);
            l_run *= alpha;
            if (hi == 0) wsf[r32] = alpha;
            ATT_WAITL();
#pragma unroll
            for (int g = 0; g < 4; ++g) {
                const f32x4 a4 = *(const __attribute__((address_space(3))) f32x4*)(wsf + 8 * g + 4 * hi);
#pragma unroll
                for (int d = 0; d < NDB; ++d) { o[d][4 * g + 0] *= a4[0]; o[d][4 * g + 1] *= a4[1]; o[d][4 * g + 2] *= a4[2]; o[d][4 * g + 3] *= a4[3]; }
            }
        }
    }
    float s = 0.f;
#pragma unroll
    for (int r = 0; r < 16; ++r) { p0[r] = __builtin_amdgcn_exp2f(p0[r]); p1[r] = __builtin_amdgcn_exp2f(p1[r]); s += p0[r] + p1[r]; }
    l_run += s;
    u32x4 pw[4];
#pragma unroll
    for (int k = 0; k < 2; ++k) { pw[k] = (u32x4){cvtpk_s(p0[8 * k], p0[8 * k + 1]), cvtpk_s(p0[8 * k + 2], p0[8 * k + 3]), cvtpk_s(p0[8 * k + 4], p0[8 * k + 5]), cvtpk_s(p0[8 * k + 6], p0[8 * k + 7])};
        pw[2 + k] = (u32x4){cvtpk_s(p1[8 * k], p1[8 * k + 1]), cvtpk_s(p1[8 * k + 2], p1[8 * k + 3]), cvtpk_s(p1[8 * k + 4], p1[8 * k + 5]), cvtpk_s(p1[8 * k + 6], p1[8 * k + 7])}; }
    s16x4 fa[8], fb[8];
#pragma unroll
    for (int ks = 0; ks < 4; ++ks) { fa[2 * ks] = vtr(vslot + vo[0][0] + ks * (1024 * NDB)); fa[2 * ks + 1] = vtr(vslot + vo[0][1] + ks * (1024 * NDB)); }
#pragma unroll
    for (int d0 = 0; d0 < NDB; ++d0) {
        __builtin_amdgcn_sched_barrier(0);
        if (d0 + 1 < NDB) {
#pragma unroll
            for (int ks = 0; ks < 4; ++ks) { if (d0 & 1) { fa[2 * ks] = vtr(vslot + vo[d0 + 1 < NDB ? d0 + 1 : 0][0] + ks * (1024 * NDB)); fa[2 * ks + 1] = vtr(vslot + vo[d0 + 1 < NDB ? d0 + 1 : 0][1] + ks * (1024 * NDB)); }
                else { fb[2 * ks] = vtr(vslot + vo[d0 + 1 < NDB ? d0 + 1 : 0][0] + ks * (1024 * NDB)); fb[2 * ks + 1] = vtr(vslot + vo[d0 + 1 < NDB ? d0 + 1 : 0][1] + ks * (1024 * NDB)); } }
        }
        __builtin_amdgcn_sched_barrier(0);
#pragma unroll
        for (int ks = 0; ks < 4; ++ks) {
            const s16x4 lo = (d0 & 1) ? fb[2 * ks] : fa[2 * ks], hh = (d0 & 1) ? fb[2 * ks + 1] : fa[2 * ks + 1];
            const bf16x8 vb = (bf16x8){lo[0], lo[1], lo[2], lo[3], hh[0], hh[1], hh[2], hh[3]};
            o[d0] = __builtin_amdgcn_mfma_f32_32x32x16_bf16(__builtin_bit_cast(bf16x8, pw[ks]), vb, o[d0], 0, 0, 0);
        }
    }
}
template <int NDB>
__device__ __forceinline__ void pv_only(f32x16 (&o)[NDB], const u32x4 (&pw)[4], lds_cptr vslot, const int (&vo)[NDB][2]) {
#pragma unroll
    for (int d0 = 0; d0 < NDB; ++d0)
#pragma unroll
        for (int ks = 0; ks < 4; ++ks) {
            const s16x4 lo = vtr(vslot + vo[d0][0] + ks * (1024 * NDB)), hh = vtr(vslot + vo[d0][1] + ks * (1024 * NDB));
            const bf16x8 vb = (bf16x8){lo[0], lo[1], lo[2], lo[3], hh[0], hh[1], hh[2], hh[3]};
            o[d0] = __builtin_amdgcn_mfma_f32_32x32x16_bf16(__builtin_bit_cast(bf16x8, pw[ks]), vb, o[d0], 0, 0, 0);
        }
}
template <int NDB>
__device__ __forceinline__ float finish_o(float l_run, f32x16 (&o)[NDB], lds_fptr wsf, int r32, int hi) {
    const float l = halfsum(l_run);
    if (hi == 0) wsf[32 + r32] = 1.0f / l;
    ATT_WAITL();
#pragma unroll
    for (int g = 0; g < 4; ++g) {
        const f32x4 a4 = *(const __attribute__((address_space(3))) f32x4*)(wsf + 32 + 8 * g + 4 * hi);
#pragma unroll
        for (int d = 0; d < NDB; ++d) { o[d][4 * g + 0] *= a4[0]; o[d][4 * g + 1] *= a4[1]; o[d][4 * g + 2] *= a4[2]; o[d][4 * g + 3] *= a4[3]; }
    }
    return l;
}
}

constexpr int NWAVES = 8;
constexpr int NB = 8, SEQ = 4096, DM = 1024, TT = NB * SEQ;
constexpr int MEMT = 256, MEMROWS = NB * MEMT;
constexpr int INW = 2560, SKVW = 4608, PQW = 2048, MKVW = 512;
constexpr int NEXP = 16384;
constexpr float EPS = 1e-5f;
constexpr int NPHASE = 25;

constexpr size_t MiB = 1u << 20;
constexpr size_t WS_CTL = 0, CTL_ZERO_BYTES = 1 * MiB;
constexpr size_t WS_WA = 1 * MiB, WS_WB = 11 * MiB, WS_WMKV = 21 * MiB, WS_WOUT = 25 * MiB, WS_WPQ = 33 * MiB, WS_WSKV = 49 * MiB, WS_PKEYS = 58 * MiB, WS_ROPE = 60 * MiB, WS_SS = 61 * MiB, WS_MEMKV = 63 * MiB;
constexpr size_t WS_PU = 96 * MiB, WS_PV = 160 * MiB;
constexpr int PROW = 544, PVROW = 512;
constexpr size_t WS_PSC = 80 * MiB;
constexpr size_t WS_XN = 352 * MiB, WS_XB = 416 * MiB, WS_PROJ = 480 * MiB, WS_MIX = 640 * MiB, WS_SKV = 704 * MiB, WS_END = 992 * MiB;
constexpr size_t WS_MEMN = WS_SKV;
constexpr size_t WS_OG = 224 * MiB;
constexpr size_t WS_LSEG = 368 * MiB;
static_assert(WS_OG + (size_t)TT * 2304 * 2 <= WS_LSEG && WS_LSEG + (size_t)TT * 36 * 4 <= WS_XB + 64 * MiB && WS_OG >= WS_PV + 50 * MiB, "OG scratch");
constexpr int CW_BAR = 4096;

constexpr int RING_OFF = 0, RING_BYTES = 131072;
constexpr int LDSCTL_OFF = RING_BYTES, MISC_OFF = LDSCTL_OFF + 320;
constexpr int PEER_SCR = LDSCTL_OFF + 1024;
constexpr int LDS_BYTES = 163840;
static_assert(PEER_SCR + 8 * 2048 <= LDS_BYTES, "LDS map");

#define XB_TMO      128
#define XB_XCNT(j)  (256  + 64 * (j))
#define XB_XSUB(j)  (1280 + 64 * (j))
#define XB_XGEN(j)  (2304 + 64 * (j))
#define XB_TOP      3328
#define XB_TOPGEN   3392
#define XCD_BAR_WORDS 3456
#define XB_SPIN_CAP (1u << 18)

__device__ __forceinline__ unsigned xb_ld(unsigned* p)              { return __hip_atomic_load(p, __ATOMIC_RELAXED, __HIP_MEMORY_SCOPE_AGENT); }
__device__ __forceinline__ unsigned xb_add(unsigned* p, unsigned v) { return __hip_atomic_fetch_add(p, v, __ATOMIC_RELAXED, __HIP_MEMORY_SCOPE_AGENT); }
__device__ __forceinline__ unsigned xb_xcc_id() { return (unsigned)__builtin_amdgcn_s_getreg((3 << 11) | 20) & 0xFu; }
#define XB_SPIN(cond, bar) do { unsigned _sp = 0; while (cond) { __builtin_amdgcn_s_sleep(1); \
    if ((++_sp & 255u) == 0u) { if (xb_ld(&(bar)[XB_TMO])) break; if (_sp > XB_SPIN_CAP) { atomicAdd(&(bar)[XB_TMO], 1u); break; } } } } while (0)

struct XcdBarrier {
    unsigned* bar; unsigned x;
    volatile LAS unsigned* st;
};

__device__ __forceinline__ XcdBarrier xcd_barrier_post(unsigned* bar, volatile LAS unsigned* st) {
    XcdBarrier b; b.bar = bar; b.x = xb_xcc_id(); b.st = st;
    if (threadIdx.x == 0) (void)xb_add(&bar[XB_XCNT(b.x)], 1u);
    return b;
}
__device__ __forceinline__ void xcd_barrier_complete(unsigned* bar, unsigned x, unsigned& nloc, unsigned& nx) {
    const unsigned G = gridDim.x * gridDim.y * gridDim.z;
    unsigned sum, cnt, mine, sp = 0u;
    for (;;) {
        sum = 0u; cnt = 0u; mine = 0u;
#pragma unroll
        for (unsigned j = 0; j < 16; ++j) { const unsigned c = xb_ld(&bar[XB_XCNT(j)]); sum += c; cnt += (c > 0u) ? 1u : 0u; mine = (j == x) ? c : mine; }
        if (sum == G) break;
        __builtin_amdgcn_s_sleep(1);
        if ((++sp & 255u) == 0u) { if (xb_ld(&bar[XB_TMO])) break; if (sp > XB_SPIN_CAP) { atomicAdd(&bar[XB_TMO], 1u); break; } }
    }
    nloc = mine > 0u ? mine : 1u; nx = cnt > 0u ? cnt : 1u;
}

__device__ __forceinline__ void xcd_barrier(const XcdBarrier& b) {
    asm volatile("s_waitcnt vmcnt(0)" ::: "memory");
    __syncthreads();
    if (threadIdx.x == 0) {
        unsigned* bar = b.bar;
        __builtin_amdgcn_s_waitcnt(0);
        unsigned nloc = b.st[0], nx = b.st[1];
        if (nloc == 0u) { xcd_barrier_complete(bar, b.x, nloc, nx); b.st[0] = nloc; b.st[1] = nx; }
        const unsigned old = xb_add(&bar[XB_XSUB(b.x)], 1u);
        const unsigned gen = old / nloc;
        if (old + 1u == (gen + 1u) * nloc) {
            __builtin_amdgcn_fence(__ATOMIC_RELEASE, "agent");
            asm volatile("s_waitcnt vmcnt(0)" ::: "memory");
            const unsigned og = xb_add(&bar[XB_TOP], 1u);
            const unsigned tg = og / nx;
            if (og + 1u == (tg + 1u) * nx) xb_add(&bar[XB_TOPGEN], 1u);
            else XB_SPIN(xb_ld(&bar[XB_TOPGEN]) == tg, bar);
            __builtin_amdgcn_fence(__ATOMIC_ACQUIRE, "agent");
            xb_add(&bar[XB_XGEN(b.x)], 1u);
            asm volatile("s_waitcnt vmcnt(0)" ::: "memory");
        } else {
            XB_SPIN(xb_ld(&bar[XB_XGEN(b.x)]) == gen, bar);
            __builtin_amdgcn_fence(__ATOMIC_ACQUIRE, "agent");
            asm volatile("s_waitcnt vmcnt(0)" ::: "memory");
        }
    }
    __syncthreads();
}

struct Frame {
    LAS unsigned char* lds;
    volatile LAS unsigned* MISC;
    int tid, lane, wave, vcu, G, bx;
    const unsigned char __attribute__((address_space(4)))* ka;
};
__device__ __forceinline__ Frame make_frame() {
    extern __shared__ __attribute__((aligned(16))) unsigned char lds_dyn_[];
    Frame F; int tid = threadIdx.x, bx = blockIdx.x, G = gridDim.x;
    asm volatile("" : "+v"(tid)); asm volatile("" : "+s"(bx), "+s"(G));
    F.lds = (LAS unsigned char*)lds_dyn_; F.MISC = (volatile LAS unsigned*)(F.lds + MISC_OFF);
    F.tid = tid; F.lane = tid & 63; F.wave = __builtin_amdgcn_readfirstlane(tid >> 6);
    F.G = G; F.vcu = (G % 8 == 0) ? (bx % 8) * (G / 8) + bx / 8 : bx; F.bx = bx;
    F.ka = (const unsigned char __attribute__((address_space(4)))*)__builtin_amdgcn_kernarg_segment_ptr();
    return F;
}
__device__ __forceinline__ const unsigned char __attribute__((address_space(4)))* ka_fresh(const Frame& F) { const unsigned char __attribute__((address_space(4)))* p = F.ka; asm volatile("" : "+s"(p)); return p; }
#define KA_IN(kp, i) (*(const float* const __attribute__((address_space(4)))*)((kp) + 8 * (i)))
#define KA_OUT(kp) (*(float* const __attribute__((address_space(4)))*)((kp) + 144))
#define KA_WS(kp) (*(unsigned char* const __attribute__((address_space(4)))*)((kp) + 152))
#define WSP(T, off) ((T*)(ws_ + (off)))
__device__ __forceinline__ float wave_sum(float v) { return wave_sum_valu(v); }
__device__ __forceinline__ unsigned cvtpk(float lo, float hi) { return att::cvtpk_s(lo, hi); }

__device__ __forceinline__ void p0_transpose_item(const float* W, int K, int N, bf16* WT, const float* gain, LAS float* scr, int item, int lane) {
    const int nblk = N / 32, kb = item / nblk, nb = item % nblk, k0 = 64 * kb, n0 = 32 * nb;
#pragma unroll 8
    for (int i = 0; i < 32; ++i) { const int kk = 2 * i + (lane >> 5); float w = W[(size_t)(k0 + kk) * N + n0 + (lane & 31)]; if (gain) w *= gain[k0 + kk]; scr[kk * 33 + (lane & 31)] = w; }
    LDS_WAIT(); asm volatile("" ::: "memory");
    const int c = lane & 7;
#pragma unroll
    for (int j = 0; j < 4; ++j) { const int n = (lane >> 3) + 8 * j; const LAS float* s = scr + (8 * c) * 33 + n;
        v4u o; o.x = cvtpk(s[0 * 33], s[1 * 33]); o.y = cvtpk(s[2 * 33], s[3 * 33]); o.z = cvtpk(s[4 * 33], s[5 * 33]); o.w = cvtpk(s[6 * 33], s[7 * 33]);
        *(GAS v4u*)(WT + (size_t)(n0 + n) * K + k0 + 8 * c) = o; }
    LDS_WAIT(); asm volatile("" ::: "memory");
}
__device__ __forceinline__ void cvt_row(const float* src, bf16* dst, int lane) {
    const GAS f32x4* s = (const GAS f32x4*)src + lane; GAS unsigned long long* d = (GAS unsigned long long*)dst + lane;
    f32x4 v[4];
#pragma unroll
    for (int j = 0; j < 4; ++j) v[j] = s[64 * j];
#pragma unroll
    for (int j = 0; j < 4; ++j) d[64 * j] = (unsigned long long)cvtpk(v[j].x, v[j].y) | ((unsigned long long)cvtpk(v[j].z, v[j].w) << 32);
}
template <bool PERM> __device__ __forceinline__ void cvt_2rows_fp4(const float* src, unsigned char* dst, int lane) {
    const int l = lane & 31, h = lane >> 5;
    const GAS f32x4* s = (const GAS f32x4*)(src + (size_t)h * DM + 32 * l);
    f32x4 v[8]; float am = 0.f;
#pragma unroll
    for (int j = 0; j < 8; ++j) { v[j] = s[j]; am = __builtin_fmaxf(am, __builtin_fmaxf(__builtin_fmaxf(__builtin_fabsf(v[j].x), __builtin_fabsf(v[j].y)), __builtin_fmaxf(__builtin_fabsf(v[j].z), __builtin_fabsf(v[j].w)))); }
    const unsigned tb = __float_as_uint(am * (1.0f / 6.0f));
    int eb = (int)(tb >> 23) + ((tb & 0x7fffffu) ? 1 : 0); eb = eb < 1 ? 1 : (eb > 254 ? 254 : eb);
    const float sc = __uint_as_float((unsigned)eb << 23);
    unsigned p[4];
#pragma unroll
    for (int k = 0; k < 4; ++k) { unsigned w = 0u;
        w = __builtin_amdgcn_cvt_scalef32_pk_fp4_f32(w, v[2 * k].x, v[2 * k].y, sc, 0); w = __builtin_amdgcn_cvt_scalef32_pk_fp4_f32(w, v[2 * k].z, v[2 * k].w, sc, 1);
        w = __builtin_amdgcn_cvt_scalef32_pk_fp4_f32(w, v[2 * k + 1].x, v[2 * k + 1].y, sc, 2); w = __builtin_amdgcn_cvt_scalef32_pk_fp4_f32(w, v[2 * k + 1].z, v[2 * k + 1].w, sc, 3); p[k] = w; }
    unsigned char* d = dst + (size_t)h * PROW;
    *(GAS v4u*)(d + 16 * l) = (v4u){p[0], p[1], p[2], p[3]};
    d[512 + (PERM ? 8 * (l & 3) + (l >> 2) : l)] = (unsigned char)eb;
}
__device__ __forceinline__ void cvt_2rows_fp4r(const float* src, unsigned char* dst, float* sc, int lane) {
    const int l = lane & 31, h = lane >> 5;
    const GAS f32x4* s = (const GAS f32x4*)(src + (size_t)h * DM + 32 * l);
    f32x4 v[8]; float am = 0.f;
#pragma unroll
    for (int j = 0; j < 8; ++j) { v[j] = s[j]; am = __builtin_fmaxf(am, __builtin_fmaxf(__builtin_fmaxf(__builtin_fabsf(v[j].x), __builtin_fabsf(v[j].y)), __builtin_fmaxf(__builtin_fabsf(v[j].z), __builtin_fabsf(v[j].w)))); }
    am = __builtin_fmaxf(half32_max(am), 1e-30f);
    const float scl = am * (1.0f / 6.0f), inv = 6.0f / am;
    unsigned p[4];
#pragma unroll
    for (int k = 0; k < 4; ++k) { unsigned w = 0u;
        w = __builtin_amdgcn_cvt_scalef32_pk_fp4_f32(w, v[2 * k].x * inv, v[2 * k].y * inv, 1.0f, 0); w = __builtin_amdgcn_cvt_scalef32_pk_fp4_f32(w, v[2 * k].z * inv, v[2 * k].w * inv, 1.0f, 1);
        w = __builtin_amdgcn_cvt_scalef32_pk_fp4_f32(w, v[2 * k + 1].x * inv, v[2 * k + 1].y * inv, 1.0f, 2); w = __builtin_amdgcn_cvt_scalef32_pk_fp4_f32(w, v[2 * k + 1].z * inv, v[2 * k + 1].w * inv, 1.0f, 3); p[k] = w; }
    *(GAS v4u*)(dst + (size_t)h * PVROW + 16 * l) = (v4u){p[0], p[1], p[2], p[3]};
    if (l == 0) sc[h] = scl;
}
__device__ __forceinline__ void rms_row(const float* xrow, const float* g, bf16* orow, bf16* cp, int lane) {
    const GAS f32x4* xr = (const GAS f32x4*)xrow + lane; const GAS f32x4* gr = (const GAS f32x4*)g + lane;
    f32x4 v[4]; float s = 0.f;
#pragma unroll
    for (int j = 0; j < 4; ++j) { v[j] = xr[64 * j]; s += (v[j].x * v[j].x + v[j].y * v[j].y) + (v[j].z * v[j].z + v[j].w * v[j].w); }
    if (cp) { GAS unsigned long long* c = (GAS unsigned long long*)cp + lane;
#pragma unroll
        for (int j = 0; j < 4; ++j) c[64 * j] = (unsigned long long)cvtpk(v[j].x, v[j].y) | ((unsigned long long)cvtpk(v[j].z, v[j].w) << 32); }
    const float rstd = 1.0f / sqrtf(wave_sum(s) * (1.f / DM) + EPS);
    GAS unsigned long long* o8 = (GAS unsigned long long*)orow + lane;
#pragma unroll
    for (int j = 0; j < 4; ++j) { const f32x4 gg = gr[64 * j]; o8[64 * j] = (unsigned long long)cvtpk(v[j].x * rstd * gg.x, v[j].y * rstd * gg.y) | ((unsigned long long)cvtpk(v[j].z * rstd * gg.z, v[j].w * rstd * gg.w) << 32); }
}
__device__ __forceinline__ void p0_prologue(Frame& F) {
    const auto kp_ = ka_fresh(F); unsigned char* const ws_ = KA_WS(kp_); float* const out_ = KA_OUT(kp_);
#define FIN(i) KA_IN(kp_, i)
    LAS float* scr = (LAS float*)(F.lds + RING_OFF + F.wave * 16384);
    const int gw = F.vcu * NWAVES + F.wave, NGW = F.G * NWAVES, lane = F.lane;
    constexpr int I_IN = 16 * (INW / 32), I_MKV = 16 * (MKVW / 32), I_OUT = 16 * (DM / 32), I_PQ = 16 * (PQW / 32), I_SKV = 16 * (SKVW / 32);
    constexpr int E0 = 2 * I_IN, E1 = E0 + 2 * I_IN, E2 = E1 + 4 * I_MKV, E3 = E2 + 4 * I_OUT, E4 = E3 + 4 * I_PQ, E5 = E4 + I_SKV;
    for (int it = gw; it < E5; it += NGW) {
        if (it < E0) { const int l = it / I_IN, r = it % I_IN; p0_transpose_item(FIN(3) + (size_t)l * DM * INW, DM, INW, WSP(bf16, WS_WA) + (size_t)l * INW * DM, nullptr, scr, r, lane); }
        else if (it < E1) { const int q = it - E0, l = q / I_IN, r = q % I_IN; p0_transpose_item(FIN(6) + (size_t)l * DM * INW, DM, INW, WSP(bf16, WS_WB) + (size_t)l * INW * DM, nullptr, scr, r, lane); }
        else if (it < E2) { const int q = it - E1, l = q / I_MKV, r = q % I_MKV; p0_transpose_item(FIN(8) + (size_t)l * DM * MKVW, DM, MKVW, WSP(bf16, WS_WMKV) + (size_t)l * MKVW * DM, nullptr, scr, r, lane); }
        else if (it < E3) { const int q = it - E2, l = q / I_OUT, r = q % I_OUT; p0_transpose_item(FIN(9) + (size_t)l * DM * DM, DM, DM, WSP(bf16, WS_WOUT) + (size_t)l * DM * DM, nullptr, scr, r, lane); }
        else if (it < E4) { const int q = it - E3, l = q / I_PQ, r = q % I_PQ; p0_transpose_item(FIN(11) + (size_t)l * DM * PQW, DM, PQW, WSP(bf16, WS_WPQ) + (size_t)l * PQW * DM, FIN(10) + l * DM, scr, r, lane); }
        else { const int r = it - E4; p0_transpose_item(FIN(16), DM, SKVW, WSP(bf16, WS_WSKV), nullptr, scr, r, lane); }
    }
    for (int r2 = gw; r2 < 2 * NEXP; r2 += NGW) { cvt_2rows_fp4r(FIN(13) + (size_t)r2 * 2 * DM, WSP(unsigned char, WS_PU) + (size_t)r2 * 2 * PVROW, WSP(float, WS_PSC + 512 * 1024) + (size_t)r2 * 2, lane); cvt_2rows_fp4r(FIN(14) + (size_t)r2 * 2 * DM, WSP(unsigned char, WS_PV) + (size_t)r2 * 2 * PVROW, WSP(float, WS_PSC) + (size_t)r2 * 2, lane); }
    for (int r = gw; r < 1024; r += NGW) cvt_row(FIN(12) + (size_t)r * 1024, WSP(bf16, WS_PKEYS) + (size_t)r * 1024, lane);
    for (int e = gw * 64 + lane; e < SEQ * 8; e += NGW * 64) { const int t = e >> 3, i = e & 7;
        const double ang = (double)t * pow(500000.0, -(double)i / 8.0);
        WSP(float, WS_ROPE)[t * 16 + i] = (float)cos(ang); WSP(float, WS_ROPE)[t * 16 + 8 + i] = (float)sin(ang); }
    for (int r = gw; r < 4 * MEMROWS; r += NGW) { const int l = r / MEMROWS, m = r % MEMROWS; rms_row(FIN(1) + (size_t)m * DM, FIN(7) + l * DM, WSP(bf16, WS_MEMN) + (size_t)r * DM, nullptr, lane); }
    for (int m = gw; m < TT; m += NGW) rms_row(FIN(0) + (size_t)m * DM, FIN(2), WSP(bf16, WS_XN) + (size_t)m * DM, WSP(bf16, WS_XB) + (size_t)m * DM, lane);
}
#undef FIN

__device__ __forceinline__ void diff_unit(Frame& F, int b, int h, int ib, const bf16* PROJ, bf16* MIX, float lam, float oml, const float* subg) {
    using namespace att;
    const int lane = F.lane, r32 = lane & 31, hi = lane >> 5, w = F.wave, p = w >> 2, wq = w & 3;
    const lds_cptr L = (lds_cptr)(F.lds + RING_OFF);
    const unsigned lds0 = (unsigned)(uintptr_t)(F.lds + RING_OFF);
    lds_fptr wsf = (lds_fptr)(F.lds + RING_OFF + 98304 + w * 256);
    const size_t rb = (size_t)b * SEQ;
    const bf16* Qw = PROJ + (rb + 128 * ib + 32 * wq + r32) * INW + (2 * h + p) * 64;
    const bf16* Kg = PROJ + rb * INW + 768 + (2 * h) * 64;
    const bf16* Vg = PROJ + rb * INW + 1536 + h * 128;
    const int NT = 2 * (ib + 1);
    const int krow_ = 8 * w + (lane >> 3), kch_ = (lane & 7) ^ kswz(krow_);
    const bf16* ksrc0 = Kg + (size_t)krow_ * INW + kch_ * 8;
    const bf16* ksrc1 = ksrc0 + 64;
    const int vrow_ = 8 * w + (lane >> 4), vch_ = (lane & 15) ^ ((vrow_ & 3) << 2);
    const bf16* vsrc0 = Vg + (size_t)vrow_ * INW + vch_ * 8;
    const bf16* vsrc1 = vsrc0 + (size_t)4 * INW;
#define DIFF_ISSUE(t, slot) do { const size_t go_ = (size_t)(t) * 64 * INW; const unsigned sb_ = lds0 + (slot) * 32768; \
        glds16(ksrc0 + go_, (unsigned)__builtin_amdgcn_readfirstlane(sb_ + w * 1024)); glds16(ksrc1 + go_, (unsigned)__builtin_amdgcn_readfirstlane(sb_ + 8192 + w * 1024)); \
        glds16(vsrc0 + go_, (unsigned)__builtin_amdgcn_readfirstlane(sb_ + 16384 + w * 2048)); glds16(vsrc1 + go_, (unsigned)__builtin_amdgcn_readfirstlane(sb_ + 16384 + w * 2048 + 1024)); } while (0)
    DIFF_ISSUE(0, 0); DIFF_ISSUE(1, 1);
    bf16x8 qr[4];
#pragma unroll
    for (int d0 = 0; d0 < 4; ++d0) qr[d0] = *(const bf16x8*)(Qw + d0 * 16 + hi * 8);
    asm volatile("" : "+v"(qr[0]), "+v"(qr[1]), "+v"(qr[2]), "+v"(qr[3]));
    float m_run = 0.f, l_run = 0.f; f32x16 o[4];
#pragma unroll
    for (int d = 0; d < 4; ++d) o[d] = f32x16{};
    const int qrel = 32 * wq + r32; int ko[4], vo[4][2]; kread_offs(ko, r32, hi); vread_offs<4>(vo, lane);
    int sl = 0;
    for (int t = 0; t < NT; ++t) {
        if (t + 1 < NT) ATT_WAITV(4); else ATT_WAITV(0);
        ATT_BAR();
        if (t + 2 < NT) DIFF_ISSUE(t + 2, (sl >= 1 ? sl - 1 : 2));
        const lds_cptr S = L + sl * 32768;
        f32x16 p0, p1;
        qkt(p0, p1, S + p * 8192, qr, ko, -m_run);
        const int jb = t - (NT - 2);
        if (jb >= 0) { const int kb = 64 * jb + 4 * hi;
#pragma unroll
            for (int r = 0; r < 16; ++r) { const int kv = kb + (r & 3) + 8 * (r >> 2); if (kv > qrel) p0[r] = -INFINITY; if (kv + 32 > qrel) p1[r] = -INFINITY; } }
        softmax_pv<4>(p0, p1, m_run, l_run, t == 0, o, S + 16384, vo, wsf, r32, hi);
        sl = sl == 2 ? 0 : sl + 1;
    }
#undef DIFF_ISSUE
    finish_o<4>(l_run, o, wsf, r32, hi);
    ATT_BAR();
    lds_fptr X = (lds_fptr)(F.lds + RING_OFF) + wq * 4096;
    if (p == 1) {
#pragma unroll
        for (int d = 0; d < 4; ++d)
#pragma unroll
            for (int r = 0; r < 16; ++r) X[(d * 16 + r) * 64 + lane] = o[d][r];
    }
    ATT_BAR();
    if (p == 0) {
        float ss[16];
#pragma unroll
        for (int r = 0; r < 16; ++r) ss[r] = 0.f;
#pragma unroll
        for (int d = 0; d < 4; ++d)
#pragma unroll
            for (int r = 0; r < 16; ++r) { const float v = o[d][r] - lam * X[(d * 16 + r) * 64 + lane]; o[d][r] = v; ss[r] += v * v; }
#pragma unroll
        for (int r = 0; r < 16; ++r) {
            float s = ss[r];
            s = half32_sum(s);
            ss[r] = oml / sqrtf(s * (1.f / 128.f) + EPS);
        }
        LAS unsigned short* stg = (LAS unsigned short*)(F.lds + RING_OFF + 65536 + wq * 8192);
#pragma unroll
        for (int d = 0; d < 4; ++d) { const float g = subg[32 * d + r32];
#pragma unroll
            for (int r = 0; r < 16; ++r) { const unsigned short hb = (unsigned short)(cvtpk(o[d][r] * ss[r] * g, 0.f) & 0xffffu); stg[crow(r, hi) * 128 + 32 * d + r32] = hb; } }
        ATT_WAITL();
        bf16* Ow = MIX + (rb + 128 * ib + 32 * wq) * DM + h * 128;
#pragma unroll
        for (int i = 0; i < 8; ++i) { const int idx = i * 64 + lane, row = idx >> 4, ch = idx & 15;
            const u32x4 v = *(const LAS u32x4*)(stg + row * 128 + ch * 8); *(u32x4*)(Ow + (size_t)row * DM + ch * 8) = v; }
    }
    ATT_BAR();
}

constexpr int WP_STRIDE = 16384;
struct MemMap {
    int base;
    __device__ __forceinline__ int nt() const { return 4; }
    __device__ __forceinline__ int first() const { return 0; }
    __device__ __forceinline__ int krow(int tt, int j) const { return base + 64 * tt + j; }
    __device__ __forceinline__ void mask(int, att::f32x16&, att::f32x16&, int, int) const {}
};
struct DilMap {
    int rowbase, d, res, m0, ks, Lm1;
    __device__ __forceinline__ int nt() const { return 3; }
    __device__ __forceinline__ int first() const { return ks + 64 <= 0 ? (ks + 128 <= 0 ? 2 : 1) : 0; }
    __device__ __forceinline__ int krow(int tt, int j) const { int mp = ks + 64 * tt + j; mp = mp < 0 ? 0 : (mp > Lm1 ? Lm1 : mp); return rowbase + mp * d + res; }
    __device__ __forceinline__ void mask(int tt, att::f32x16& p0, att::f32x16& p1, int r32, int hi) const {
        const int m = m0 + r32, kb = ks + 64 * tt + 4 * hi;
#pragma unroll
        for (int r = 0; r < 16; ++r) { const int mp = kb + (r & 3) + 8 * (r >> 2);
            if (mp < 0 || mp > m || mp < m - 128) p0[r] = -INFINITY;
            if (mp + 32 < 0 || mp + 32 > m || mp + 32 < m - 128) p1[r] = -INFINITY; }
    }
};
template <class KM>
__device__ __forceinline__ void win_attn(Frame& F, const KM& km, const bf16* qp, const bf16* Kg, int pitchK, const bf16* Vg, int pitchV, att::f32x16 (&o)[2], float& m_out, float& l_out) {
    using namespace att;
    const int lane = F.lane, r32 = lane & 31, hi = lane >> 5, w = F.wave;
    const unsigned kdst = (unsigned)(uintptr_t)(F.lds + RING_OFF + w * WP_STRIDE), vdst = kdst + 8192;
    const lds_cptr Ks = (lds_cptr)(F.lds + RING_OFF + w * WP_STRIDE), Vs = Ks + 8192;
    lds_fptr wsf = (lds_fptr)(F.lds + PEER_SCR + w * 256);
    bf16x8 qr[4];
#pragma unroll
    for (int d0 = 0; d0 < 4; ++d0) qr[d0] = *(const bf16x8*)(qp + d0 * 16 + hi * 8);
    asm volatile("" : "+v"(qr[0]), "+v"(qr[1]), "+v"(qr[2]), "+v"(qr[3]));
    float m_run = 0.f, l_run = 0.f;
    o[0] = f32x16{}; o[1] = f32x16{};
    int ko[4], vo[2][2]; kread_offs(ko, r32, hi); vread_offs<2>(vo, lane);
#define WP_ISSUE_K(tt) do { _Pragma("unroll") for (int i_ = 0; i_ < 8; ++i_) { const int row_ = 8 * i_ + (lane >> 3); \
        glds16(Kg + (size_t)km.krow(tt, row_) * pitchK + (((lane & 7) ^ kswz(row_)) << 3), (unsigned)__builtin_amdgcn_readfirstlane(kdst + i_ * 1024)); } } while (0)
#define WP_ISSUE_V(tt) do { _Pragma("unroll") for (int i_ = 0; i_ < 8; ++i_) { const int row_ = 8 * i_ + (lane >> 3); \
        glds16(Vg + (size_t)km.krow(tt, row_) * pitchV + (((lane & 7) ^ kswz(row_)) << 3), (unsigned)__builtin_amdgcn_readfirstlane(vdst + i_ * 1024)); } } while (0)
    const int t0 = km.first(), nt = km.nt();
    ATT_WAITL();
    WP_ISSUE_K(t0); WP_ISSUE_V(t0);
    for (int tt = t0; tt < nt; ++tt) {
        ATT_WAITV(8);
        f32x16 p0, p1;
        qkt(p0, p1, Ks, qr, ko, -m_run);
        if (tt + 1 < nt) { ATT_WAITL(); WP_ISSUE_K(tt + 1); ATT_WAITV(8); } else { ATT_WAITV(0); }
        km.mask(tt, p0, p1, r32, hi);
        softmax_pv<2>(p0, p1, m_run, l_run, tt == t0, o, Vs, vo, wsf, r32, hi);
        if (tt + 1 < nt) { ATT_WAITL(); WP_ISSUE_V(tt + 1); }
    }
#undef WP_ISSUE_K
#undef WP_ISSUE_V
    l_out = finish_o<2>(l_run, o, wsf, r32, hi);
    m_out = m_run;
}
template <class RowOff>
__device__ __forceinline__ void win_store(Frame& F, const att::f32x16 (&o)[2], bf16* dst, const RowOff& rowoff) {
    using namespace att;
    const int lane = F.lane, r32 = lane & 31, hi = lane >> 5;
    LAS unsigned short* stg = (LAS unsigned short*)(F.lds + RING_OFF + F.wave * WP_STRIDE);
    ATT_WAITL();
#pragma unroll
    for (int r = 0; r < 16; ++r) { const int orow = crow(r, hi);
#pragma unroll
        for (int d0 = 0; d0 < 2; ++d0) stg[orow * 64 + d0 * 32 + r32] = (unsigned short)(cvtpk(o[d0][r], 0.f) & 0xffffu); }
    ATT_WAITL();
#pragma unroll
    for (int i = 0; i < 4; ++i) { const int row = i * 8 + (lane >> 3), ch = lane & 7; const u32x4 v = *(const LAS u32x4*)(stg + row * 64 + ch * 8); *(u32x4*)(dst + rowoff(row) + ch * 8) = v; }
    ATT_WAITL();
}
__device__ __forceinline__ void mem_attn_all(Frame& F, const bf16* PROJ, const bf16* MKV, bf16* MIX) {
    const int gw = F.vcu * NWAVES + F.wave, NGW = F.G * NWAVES, r32 = F.lane & 31;
    for (int qb = gw; qb < NB * 4 * (SEQ / 32); qb += NGW) {
        const int blk = qb % (SEQ / 32), mh = (qb / (SEQ / 32)) & 3, b = qb / (4 * (SEQ / 32));
        const size_t row0 = (size_t)b * SEQ + 32 * blk;
        MemMap km{b * MEMT};
        att::f32x16 o[2]; float m_, l_;
        win_attn(F, km, PROJ + (row0 + r32) * INW + 2304 + mh * 64, MKV + mh * 64, MKVW, MKV + 256 + mh * 64, MKVW, o, m_, l_);
        win_store(F, o, MIX + row0 * DM + 768 + mh * 64, [](int i) { return (size_t)i * DM; });
    }
}
__device__ __forceinline__ void dil_strip(Frame& F, int b, int head, int res, int s, int d, const bf16* PROJ, const bf16* SKV, bf16* OG, float* LSEG) {
    using namespace att;
    const int lane = F.lane, r32 = lane & 31, hi = lane >> 5, w = F.wave;
    const lds_cptr L = (lds_cptr)(F.lds + RING_OFF);
    const unsigned lds0 = (unsigned)(uintptr_t)(F.lds + RING_OFF);
    lds_fptr wsf = (lds_fptr)(F.lds + PEER_SCR + w * 256);
    const int rb = b * SEQ, Lm1 = SEQ / d - 1, kb0 = 256 * s - 128, m0 = 256 * s + 32 * w;
    const bf16* Kg = SKV + head * 64; const bf16* Vg = Kg + 2304;
    {   const int row_ = 8 * w + (lane >> 3), co_ = ((lane & 7) ^ kswz(row_)) << 3;
#pragma unroll
        for (int j = 0; j < 6; ++j) if (kb0 + 64 * j + 64 > 0) {
            int mp = kb0 + 64 * j + row_; mp = mp < 0 ? 0 : (mp > Lm1 ? Lm1 : mp);
            const size_t go = (size_t)(rb + mp * d + res) * SKVW + co_;
            glds16(Kg + go, (unsigned)__builtin_amdgcn_readfirstlane(lds0 + j * 16384 + w * 1024)); glds16(Vg + go, (unsigned)__builtin_amdgcn_readfirstlane(lds0 + j * 16384 + 8192 + w * 1024)); } }
    const size_t qrow = (size_t)rb + (size_t)(m0 + r32) * d + res;
    bf16x8 qr[4];
#pragma unroll
    for (int d0 = 0; d0 < 4; ++d0) qr[d0] = *(const bf16x8*)(PROJ + qrow * INW + head * 64 + d0 * 16 + hi * 8);
    asm volatile("" : "+v"(qr[0]), "+v"(qr[1]), "+v"(qr[2]), "+v"(qr[3]));
    int ko[4], vo[2][2]; kread_offs(ko, r32, hi); vread_offs<2>(vo, lane);
    ATT_WAITV(0); ATT_BAR();
    float m_run = 0.f, l_run = 0.f; f32x16 o[2]; o[0] = f32x16{}; o[1] = f32x16{};
    DilMap km{rb, d, res, m0, kb0, Lm1};
    bool first = true;
    for (int jj = 0; jj < 3; ++jj) {
        const int j = (w >> 1) + jj;
        if (kb0 + 64 * j + 64 <= 0) continue;
        f32x16 p0, p1;
        qkt(p0, p1, L + j * 16384, qr, ko, -m_run);
        km.mask(j, p0, p1, r32, hi);
        softmax_pv<2>(p0, p1, m_run, l_run, first, o, L + j * 16384 + 8192, vo, wsf, r32, hi);
        first = false;
    }
    const float l = finish_o<2>(l_run, o, wsf, r32, hi);
    {   LAS unsigned short* stg = (LAS unsigned short*)(F.lds + RING_OFF + 98304 + w * 4096);
#pragma unroll
        for (int r = 0; r < 16; ++r) { const int orow = crow(r, hi);
#pragma unroll
            for (int d0 = 0; d0 < 2; ++d0) stg[orow * 64 + d0 * 32 + r32] = (unsigned short)(cvtpk(o[d0][r], 0.f) & 0xffffu); }
        ATT_WAITL();
        bf16* dst = OG + ((size_t)rb + (size_t)m0 * d + res) * 2304 + head * 64;
#pragma unroll
        for (int i = 0; i < 4; ++i) { const int row = i * 8 + (lane >> 3), ch = lane & 7; const u32x4 v = *(const LAS u32x4*)(stg + row * 64 + ch * 8); *(u32x4*)(dst + (size_t)row * d * 2304 + ch * 8) = v; }
        if (hi == 0) LSEG[qrow * 36 + head] = m_run + __builtin_amdgcn_logf(l); }
    ATT_BAR();
}
__device__ __forceinline__ void dil_combine_all(Frame& F, const bf16* OG, const float* LSEG, bf16* MIX) {
    const int gt = F.vcu * (NWAVES * 64) + F.tid, NT_ = F.G * NWAVES * 64;
    for (int it = gt; it < TT * 12; it += NT_) {
        const int row = it / 12, j = it - row * 12;
        const float* lp = LSEG + (size_t)row * 36 + j; const float l0 = lp[0], l1 = lp[12], l2 = lp[24];
        const float mx = __builtin_fmaxf(l0, __builtin_fmaxf(l1, l2));
        float a0 = __builtin_amdgcn_exp2f(l0 - mx), a1 = __builtin_amdgcn_exp2f(l1 - mx), a2 = __builtin_amdgcn_exp2f(l2 - mx);
        const float inv = 1.0f / (a0 + a1 + a2); a0 *= inv; a1 *= inv; a2 *= inv;
        const v4u* g0 = (const v4u*)(OG + (size_t)row * 2304 + j * 64); const v4u* g1 = g0 + 12 * 8; const v4u* g2 = g1 + 12 * 8;
        v4u* dst = (v4u*)(MIX + (size_t)row * DM + j * 64);
#pragma unroll
        for (int c = 0; c < 8; ++c) {
            const v4u x = g0[c], y = g1[c], z = g2[c]; v4u r;
#pragma unroll
            for (int k = 0; k < 4; ++k) {
                const unsigned xk = x[k], yk = y[k], zk = z[k];
                const float lo = a0 * __uint_as_float(xk << 16) + a1 * __uint_as_float(yk << 16) + a2 * __uint_as_float(zk << 16);
                const float hh = a0 * __uint_as_float(xk & 0xffff0000u) + a1 * __uint_as_float(yk & 0xffff0000u) + a2 * __uint_as_float(zk & 0xffff0000u);
                r[k] = cvtpk(lo, hh);
            }
            dst[c] = r;
        }
    }
}
#ifndef REPMASK
#define REPMASK 0
#endif
#define NREP(b) (((REPMASK) & (b)) ? 2 : 1)

#define CEX(a, b) do { const float hi_ = __builtin_fmaxf(a, b), lo_ = __builtin_fminf(a, b); a = hi_; b = lo_; } while (0)
template <int K, int J> __device__ __forceinline__ void bstage(float (&a)[16]) {
#pragma unroll
    for (int i = 0; i < 16; ++i) { constexpr int k = K, j = J; const int l = i ^ j; if (l > i) { if ((i & k) == 0) CEX(a[i], a[l]); else CEX(a[l], a[i]); } }
}
__device__ __forceinline__ void sort16_desc(float (&a)[16]) {
    CEX(a[0], a[13]); CEX(a[1], a[12]); CEX(a[2], a[15]); CEX(a[3], a[14]); CEX(a[4], a[8]); CEX(a[5], a[6]); CEX(a[7], a[11]); CEX(a[9], a[10]);
    CEX(a[0], a[5]); CEX(a[1], a[7]); CEX(a[2], a[9]); CEX(a[3], a[4]); CEX(a[6], a[13]); CEX(a[8], a[14]); CEX(a[10], a[15]); CEX(a[11], a[12]);
    CEX(a[0], a[1]); CEX(a[2], a[3]); CEX(a[4], a[5]); CEX(a[6], a[8]); CEX(a[7], a[9]); CEX(a[10], a[11]); CEX(a[12], a[13]); CEX(a[14], a[15]);
    CEX(a[0], a[2]); CEX(a[1], a[3]); CEX(a[4], a[10]); CEX(a[5], a[11]); CEX(a[6], a[7]); CEX(a[8], a[9]); CEX(a[12], a[14]); CEX(a[13], a[15]);
    CEX(a[1], a[2]); CEX(a[3], a[12]); CEX(a[4], a[6]); CEX(a[5], a[7]); CEX(a[8], a[10]); CEX(a[9], a[11]); CEX(a[13], a[14]);
    CEX(a[1], a[4]); CEX(a[2], a[6]); CEX(a[5], a[8]); CEX(a[7], a[10]); CEX(a[9], a[13]); CEX(a[11], a[14]);
    CEX(a[2], a[4]); CEX(a[3], a[6]); CEX(a[9], a[12]); CEX(a[11], a[13]);
    CEX(a[3], a[5]); CEX(a[6], a[8]); CEX(a[7], a[9]); CEX(a[10], a[12]);
    CEX(a[3], a[4]); CEX(a[5], a[6]); CEX(a[7], a[8]); CEX(a[9], a[10]); CEX(a[11], a[12]);
    CEX(a[6], a[7]); CEX(a[8], a[9]);
}
__device__ __forceinline__ void merge16(float (&a)[16], const float (&b)[16]) {
#pragma unroll
    for (int i = 0; i < 16; ++i) a[i] = __builtin_fmaxf(a[i], b[15 - i]);
    bstage<16, 8>(a); bstage<16, 4>(a); bstage<16, 2>(a); bstage<16, 1>(a);
}
__device__ __forceinline__ void top16_of_64(const float (&v)[64], float (&out)[16]) {
    float c1[16], c2[16], c3[16];
#pragma unroll
    for (int i = 0; i < 16; ++i) { out[i] = v[i]; c1[i] = v[16 + i]; }
    sort16_desc(out); sort16_desc(c1); merge16(out, c1);
#pragma unroll
    for (int i = 0; i < 16; ++i) { c2[i] = v[32 + i]; c3[i] = v[48 + i]; }
    sort16_desc(c2); sort16_desc(c3); merge16(c2, c3); merge16(out, c2);
}
struct CandTab { int pos[16][16]; int inv[64]; int n;
    constexpr CandTab() : pos{}, inv{}, n(0) { for (int q = 0; q < 64; ++q) inv[q] = -1; for (int a = 0; a < 16; ++a) for (int b = 0; b < 16; ++b) { if ((a + 1) * (b + 1) <= 16) { pos[a][b] = n; inv[n] = a * 16 + b; ++n; } else pos[a][b] = -1; } } };
static constexpr CandTab kCand{};
static_assert(kCand.n == 50, "50 candidate pairs");
__device__ __forceinline__ float gelu1(float v) { pg8::f32x2 t = {v, v}; return pg8::gelu_pk(t).x; }

__device__ __forceinline__ void peer_phase(Frame& F, int l) {
    using att::f32x16; using att::crow;
    const int lane = F.lane, r32 = lane & 31, hi = lane >> 5, w = F.wave;
    const auto kp_ = ka_fresh(F); unsigned char* const ws_ = KA_WS(kp_); float* const out_ = KA_OUT(kp_);
    const bf16* PQ = WSP(bf16, WS_PROJ);
    const bf16* keys = WSP(bf16, WS_PKEYS) + (size_t)l * 16 * 128 * 128;
    const unsigned char* U6 = WSP(unsigned char, WS_PU) + (size_t)l * NEXP * PVROW;
    const unsigned char* V6 = WSP(unsigned char, WS_PV) + (size_t)l * NEXP * PROW;
    LAS unsigned* ids = (LAS unsigned*)(F.lds + RING_OFF);
    const unsigned kbuf = (unsigned)(uintptr_t)(F.lds + RING_OFF + 65536 + (w >> 2) * 32768);
    const att::lds_cptr KB = (att::lds_cptr)(F.lds + RING_OFF + 65536 + (w >> 2) * 32768);
    LAS unsigned char* scr = F.lds + PEER_SCR + w * 2048 + lane * 32;
    const float* gf = KA_IN(kp_, 10) + l * DM;
    for (int tile = F.bx; tile < TT / 128; tile += F.G) {
        {
            const int tokl = 32 * (w & 3) + r32; const size_t tok = (size_t)tile * 128 + tokl;
#define KEYS_ISSUE(gi) do { const bf16* kg_ = keys + (size_t)((4 * (w >> 2)) * 2 + (gi)) * 16384; int ln_ = lane; asm volatile("" : "+v"(ln_)); _Pragma("unroll") for (int i_ = 0; i_ < 8; ++i_) { const int q_ = 8 * (w & 3) + i_, row_ = 4 * q_ + (ln_ >> 4); \
                att::glds16(kg_ + row_ * 128 + (((ln_ & 15) ^ (row_ & 15)) << 3), (unsigned)__builtin_amdgcn_readfirstlane(kbuf + q_ * 1024)); } } while (0)
            const int grp_ = __builtin_amdgcn_readfirstlane(w >> 2);
            for (int rep_ = 0; rep_ < NREP(256); ++rep_) {
            if (grp_ != 0) ATT_BAR();
            KEYS_ISSUE(0);
            bf16x8 bq[8];
            { const bf16* qp = PQ + tok * PQW + (4 * (w >> 2)) * 256 + hi * 8;
#pragma unroll
              for (int ks = 0; ks < 8; ++ks) bq[ks] = *(const bf16x8*)(qp + ks * 16); }
            for (int hh = 0; hh < 4; ++hh) {
                const int h = 4 * (w >> 2) + hh;
                float L0[16], L1[16];
#pragma unroll
                for (int p = 0; p < 2; ++p) {
                    asm volatile("" : "+v"(bq[0]), "+v"(bq[1]), "+v"(bq[2]), "+v"(bq[3]), "+v"(bq[4]), "+v"(bq[5]), "+v"(bq[6]), "+v"(bq[7]));
                    ATT_WAITV(0); ATT_BAR();
                    f32x16 acc[4];
#pragma unroll
                    for (int kb = 0; kb < 4; ++kb) acc[kb] = f32x16{};
                    const int kro = r32 * 256, ksw = r32 & 15;
                    {
                        typedef const __attribute__((address_space(3))) bf16x8* kfp_t; bf16x8 ka[4], kn[4];
#pragma unroll
                        for (int kb = 0; kb < 4; ++kb) ka[kb] = *(kfp_t)(KB + kb * 8192 + kro + (((hi) ^ ksw) << 4));
#pragma unroll
                        for (int ks = 0; ks < 8; ++ks) {
                            if (ks + 1 < 8) {
#pragma unroll
                                for (int kb = 0; kb < 4; ++kb) kn[kb] = *(kfp_t)(KB + kb * 8192 + kro + (((2 * (ks + 1) + hi) ^ ksw) << 4)); }
                            __builtin_amdgcn_sched_barrier(0);
#pragma unroll
                            for (int kb = 0; kb < 4; ++kb) acc[kb] = __builtin_amdgcn_mfma_f32_32x32x16_bf16(ka[kb], bq[ks], acc[kb], 0, 0, 0);
                            __builtin_amdgcn_sched_barrier(0);
#pragma unroll
                            for (int kb = 0; kb < 4; ++kb) ka[kb] = kn[kb];
                        }
                    }
                    asm volatile("" : "+v"(acc[0]), "+v"(acc[1]), "+v"(acc[2]), "+v"(acc[3]));
                    ATT_BAR();
                    if (hh * 2 + p + 1 < 8) { KEYS_ISSUE(hh * 2 + p + 1);
                        const bf16* qp = PQ + tok * PQW + (4 * (w >> 2)) * 256 + (hh * 2 + p + 1) * 128 + hi * 8;
#pragma unroll
                        for (int ks = 0; ks < 8; ++ks) bq[ks] = *(const bf16x8*)(qp + ks * 16); }
                    float t[16];
#pragma unroll
                    for (int kb = 0; kb < 4; ++kb) { float c[16];
#pragma unroll
                        for (int r = 0; r < 16; ++r) c[r] = __uint_as_float((__float_as_uint(acc[kb][r]) & ~127u) | (unsigned)(kb * 32 + (r & 3) + 8 * (r >> 2)));
                        sort16_desc(c);
                        if (kb == 0) {
#pragma unroll
                            for (int r = 0; r < 16; ++r) t[r] = c[r];
                        } else merge16(t, c); }
                    float a[16], b[16];
#pragma unroll
                    for (int i = 0; i < 16; ++i) { auto rr = __builtin_amdgcn_permlane32_swap(__float_as_uint(t[i]), __float_as_uint(t[i]), false, false); a[i] = __uint_as_float(rr[0]); b[i] = __uint_as_float(rr[1] | 4u); }
                    merge16(a, b);
#pragma unroll
                    for (int i = 0; i < 16; ++i) { if (p == 0) L0[i] = a[i]; else L1[i] = a[i]; }
                }
#pragma unroll
                for (int q = 0; q < 4; ++q) {
                    ((LAS unsigned*)scr)[q] = (__float_as_uint(L0[4 * q]) & 127u) | ((__float_as_uint(L0[4 * q + 1]) & 127u) << 8) | ((__float_as_uint(L0[4 * q + 2]) & 127u) << 16) | ((__float_as_uint(L0[4 * q + 3]) & 127u) << 24);
                    ((LAS unsigned*)scr)[4 + q] = (__float_as_uint(L1[4 * q]) & 127u) | ((__float_as_uint(L1[4 * q + 1]) & 127u) << 8) | ((__float_as_uint(L1[4 * q + 2]) & 127u) << 16) | ((__float_as_uint(L1[4 * q + 3]) & 127u) << 24);
                }
                float sel[16];
#pragma unroll
                for (int ch = 0; ch < 4; ++ch) { float c[16];
#pragma unroll
                    for (int q = 0; q < 16; ++q) { constexpr int dummy = 0; const int code = kCand.inv[ch * 16 + q];
                        c[q] = code >= 0 ? __uint_as_float((__float_as_uint(L0[code >= 0 ? (code >> 4) : 0] + L1[code >= 0 ? (code & 15) : 0]) & ~255u) | (unsigned)(code >= 0 ? code : 0)) : -INFINITY; }
                    sort16_desc(c);
                    if (ch == 0) {
#pragma unroll
                        for (int q = 0; q < 16; ++q) sel[q] = c[q];
                    } else merge16(sel, c); }
                asm volatile("s_waitcnt lgkmcnt(0)" ::: "memory");
                float ev[16]; unsigned eid[16]; float esum = 0.f;
                const float s0 = __uint_as_float(__float_as_uint(sel[0]) & ~255u);
#pragma unroll
                for (int k = 0; k < 16; ++k) { const unsigned bits = __float_as_uint(sel[k]); const unsigned code = bits & 255u;
                    const unsigned i1 = scr[code >> 4], i2 = scr[16 + (code & 15u)];
                    eid[k] = i1 * 128u + i2; ev[k] = __expf(__uint_as_float(bits & ~255u) - s0); esum += ev[k]; }
                const float rinv = 1.0f / esum;
                asm volatile("s_waitcnt lgkmcnt(0)" ::: "memory");
#pragma unroll
                for (int k = 0; k < 8; ++k) { const unsigned idv = hi ? eid[k + 8] : eid[k]; const float gv = (hi ? ev[k + 8] : ev[k]) * rinv;
                    ids[tokl * 128 + h * 16 + 8 * hi + k] = idv | (cvtpk(0.f, gv) & 0xffff0000u); }
            }
            if (grp_ == 0) ATT_BAR();
            }
#undef KEYS_ISSUE
        }
        {
            LAS float* gl_ = (LAS float*)(F.lds + 149504); const float* ga_ = (l < 3) ? KA_IN(kp_, 2) + (l + 1) * DM : KA_IN(kp_, 17);
            gl_[2 * F.tid] = ga_[2 * F.tid]; gl_[2 * F.tid + 1] = ga_[2 * F.tid + 1];
            { const int e_ = 2 * F.tid, o_ = 2048 + (32 * ((e_ & 31) >> 2) + (e_ >> 5)) * 4 + (e_ & 3); gl_[o_] = gf[e_]; gl_[o_ + 1] = gf[e_ + 1]; }
            if (l == 1) { const float* gb_ = KA_IN(kp_, 15); gl_[1024 + 2 * F.tid] = gb_[2 * F.tid]; gl_[1025 + 2 * F.tid] = gb_[2 * F.tid + 1]; }
        }
        __syncthreads();
        {
        const Frame F2 = make_frame(); const int lane = F2.lane, w = F2.wave, bl = lane & 31, hf = lane >> 5;
        typedef __bf16 bf2 __attribute__((ext_vector_type(2))); typedef float f32x2_t __attribute__((ext_vector_type(2)));
        {   LAS unsigned* lst = ids + w * 2048; unsigned ent[16][2];
#pragma unroll
            for (int t = 0; t < 16; ++t) { ent[t][0] = lst[t * 128 + lane]; ent[t][1] = lst[t * 128 + 64 + lane]; }
            asm volatile("s_waitcnt lgkmcnt(0)" ::: "memory");
#pragma unroll
            for (int t = 0; t < 16; ++t) {
                LAS unsigned* L = lst + t * 128; const unsigned q0 = ent[t][0], q1 = ent[t][1]; const int r0 = (int)((q0 >> 11) & 7u), r1 = (int)((q1 >> 11) & 7u);
                int base = 0;
                for (int r = 0; r < 8; ++r) {
                    const unsigned long long m0 = __ballot(r0 == r), m1 = __ballot(r1 == r); const int c0 = __popcll(m0);
                    if (r0 == r) L[base + __builtin_amdgcn_mbcnt_hi((unsigned)(m0 >> 32), __builtin_amdgcn_mbcnt_lo((unsigned)m0, 0))] = q0;
                    if (r1 == r) L[base + c0 + __builtin_amdgcn_mbcnt_hi((unsigned)(m1 >> 32), __builtin_amdgcn_mbcnt_lo((unsigned)m1, 0))] = q1;
                    base += c0 + __popcll(m1);
                }
            }
            asm volatile("s_waitcnt lgkmcnt(0)" ::: "memory");
        }
        const __amdgpu_buffer_rsrc_t rsu = __builtin_amdgcn_make_buffer_rsrc((void*)U6, 0, NEXP * PVROW, 0x00020000), rsus = __builtin_amdgcn_make_buffer_rsrc((void*)(WSP(float, WS_PSC + 512 * 1024) + (size_t)l * NEXP), 0, NEXP * 4, 0x00020000), rsv = __builtin_amdgcn_make_buffer_rsrc((void*)V6, 0, NEXP * PROW, 0x00020000);
        {
            const int ci = lane & 15, cg = lane >> 4;
            const unsigned xq8 = (unsigned)(uintptr_t)(F2.lds + RING_OFF + 65536 + w * 8192);
            const bool wr = ((ci & 7) == 0) && ((cg >> 1) == (ci >> 3));
            typedef int v8i_t __attribute__((ext_vector_type(8))); typedef unsigned v2u_t __attribute__((ext_vector_type(2)));
            for (int h = 0; h < 2; ++h) {
                int eb_v = 127;
                asm volatile("s_waitcnt lgkmcnt(0)" ::: "memory");
                v4u a0, a1, a2, a3, a4, a5, a6, a7, b0, b1, b2, b3, b4, b5, b6, b7; float sa, sb;
                LAS float* const sxb = (LAS float*)(F2.lds + 148480 + w * 64);
                const unsigned xsc = (unsigned)(uintptr_t)(F2.lds + PEER_SCR + w * 2048);
#define U_REQ(B0, B1, B2, B3, B4, B5, B6, B7, S, k_) do { const int p_ = (k_) >> 4, G_ = ((k_) & 15) ^ ((p_ & 1) ? 15 : 0);       \
                    const LAS unsigned* lp_ = ids + (16 * w + 8 * h + 2 * p_ + hf) * 128 + 8 * G_; const v4u ea_ = *(const LAS v4u*)lp_, eb4_ = *(const LAS v4u*)(lp_ + 4); \
                    const unsigned es_ = ids[(16 * w + 8 * h + 2 * p_ + (ci >> 3)) * 128 + 8 * G_ + (ci & 7)] & 0x3fffu; \
                    B0 = __builtin_bit_cast(v4u, __builtin_amdgcn_raw_buffer_load_b128(rsu, (int)((ea_.x & 0x3fffu) * (unsigned)PVROW) + 16 * bl, 0, 0)); B1 = __builtin_bit_cast(v4u, __builtin_amdgcn_raw_buffer_load_b128(rsu, (int)((ea_.y & 0x3fffu) * (unsigned)PVROW) + 16 * bl, 0, 0)); \
                    B2 = __builtin_bit_cast(v4u, __builtin_amdgcn_raw_buffer_load_b128(rsu, (int)((ea_.z & 0x3fffu) * (unsigned)PVROW) + 16 * bl, 0, 0)); B3 = __builtin_bit_cast(v4u, __builtin_amdgcn_raw_buffer_load_b128(rsu, (int)((ea_.w & 0x3fffu) * (unsigned)PVROW) + 16 * bl, 0, 0)); \
                    B4 = __builtin_bit_cast(v4u, __builtin_amdgcn_raw_buffer_load_b128(rsu, (int)((eb4_.x & 0x3fffu) * (unsigned)PVROW) + 16 * bl, 0, 0)); B5 = __builtin_bit_cast(v4u, __builtin_amdgcn_raw_buffer_load_b128(rsu, (int)((eb4_.y & 0x3fffu) * (unsigned)PVROW) + 16 * bl, 0, 0)); \
                    B6 = __builtin_bit_cast(v4u, __builtin_amdgcn_raw_buffer_load_b128(rsu, (int)((eb4_.z & 0x3fffu) * (unsigned)PVROW) + 16 * bl, 0, 0)); B7 = __builtin_bit_cast(v4u, __builtin_amdgcn_raw_buffer_load_b128(rsu, (int)((eb4_.w & 0x3fffu) * (unsigned)PVROW) + 16 * bl, 0, 0)); \
                    S = __builtin_bit_cast(float, __builtin_amdgcn_raw_buffer_load_b32(rsus, (int)(es_ * 4u), 0, 0)); } while (0)
#define U_ST(UB, i_) do { const int r_ = 8 * hf + (i_); *(LAS v4u*)(uintptr_t)(xq8 + 512 * r_ + 16 * ((bl ^ r_) & 31)) = UB; } while (0)
#define MF1(S, j_) do { const v4u ua_ = *(const LAS v4u*)(uintptr_t)(xq8 + 512 * ci + 16 * (((4 * (j_) + cg) ^ ci) & 31)); const v8i_t a_ = {(int)ua_.x, (int)ua_.y, (int)ua_.z, (int)ua_.w, 0, 0, 0, 0}; \
                    D_ = __builtin_amdgcn_mfma_scale_f32_16x16x128_f8f6f4(a_, xb[j_], D_, 4, 0, 0, 127, 0, sbx_); } while (0)
#define STEP(C0, C1, C2, C3, C4, C5, C6, C7, SC_, N0, N1, N2, N3, N4, N5, N6, N7, SN_, k_) do { \
                    { const int k2_ = (k_) + 1 < 64 ? (k_) + 1 : 63; U_REQ(N0, N1, N2, N3, N4, N5, N6, N7, SN_, k2_); } \
                    int t_; asm volatile("s_mov_b32 %0, 1" : "=s"(t_)); if (t_) { \
                    const int p_ = (k_) >> 4, G_ = ((k_) & 15) ^ ((p_ & 1) ? 15 : 0); \
                    f32x4 D_ = {0.f, 0.f, 0.f, 0.f}; \
                    U_ST(C0, 0); U_ST(C1, 1); U_ST(C2, 2); U_ST(C3, 3); U_ST(C4, 4); U_ST(C5, 5); U_ST(C6, 6); U_ST(C7, 7); asm volatile("s_waitcnt lgkmcnt(0)" ::: "memory"); \
                    MF1(SC_, 0); MF1(SC_, 1); MF1(SC_, 2); MF1(SC_, 3); MF1(SC_, 4); MF1(SC_, 5); MF1(SC_, 6); MF1(SC_, 7); \
                    { float d0_ = D_[0], d1_ = D_[1], d2_ = D_[2], d3_ = D_[3]; asm volatile("" : "+v"(d0_), "+v"(d1_), "+v"(d2_), "+v"(d3_)); D_ = (f32x4){d0_, d1_, d2_, d3_}; }     \
                    LAS unsigned* idc_ = ids + (16 * w + 8 * h + 2 * p_ + hf) * 128 + 8 * G_ + 4 * (cg & 1);       \
                    if (cg == 0) sxb[ci] = SC_;       \
                    asm volatile("s_waitcnt lgkmcnt(0)" ::: "memory"); const f32x4 su_ = *(const LAS f32x4*)(sxb + 4 * cg); asm volatile("s_waitcnt lgkmcnt(0)" ::: "memory"); \
                    const v4u q_ = *(const LAS v4u*)idc_; pg8::f32x2 t0_ = {D_[0] * su_[0], D_[1] * su_[1]}, t1_ = {D_[2] * su_[2], D_[3] * su_[3]}; t0_ = pg8::gelu_pk(t0_); t1_ = pg8::gelu_pk(t1_); \
                    const v4u n_ = {(q_.x & 0xffffu) | (cvtpk(0.f, __uint_as_float(q_.x & 0xffff0000u) * t0_.x) & 0xffff0000u), (q_.y & 0xffffu) | (cvtpk(0.f, __uint_as_float(q_.y & 0xffff0000u) * t0_.y) & 0xffff0000u), \
                                    (q_.z & 0xffffu) | (cvtpk(0.f, __uint_as_float(q_.z & 0xffff0000u) * t1_.x) & 0xffff0000u), (q_.w & 0xffffu) | (cvtpk(0.f, __uint_as_float(q_.w & 0xffff0000u) * t1_.y) & 0xffff0000u)}; \
                    if (wr) *(LAS v4u*)idc_ = n_; } } while (0)
                v8i_t xb[8]; int sbx_ = 120;
                U_REQ(a0, a1, a2, a3, a4, a5, a6, a7, sa, 0);
#define XSTAGE                     const int tokl = 16 * w + 8 * h + 2 * p + hf; const size_t tok = (size_t)tile * 128 + tokl; \
                    const bf16* xrow = WSP(bf16, WS_XB) + tok * DM + 32 * bl; \
            {   v4u xw[4]; float ssq = 0.f; f32x4 x[8]; \
_Pragma("unroll") \
                for (int j = 0; j < 4; ++j) xw[j] = ((const v4u*)xrow)[j]; \
_Pragma("unroll") \
                for (int j = 0; j < 4; ++j) { const unsigned a_ = xw[j].x, b_ = xw[j].y, c_ = xw[j].z, d_ = xw[j].w; \
                    x[2 * j] = (f32x4){__uint_as_float(a_ << 16), __uint_as_float(a_ & 0xffff0000u), __uint_as_float(b_ << 16), __uint_as_float(b_ & 0xffff0000u)}; \
                    x[2 * j + 1] = (f32x4){__uint_as_float(c_ << 16), __uint_as_float(c_ & 0xffff0000u), __uint_as_float(d_ << 16), __uint_as_float(d_ & 0xffff0000u)}; } \
_Pragma("unroll") \
                for (int j = 0; j < 8; ++j) ssq += (x[j][0] * x[j][0] + x[j][1] * x[j][1]) + (x[j][2] * x[j][2] + x[j][3] * x[j][3]); \
                const float rstd = 1.0f / sqrtf(half32_sum(ssq) * (1.f / DM) + EPS); \
                float am = 0.f; \
_Pragma("unroll") \
                for (int j = 0; j < 8; ++j) { const f32x4 gg = ((const LAS f32x4*)(F2.lds + 149504 + 8192))[32 * j + bl]; x[j] = x[j] * rstd * gg; \
                    am = __builtin_fmaxf(am, __builtin_fmaxf(__builtin_fmaxf(__builtin_fabsf(x[j][0]), __builtin_fabsf(x[j][1])), __builtin_fmaxf(__builtin_fabsf(x[j][2]), __builtin_fabsf(x[j][3])))); } \
                am = __builtin_fmaxf(half32_max(am), 1e-30f); \
                auto rr = __builtin_amdgcn_permlane32_swap(__float_as_uint(am), __float_as_uint(am), false, false); \
                const int ebA = (int)(rr[0] >> 23), ebB = (int)(rr[1] >> 23), ebO = hf ? ebB : ebA; \
                const float mult = __uint_as_float((unsigned)(261 - ebO) << 23); \
                if (lane == 2 * p) eb_v = ebA; if (lane == 2 * p + 1) eb_v = ebB; \
                unsigned q8[8]; \
_Pragma("unroll") \
                for (int j = 0; j < 8; ++j) { int p_ = __builtin_amdgcn_cvt_pk_fp8_f32(x[j][0] * mult, x[j][1] * mult, 0, false); p_ = __builtin_amdgcn_cvt_pk_fp8_f32(x[j][2] * mult, x[j][3] * mult, p_, true); q8[j] = (unsigned)p_; } \
                { const unsigned xo_ = xsc + hf * 1024 + bl * 32; *(LAS v4u*)(uintptr_t)xo_ = (v4u){q8[0], q8[1], q8[2], q8[3]}; *(LAS v4u*)(uintptr_t)(xo_ + 16) = (v4u){q8[4], q8[5], q8[6], q8[7]}; } \
                asm volatile("s_waitcnt lgkmcnt(0)" ::: "memory"); \
            }
#define NEWPAIR(k_) do { if (((k_) & 15) == 0) { const int p = (k_) >> 4; \
                        XSTAGE \
                        const int ebA_ = __builtin_amdgcn_readlane(eb_v, 2 * p), ebB_ = __builtin_amdgcn_readlane(eb_v, 2 * p + 1); sbx_ = ((ci >> 3) ? ebB_ : ebA_) - 7; \
                        const unsigned xrd_ = xsc + (ci >> 3) * 1024 + cg * 16; \
                        _Pragma("unroll") for (int j = 0; j < 8; ++j) { const v4u x0_ = *(const LAS v4u*)(uintptr_t)(xrd_ + 128 * j), x1_ = *(const LAS v4u*)(uintptr_t)(xrd_ + 128 * j + 64); \
                            xb[j] = (v8i_t){(int)x0_.x, (int)x0_.y, (int)x0_.z, (int)x0_.w, (int)x1_.x, (int)x1_.y, (int)x1_.z, (int)x1_.w}; } } } while (0)
#pragma nounroll
                for (int pq = 0; pq < 4; ++pq) {
                    asm volatile("s_barrier" ::: "memory");
                    NEWPAIR(16 * pq);
#pragma nounroll
                    for (int G = 0; G < 16; G += 2) { const int k = 16 * pq + G;
                        STEP(a0, a1, a2, a3, a4, a5, a6, a7, sa, b0, b1, b2, b3, b4, b5, b6, b7, sb, k);
                        STEP(b0, b1, b2, b3, b4, b5, b6, b7, sb, a0, a1, a2, a3, a4, a5, a6, a7, sa, k + 1);
                    }
                }
#undef NEWPAIR
#undef XSTAGE
#undef U_ST
#undef STEP
#undef MF1
#undef U_REQ
                asm volatile("s_waitcnt lgkmcnt(0)" ::: "memory");
            }
        }
        {
            const int ci = lane & 15, kb = lane >> 4, lr = lane >> 2, lp = lane & 3;
            typedef int v8i_t __attribute__((ext_vector_type(8))); typedef int v2i_t __attribute__((ext_vector_type(2))); typedef float f32x2_t __attribute__((ext_vector_type(2)));
            const unsigned vt = (unsigned)(uintptr_t)(F2.lds + RING_OFF + 65536 + w * 8192);
            LAS unsigned char* const CA = F2.lds + PEER_SCR + w * 2048;
            const unsigned trb = vt + 64 * (32 * kb + ci); const int swz = (ci >> 2) & 3;
            const unsigned stb = vt + 64 * lr + 16 * (lp ^ ((lr >> 2) & 3));
            const __amdgpu_buffer_rsrc_t rss = __builtin_amdgcn_make_buffer_rsrc((void*)(WSP(float, WS_PSC) + (size_t)l * NEXP), 0, NEXP * 4, 0x00020000);
            const __amdgpu_buffer_rsrc_t rsp = __builtin_amdgcn_make_buffer_rsrc((void*)(WSP(unsigned char, WS_PV) + (size_t)l * NEXP * PVROW), 0, NEXP * PVROW, 0x00020000);
            v4u R0[8], R1[8], R2[8], R3[8];
            int ron[8]; float svn0, svn1; unsigned en0, en1;
#define V_REQ(R, ro_, s_) do { _Pragma("unroll") for (int q = 0; q < 8; ++q) R[q] = __builtin_bit_cast(v4u, __builtin_amdgcn_raw_buffer_load_b128(rsp, ro_[q] + 64 * (s_), 0, 0)); } while (0)
#define V_TOK(t_) do { const LAS unsigned* ls_ = ids + (16 * w + (t_)) * 128; en0 = ls_[lane]; en1 = ls_[lane + 64]; \
                _Pragma("unroll") for (int q = 0; q < 8; ++q) ron[q] = (int)((ls_[16 * q + lr] & 0x3fffu) * (unsigned)PVROW) + 16 * lp; \
                svn0 = __builtin_bit_cast(float, __builtin_amdgcn_raw_buffer_load_b32(rss, (int)((en0 & 0x3fffu) * 4u), 0, 0)); svn1 = __builtin_bit_cast(float, __builtin_amdgcn_raw_buffer_load_b32(rss, (int)((en1 & 0x3fffu) * 4u), 0, 0)); } while (0)
            V_TOK(0);
            V_REQ(R0, ron, 0); V_REQ(R1, ron, 1);
#pragma nounroll
            for (int t2 = 0; t2 < 16; t2 += 2) {
                asm volatile("s_barrier" ::: "memory");
#pragma unroll
            for (int tt = 0; tt < 2; ++tt) { const int t = t2 + tt; const int FL = tt ? 6 : 0;
                const int tokl = 16 * w + t; const size_t tok = (size_t)tile * 128 + tokl;
                int ro[8]; const float s0 = svn0, s1 = svn1; const unsigned e0 = en0, e1 = en1;
#pragma unroll
                for (int q = 0; q < 8; ++q) ro[q] = ron[q];
                V_TOK(t + 1 < 16 ? t + 1 : 15);
                unsigned xo[8];
                { const unsigned* xr = (const unsigned*)(WSP(bf16, WS_XB) + tok * DM) + lane;
#pragma unroll
                  for (int q = 0; q < 8; ++q) xo[q] = __builtin_nontemporal_load(&xr[64 * q]); }
                int sa;
                {   const float c0 = __uint_as_float(e0 & 0xffff0000u) * s0, c1 = __uint_as_float(e1 & 0xffff0000u) * s1;
                    const float am = __builtin_fmaxf(wave_max_valu(__builtin_fmaxf(__builtin_fabsf(c0), __builtin_fabsf(c1))), 1e-30f);
                    const int eb = (int)(__float_as_uint(am) >> 23); const float mult = __uint_as_float((unsigned)(261 - eb) << 23);
                    sa = eb - 7;
                    const int p0 = __builtin_amdgcn_cvt_pk_fp8_f32(c0 * mult, c1 * mult, 0, false);
                    CA[lane] = (unsigned char)(p0 & 0xff); CA[lane + 64] = (unsigned char)((p0 >> 8) & 0xff);
                }
                asm volatile("s_waitcnt lgkmcnt(0)" ::: "memory");
                v8i_t A = {0, 0, 0, 0, 0, 0, 0, 0};
                if (ci == 0) { const v4u a0 = *(const LAS v4u*)(CA + 16 * kb), a1 = *(const LAS v4u*)(CA + 64 + 16 * kb); A = (v8i_t){(int)a0.x, (int)a0.y, (int)a0.z, (int)a0.w, (int)a1.x, (int)a1.y, (int)a1.z, (int)a1.w}; }
                float yv[16];
#define V_RQ2(RA, RB, s_) do { _Pragma("unroll") for (int q = 0; q < 8; ++q) { const int o_ = ((s_) + 2 < 8) ? ro[q] + 64 * (((s_) + 2) ^ FL) : ron[q] + 64 * (((s_) + 2 - 8) ^ (6 - FL));       \
                    RA[q] = __builtin_bit_cast(v4u, __builtin_amdgcn_raw_buffer_load_b128(rsp, o_, 0, 0)); RB[q] = __builtin_bit_cast(v4u, __builtin_amdgcn_raw_buffer_load_b128(rsp, o_ + 64, 0, 0)); } } while (0)
#define V_SLICE(RC, RN, s_) do { \
                    { int t_; asm volatile("s_mov_b32 %0, 1" : "=s"(t_)); if (t_) { \
                    _Pragma("unroll") for (int q = 0; q < 8; ++q) *(LAS v4u*)(uintptr_t)(stb + 1024 * q) = RC[q]; \
                    asm volatile("s_waitcnt lgkmcnt(0)" ::: "memory"); \
                    v2i_t tb_[16];       \
                    _Pragma("unroll") for (int cb = 0; cb < 8; ++cb) { const unsigned ad_ = trb + 16 * ((cb >> 1) ^ swz) + 8 * (cb & 1); \
                        tb_[2 * cb] = __builtin_amdgcn_ds_read_tr4_b64_v2i32((LAS v2i_t*)(uintptr_t)ad_); tb_[2 * cb + 1] = __builtin_amdgcn_ds_read_tr4_b64_v2i32((LAS v2i_t*)(uintptr_t)(ad_ + 1024)); } \
                    asm volatile("s_waitcnt lgkmcnt(0)" ::: "memory"); \
                    float dd_[8]; \
                    _Pragma("unroll") for (int cb = 0; cb < 8; ++cb) { const v8i_t B_ = {tb_[2 * cb].x, tb_[2 * cb].y, tb_[2 * cb + 1].x, tb_[2 * cb + 1].y, 0, 0, 0, 0}; const f32x4 z_ = {0.f, 0.f, 0.f, 0.f}; \
                        const f32x4 d_ = __builtin_amdgcn_mfma_scale_f32_16x16x128_f8f6f4(A, B_, z_, 0, 4, 0, sa, 0, 127); dd_[cb] = d_[0]; } \
                    asm volatile("" : "+v"(dd_[0]), "+v"(dd_[1]), "+v"(dd_[2]), "+v"(dd_[3]), "+v"(dd_[4]), "+v"(dd_[5]), "+v"(dd_[6]), "+v"(dd_[7]));       \
                    if (lane < 16) { _Pragma("unroll") for (int cb = 0; cb < 8; ++cb) ((LAS float*)(CA + 256))[16 * cb + lane] = dd_[cb]; } \
                    asm volatile("s_waitcnt lgkmcnt(0)" ::: "memory"); \
                    { const f32x2_t yy = ((const LAS f32x2_t*)(CA + 256))[lane]; yv[2 * ((s_) ^ FL)] = yy.x; yv[2 * ((s_) ^ FL) + 1] = yy.y; } \
                    asm volatile("s_waitcnt lgkmcnt(0)" ::: "memory"); } } } while (0)
                V_RQ2(R2, R3, 0); V_SLICE(R0, R3, 0); V_SLICE(R1, R0, 1); V_RQ2(R0, R1, 2); V_SLICE(R2, R1, 2); V_SLICE(R3, R2, 3);
                V_RQ2(R2, R3, 4); V_SLICE(R0, R3, 4); V_SLICE(R1, R0, 5); V_RQ2(R0, R1, 6); V_SLICE(R2, R1, 6); V_SLICE(R3, R2, 7);
#undef V_SLICE
#undef V_RQ2
                float s2_ = 0.f;
#pragma unroll
                for (int q = 0; q < 8; ++q) { yv[2 * q] += __uint_as_float(xo[q] << 16); yv[2 * q + 1] += __uint_as_float(xo[q] & 0xffff0000u); s2_ += yv[2 * q] * yv[2 * q] + yv[2 * q + 1] * yv[2 * q + 1]; }
                const float r2 = 1.0f / sqrtf(wave_sum_valu(s2_) * (1.f / DM) + EPS);
                if (l < 3) {
                    unsigned* xr = (unsigned*)(WSP(bf16, WS_XB) + tok * DM) + lane; unsigned* xn = (unsigned*)(WSP(bf16, WS_XN) + tok * DM) + lane; const LAS f32x2_t* gn = (const LAS f32x2_t*)(F2.lds + 149504) + lane;
#pragma unroll
                    for (int q = 0; q < 8; ++q) { __builtin_nontemporal_store(cvtpk(yv[2 * q], yv[2 * q + 1]), &xr[64 * q]); const f32x2_t g2 = gn[64 * q]; __builtin_nontemporal_store(cvtpk(yv[2 * q] * r2 * g2.x, yv[2 * q + 1] * r2 * g2.y), &xn[64 * q]); }
                    if (l == 1) { unsigned* xs = (unsigned*)(WSP(bf16, WS_MIX) + tok * DM) + lane; const LAS f32x2_t* gs = (const LAS f32x2_t*)(F2.lds + 149504 + 4096) + lane;
#pragma unroll
                        for (int q = 0; q < 8; ++q) { const f32x2_t g2 = gs[64 * q]; __builtin_nontemporal_store(cvtpk(yv[2 * q] * r2 * g2.x, yv[2 * q + 1] * r2 * g2.y), &xs[64 * q]); } }
                } else {
                    f32x2_t* oh = (f32x2_t*)(out_ + tok * DM) + lane; const LAS f32x2_t* gn = (const LAS f32x2_t*)(F2.lds + 149504) + lane;
#pragma unroll
                    for (int q = 0; q < 8; ++q) { const f32x2_t g2 = gn[64 * q]; __builtin_nontemporal_store((f32x2_t){yv[2 * q] * r2 * g2.x, yv[2 * q + 1] * r2 * g2.y}, &oh[64 * q]); }
                }
            }
            }
#undef V_REQ
#undef V_TOK
        }
        }
        __syncthreads();
    }
}

struct Args { const float* in[18]; float* out; unsigned char* ws; int ph_lo, ph_hi; };
__global__ void __launch_bounds__(NWAVES * 64, 2) hyb_fwd(Args args) {
    { Frame F = make_frame();
      for (int u = F.tid; u < 1024 / 4; u += NWAVES * 64) ((LAS unsigned*)(F.lds + LDSCTL_OFF))[u] = 0u; }
    __syncthreads();
    const int lo = args.ph_lo, hi = args.ph_hi;
    if (hi - lo > 1) { Frame F = make_frame(); const auto kp_ = ka_fresh(F); (void)xcd_barrier_post((unsigned*)(KA_WS(kp_) + WS_CTL) + CW_BAR, F.MISC + 8); }
#ifndef PHMASK
#define PHMASK 0xff
#endif

#define PHM(b) ((PHMASK & (b)) != 0)
#define IN(k) (lo <= (k) && (k) < hi)
#define SEAM(k) do { if (IN(k) && IN((k) + 1)) { Frame F = make_frame(); const auto kq_ = ka_fresh(F); XcdBarrier b_; b_.bar = (unsigned*)(KA_WS(kq_) + WS_CTL) + CW_BAR; b_.x = xb_xcc_id(); b_.st = F.MISC + 8; xcd_barrier(b_); if (NREP(512) == 2) xcd_barrier(b_); } } while (0)

    if (PHM(1) && IN(0)) { for (int rep_ = 0; rep_ < NREP(1); ++rep_) { Frame F = make_frame(); p0_prologue(F); } }
    SEAM(0);
    for (int l = 0; l < 4; ++l) {
        const int pb = 1 + 6 * l;
        if (PHM(2) && IN(pb)) {
            const int njobs = (l == 0) ? 5 : (l == 2 ? 2 : 1);
            for (int rep_ = 0; rep_ < NREP(2); ++rep_)
            for (int jb = 0; jb < njobs; ++jb) {
                Frame F = make_frame(); const auto kp_ = ka_fresh(F); unsigned char* const ws_ = KA_WS(kp_);
                pg8::Gemm g; pg8::EpiProj E; int cid = F.bx;
                E.rope = WSP(float, WS_ROPE); E.sc = att::C2; E.hm = 0; E.hs = 0;
                const bool is_skv = (l == 2 && jb == 0), is_proj = (l == 2) ? (jb == 1) : (jb == 0);
                if (is_skv) { g = pg8::Gemm{WSP(pg8::bf16_t, WS_MIX), WSP(pg8::bf16_t, WS_WSKV), TT, SKVW, DM}; E.O = WSP(pg8::bf16_t, WS_SKV); E.ldc = SKVW; E.rope_lim = 9; E.scale_lim = 0; E.scale_tile = -1; }
                else if (is_proj) { g = pg8::Gemm{WSP(pg8::bf16_t, WS_XN), (l < 2 ? WSP(pg8::bf16_t, WS_WA) + (size_t)l * INW * DM : WSP(pg8::bf16_t, WS_WB) + (size_t)(l - 2) * INW * DM), TT, INW, DM};
                    E.O = WSP(pg8::bf16_t, WS_PROJ); E.ldc = INW; E.rope_lim = (l < 2) ? 6 : 9; E.scale_lim = (l < 2) ? 3 : 9; E.scale_tile = 9; }
                else { const int lm = jb - 1; g = pg8::Gemm{WSP(pg8::bf16_t, WS_MEMN) + (size_t)lm * MEMROWS * DM, WSP(pg8::bf16_t, WS_WMKV) + (size_t)lm * MKVW * DM, MEMROWS, MKVW, DM};
                    E.O = WSP(pg8::bf16_t, WS_MEMKV) + (size_t)lm * MEMROWS * MKVW; E.ldc = MKVW; E.rope_lim = 0; E.scale_lim = 0; E.scale_tile = -1; cid = (int)((F.bx + F.G - 16 * lm) % F.G); }
                pg8::StaticOrder S; S.init(g.M, g.N, F.G, cid);
                pg8::gemm_phase<pg8::EpiProj, pg8::StaticOrder, true, true>(F.lds + RING_OFF, g, S, E);
                __syncthreads();
            }
        }
        SEAM(pb);
        if (IN(pb + 1)) {
            Frame F = make_frame(); const auto kp_ = ka_fresh(F); unsigned char* const ws_ = KA_WS(kp_);
            const bf16* PROJ = WSP(bf16, WS_PROJ); bf16* MIX = WSP(bf16, WS_MIX);
            if (PHM(4) && l < 2) {
                for (int rep_ = 0; rep_ < NREP(4); ++rep_) {
                const float li = 0.8f - 0.6f * expf(-0.3f * (float)l);
                const float* lp = KA_IN(kp_, 4) + l * 256;
                const float d01 = wave_sum(lp[F.lane] * lp[64 + F.lane]), d23 = wave_sum(lp[128 + F.lane] * lp[192 + F.lane]);
                const float lam = expf(d01) - expf(d23) + li;
                const float* subg = KA_IN(kp_, 5) + l * 128;
                const int nper = (768 + F.G - 1) / F.G;
                for (int k = 0; k < nper; ++k) {
                    const int P = F.vcu * nper + k; if (P >= 768) break;
                    const int bh = P >> 4, s = P & 15;
                    diff_unit(F, bh / 6, bh % 6, s, PROJ, MIX, lam, 1.0f - li, subg);
                    diff_unit(F, bh / 6, bh % 6, 31 - s, PROJ, MIX, lam, 1.0f - li, subg);
                }
                }
            } else if (PHM(8)) {
                for (int rep2_ = 0; rep2_ < NREP(8); ++rep2_) {
                const bf16* SKV = WSP(bf16, WS_SKV);
                const int nper = (4608 + F.G - 1) / F.G;
                for (int k = 0; k < nper; ++k) {
                    const int U = F.vcu * nper + k; if (U >= 4608) break;
                    const int w16 = U & 15, bh = U >> 4, head = bh % 36, b = bh / 36, g = head / 12;
                    const int d = g == 0 ? 1 : (g == 1 ? 4 : 16), res = g == 0 ? 0 : (g == 1 ? (w16 >> 2) : w16), s = g == 0 ? w16 : (g == 1 ? (w16 & 3) : 0);
                    dil_strip(F, b, head, res, s, d, PROJ, SKV, WSP(bf16, WS_OG), WSP(float, WS_LSEG));
                }
                }
            }
            if (l < 2) { for (int rep3_ = 0; rep3_ < NREP(16); ++rep3_) if (PHM(16)) mem_attn_all(F, PROJ, WSP(bf16, WS_MEMKV) + (size_t)l * MEMROWS * MKVW, MIX); }
            asm volatile("s_waitcnt vmcnt(0) lgkmcnt(0)" ::: "memory"); __syncthreads();
        }
        SEAM(pb + 1);
        if (IN(pb + 2) && l >= 2) {
            Frame F = make_frame(); const auto kp_ = ka_fresh(F); unsigned char* const ws_ = KA_WS(kp_);
            if (PHM(8)) dil_combine_all(F, WSP(bf16, WS_OG), WSP(float, WS_LSEG), WSP(bf16, WS_MIX));
            for (int rep3_ = 0; rep3_ < NREP(16); ++rep3_) if (PHM(16)) mem_attn_all(F, WSP(bf16, WS_PROJ), WSP(bf16, WS_MEMKV) + (size_t)l * MEMROWS * MKVW, WSP(bf16, WS_MIX));
            asm volatile("s_waitcnt vmcnt(0) lgkmcnt(0)" ::: "memory"); __syncthreads();
        }
        if (l >= 2) SEAM(pb + 2);
        if (PHM(32) && IN(pb + 3)) {
            Frame F = make_frame(); const auto kp_ = ka_fresh(F); unsigned char* const ws_ = KA_WS(kp_);
            pg8::Gemm g{WSP(pg8::bf16_t, WS_MIX), WSP(pg8::bf16_t, WS_WOUT) + (size_t)l * DM * DM, TT, DM, DM};
            pg8::EpiRes E{WSP(pg8::bf16_t, WS_XB), WSP(float, WS_SS), DM};
            pg8::StaticOrder S; S.init(TT, DM, F.G, F.bx);
            pg8::gemm_phase<pg8::EpiRes, pg8::StaticOrder, true, true>(F.lds + RING_OFF, g, S, E);
            __syncthreads();
        }
        SEAM(pb + 3);
        if (PHM(64) && IN(pb + 4)) {
            Frame F = make_frame(); const auto kp_ = ka_fresh(F); unsigned char* const ws_ = KA_WS(kp_);
            pg8::Gemm g{WSP(pg8::bf16_t, WS_XB), WSP(pg8::bf16_t, WS_WPQ) + (size_t)l * PQW * DM, TT, PQW, DM};
            pg8::EpiScaleRow E{WSP(pg8::bf16_t, WS_PROJ), PQW, WSP(float, WS_SS), EPS};
            pg8::StaticOrder S; S.init(TT, PQW, F.G, F.bx);
            for (int rep_ = 0; rep_ < NREP(64); ++rep_) {
            pg8::gemm_phase<pg8::EpiScaleRow, pg8::StaticOrder, true, true>(F.lds + RING_OFF, g, S, E);
            __syncthreads(); }
        }
        SEAM(pb + 4);
        if (PHM(128) && IN(pb + 5)) { Frame F = make_frame(); peer_phase(F, l); }
        SEAM(pb + 5);
    }
#undef IN
#undef SEAM
}

#ifndef HYB_N_LAUNCHES
#define HYB_N_LAUNCHES 1
#endif
extern "C" void kernel_launch(void* const* d_in, const int* in_sizes, int n_in, void* d_out, int out_size, void* d_ws, size_t ws_size, hipStream_t stream) {
    static int grid = 0;
    if (grid == 0) {
        if (n_in != 18 || out_size != TT * DM || ws_size < WS_END) { fprintf(stderr, "kernel_launch: unexpected shapes (n_in %d, out %d, ws %zu)\n", n_in, out_size, ws_size); grid = -1; return; }
        int dev = 0, cus = 0, per_cu = 0;
        if (hipGetDevice(&dev) != hipSuccess || hipDeviceGetAttribute(&cus, hipDeviceAttributeMultiprocessorCount, dev) != hipSuccess) { grid = -1; return; }
        if (hipFuncSetAttribute((const void*)hyb_fwd, hipFuncAttributeMaxDynamicSharedMemorySize, LDS_BYTES) != hipSuccess) { fprintf(stderr, "kernel_launch: hipFuncSetAttribute failed\n"); grid = -1; return; }
        if (hipOccupancyMaxActiveBlocksPerMultiprocessor(&per_cu, (const void*)hyb_fwd, NWAVES * 64, LDS_BYTES) != hipSuccess || per_cu < 1) { fprintf(stderr, "kernel_launch: occupancy query says %d\n", per_cu); }
        (void)hipGetLastError();
        grid = cus;
    }
    if (grid < 0) return;
    (void)hipMemsetAsync((char*)d_ws + WS_CTL, 0, CTL_ZERO_BYTES, stream);
    Args a{};
    for (int i = 0; i < 18; ++i) a.in[i] = (const float*)d_in[i];
    a.out = (float*)d_out; a.ws = (unsigned char*)d_ws;
    if (HYB_N_LAUNCHES == 1) { a.ph_lo = 0; a.ph_hi = NPHASE; hipLaunchKernelGGL(hyb_fwd, dim3(grid), dim3(NWAVES * 64), LDS_BYTES, stream, a); }
    else { for (int p = 0; p < NPHASE; ++p) { a.ph_lo = p; a.ph_hi = p + 1; hipLaunchKernelGGL(hyb_fwd, dim3(grid), dim3(NWAVES * 64), LDS_BYTES, stream, a); } }
}
```
